# Optimizing an MI355X kernel written in HIP

```python
import math
import jax
import jax.numpy as jnp
from jax import lax
import numpy as np

D_MODEL = 1024
BATCH = 4
SEQ = 8192
DEPTH = 2

GRID_W = 64
CTX_LEN = 256
EPS = 1e-6
SUBLN_EPS = 1e-5

FN_GROUPS = 4
FN_GROUP_DIM = 64
FN_WIDTH = FN_GROUPS * FN_GROUP_DIM

HY_WIDTH = 256
HY_ORDER = 2
HY_SHORT = 3
HY_EMB_BANDS = 16
HY_EMB_DIM = 1 + 2 * HY_EMB_BANDS
HY_FILTER_ORDER = 64
HY_DECAY_TARGET = 1e-2
HY_FAST_DECAY = 0.3
HY_SLOW_DECAY = 1.5

DA_HEADS = 4
DA_QK_DIM = 64
DA_V_DIM = 2 * DA_QK_DIM
DA_WIDTH = DA_HEADS * DA_V_DIM
ROPE_BASE = 10000.0
Q_BLOCK = 128

N_BRANCHES = 3
COL_F = FN_WIDTH
COL_HY = (HY_ORDER + 1) * HY_WIDTH
COL_QK = DA_HEADS * 2 * DA_QK_DIM
COL_V = DA_WIDTH
COL_G = N_BRANCHES * D_MODEL
OFF_F = 0
OFF_HY = OFF_F + COL_F
OFF_Q = OFF_HY + COL_HY
OFF_K = OFF_Q + COL_QK
OFF_V = OFF_K + COL_QK
OFF_G = OFF_V + COL_V
IN_COLS = OFF_G + COL_G

N_EXPERTS = 32
TOP_K = 4
D_EXPERT = 1024
SWIGLU_ALPHA = 1.702
SWIGLU_LIMIT = 7.0
MOE_BLOCK = 256

kernel_name = 'hybrid_fourier_hyena_diffattn_moe_dit'


def rms_norm(x, g, eps=EPS):
    x32 = x.astype(jnp.float32)
    y = x32 * lax.rsqrt(jnp.mean(x32 * x32, axis=-1, keepdims=True) + eps)
    return (y * g.astype(jnp.float32)).astype(x.dtype)


def modulate(h, shift, scale):
    return h * (1 + scale) + shift


def fourier_mix(u):
    b, l, _ = u.shape
    ug = u.astype(jnp.float32).reshape(b, l, FN_GROUPS, FN_GROUP_DIM)
    y = jnp.fft.fftn(ug, axes=(1, 3), norm='ortho').real
    return y.reshape(b, l, FN_WIDTH).astype(u.dtype)


def short_conv(u, w, b):
    l = u.shape[1]
    r = HY_SHORT // 2
    up = jnp.pad(u, ((0, 0), (r, r), (0, 0)))
    return sum(up[:, j:j + l] * w[j] for j in range(HY_SHORT)) + b


def hyena_filter_spectra(l, p):
    t = jnp.linspace(0.0, 1.0, l, dtype=jnp.float32)[:, None]
    ang = (2.0 * math.pi / l) * jnp.arange(l, dtype=jnp.float32)[:, None]
    bands = jnp.linspace(1e-4, HY_EMB_BANDS - 1, HY_EMB_BANDS, dtype=jnp.float32)[None, :]
    emb = jnp.concatenate([t, jnp.cos(bands * ang), -jnp.sin(bands * ang)], axis=-1)
    z = jnp.sin(p['hy_freq1'] * (emb @ p['hy_w1'] + p['hy_b1']))
    z = jnp.sin(p['hy_freq2'] * (z @ p['hy_w2'] + p['hy_b2']))
    h = (z @ p['hy_w3'] + p['hy_b3']).astype(jnp.float32).reshape(l, HY_ORDER, 2, HY_WIDTH)
    deltas = jnp.abs(jnp.linspace(math.log(HY_DECAY_TARGET) / HY_SLOW_DECAY,
                                  math.log(HY_DECAY_TARGET) / HY_FAST_DECAY, HY_WIDTH, dtype=jnp.float32))
    h = h * jnp.exp(-t * deltas)[:, None, None, :]
    h_fwd, h_bwd = h[:, :, 0], h[:, :, 1]
    filt = jnp.concatenate([h_fwd, jnp.zeros((1, HY_ORDER, HY_WIDTH), jnp.float32), h_bwd[1:][::-1]], axis=0)
    filt = filt / jnp.sum(jnp.abs(filt), axis=0, keepdims=True)
    return jnp.fft.rfft(filt, axis=0)


def long_conv(u, spec, bias):
    l = u.shape[1]
    u32 = u.astype(jnp.float32)
    uf = jnp.fft.rfft(u32, n=2 * l, axis=1)
    y = jnp.fft.irfft(uf * spec[None], n=2 * l, axis=1)[:, :l]
    return (y + u32 * bias).astype(u.dtype)


def hyena_mix(z, p, spec):
    z = short_conv(z, p['hy_conv_w'], p['hy_conv_b'])
    v, x1, x2 = jnp.split(z, HY_ORDER + 1, axis=-1)
    y = x1 * long_conv(v, spec[:, 0], p['hy_bias'][0])
    return x2 * long_conv(y, spec[:, 1], p['hy_bias'][1])


def axial_rope_tables(n_lat):
    rows = n_lat // GRID_W
    row = jnp.repeat(jnp.arange(rows), GRID_W)
    col = jnp.tile(jnp.arange(GRID_W), rows)
    pos = jnp.stack([row, col], axis=-1).astype(jnp.float32)
    n_freq = DA_QK_DIM // 4
    inv = ROPE_BASE ** (-jnp.arange(n_freq, dtype=jnp.float32) / n_freq)
    ang = pos[:, :, None] * inv
    return jnp.cos(ang), jnp.sin(ang)


def apply_axial_rope(t, cos, sin):
    tr = t.reshape(t.shape[:-1] + (2, 2, DA_QK_DIM // 4))
    a, b = tr[..., 0, :], tr[..., 1, :]
    c = cos[None, :, None, None]
    s = sin[None, :, None, None]
    out = jnp.stack([a * c - b * s, b * c + a * s], axis=-2)
    return out.reshape(t.shape).astype(t.dtype)


def diff_attend(q, k, v, lam):
    s = jnp.einsum('bqhmd,bkhmd->bhmqk', q, k).astype(jnp.float32) * (DA_QK_DIM ** -0.5)
    pr = jax.nn.softmax(s, axis=-1)
    a = pr[:, :, 0] - lam * pr[:, :, 1]
    return jnp.einsum('bhqk,bkhe->bqhe', a.astype(v.dtype), v)


def latent_diff_attention(q, k_all, v_all, lam):
    b, l = q.shape[:2]
    nb = l // Q_BLOCK
    qb = q.reshape((b, nb, Q_BLOCK) + q.shape[2:]).swapaxes(0, 1)
    o = lax.map(lambda blk: diff_attend(blk, k_all, v_all, lam), qb)
    return o.swapaxes(0, 1).reshape(b, l, DA_HEADS, DA_V_DIM)


def mixer_merge(proj, attn_heads, spec, p, lam_init):
    y_f = fourier_mix(proj[..., OFF_F:OFF_HY]) @ p['w_f']
    y_h = hyena_mix(proj[..., OFF_HY:OFF_Q], p, spec) @ p['w_h']
    o = rms_norm(attn_heads, p['subln_g'], SUBLN_EPS) * (1.0 - lam_init)
    y_a = o.reshape(o.shape[:2] + (DA_WIDTH,)) @ p['w_a']
    g_f, g_h, g_a = jnp.split(jax.nn.sigmoid(proj[..., OFF_G:]), N_BRANCHES, axis=-1)
    return (g_f * y_f + g_h * y_h + g_a * y_a) @ p['w_o']


def swiglu_clamped(u):
    x_glu, x_lin = u[..., ::2], u[..., 1::2]
    x_glu = jnp.minimum(x_glu, SWIGLU_LIMIT)
    x_lin = jnp.clip(x_lin, -SWIGLU_LIMIT, SWIGLU_LIMIT)
    return x_glu * jax.nn.sigmoid(SWIGLU_ALPHA * x_glu) * (x_lin + 1)


def moe_ffn(h, p):
    t_tok, d = h.shape
    logits = (h @ p['w_router'] + p['b_router']).astype(jnp.float32)
    top_v, top_i = lax.top_k(logits, TOP_K)
    gate = jax.nn.softmax(top_v, axis=-1)
    n_assign = t_tok * TOP_K
    flat_e = top_i.reshape(-1)
    order = jnp.argsort(flat_e)
    sorted_e = flat_e[order]
    sorted_tok = order // TOP_K
    sorted_gate = gate.reshape(-1)[order]
    counts = jnp.bincount(flat_e, length=N_EXPERTS)
    padded = (counts + MOE_BLOCK - 1) // MOE_BLOCK * MOE_BLOCK
    start = jnp.cumsum(counts) - counts
    pad_end = jnp.cumsum(padded)
    pad_start = pad_end - padded
    dest = pad_start[sorted_e] + jnp.arange(n_assign) - start[sorted_e]
    n_blocks = -(-n_assign // MOE_BLOCK) + N_EXPERTS
    n_rows = n_blocks * MOE_BLOCK
    row_tok = jnp.full((n_rows,), t_tok, jnp.int32).at[dest].set(sorted_tok.astype(jnp.int32))
    row_gate = jnp.zeros((n_rows,), jnp.float32).at[dest].set(sorted_gate)
    blk_exp = jnp.minimum(jnp.searchsorted(pad_end, jnp.arange(n_blocks) * MOE_BLOCK, side='right'), N_EXPERTS - 1)
    h_pad = jnp.concatenate([h, jnp.zeros((1, d), h.dtype)], axis=0)
    w1, b1, w2, b2 = p['w_e1'], p['b_e1'], p['w_e2'], p['b_e2']

    def expert_block(args):
        tok, e = args
        u = h_pad[tok] @ w1[e] + b1[e]
        return swiglu_clamped(u) @ w2[e] + b2[e]

    y = lax.map(expert_block, (row_tok.reshape(n_blocks, MOE_BLOCK), blk_exp))
    y = y.reshape(n_rows, d) * row_gate[:, None].astype(y.dtype)
    return jax.ops.segment_sum(y, row_tok, num_segments=t_tok + 1)[:t_tok]


def hybrid_layer(l, x, xc, c, c_ctx, p, ctx_out):
    b, n_lat, d = x.shape
    n_ctx = xc.shape[1]
    lam_init = 0.8 - 0.6 * math.exp(-0.3 * l)
    lam = (jnp.exp(jnp.sum(p['lam_q'][0] * p['lam_k'][0]).astype(jnp.float32))
           - jnp.exp(jnp.sum(p['lam_q'][1] * p['lam_k'][1]).astype(jnp.float32)) + lam_init)
    mod = jnp.split((jax.nn.silu(c) @ p['w_mod'] + p['b_mod'])[:, None, :], 6, axis=-1)
    mod_c = jnp.split(jax.nn.silu(c_ctx) @ p['w_mod'] + p['b_mod'], 6, axis=-1)

    h = modulate(rms_norm(x, p['norm1_g']), mod[0], mod[1])
    hc = modulate(rms_norm(xc, p['norm1_g']), mod_c[0], mod_c[1])
    proj = h @ p['w_in']
    if ctx_out:
        proj_c = hc @ p['w_in']
        kv_c = proj_c[..., OFF_K:OFF_G]
    else:
        kv_c = hc @ p['w_in'][:, OFF_K:OFF_G]
    k_c = rms_norm(kv_c[..., :COL_QK].reshape(b, n_ctx, DA_HEADS, 2, DA_QK_DIM), p['k_norm_g'])
    v_c = kv_c[..., COL_QK:].reshape(b, n_ctx, DA_HEADS, DA_V_DIM)

    cos, sin = axial_rope_tables(n_lat)
    q = apply_axial_rope(rms_norm(proj[..., OFF_Q:OFF_K].reshape(b, n_lat, DA_HEADS, 2, DA_QK_DIM), p['q_norm_g']), cos, sin)
    k = apply_axial_rope(rms_norm(proj[..., OFF_K:OFF_V].reshape(b, n_lat, DA_HEADS, 2, DA_QK_DIM), p['k_norm_g']), cos, sin)
    v = proj[..., OFF_V:OFF_G].reshape(b, n_lat, DA_HEADS, DA_V_DIM)
    o = latent_diff_attention(q, jnp.concatenate([k, k_c], axis=1), jnp.concatenate([v, v_c], axis=1), lam)
    x_mixed = x + mod[2] * mixer_merge(proj, o, hyena_filter_spectra(n_lat, p), p, lam_init)
    if ctx_out:
        q_c = rms_norm(proj_c[..., OFF_Q:OFF_K].reshape(b, n_ctx, DA_HEADS, 2, DA_QK_DIM), p['q_norm_g'])
        o_c = diff_attend(q_c, k_c, v_c, lam)
        xc = xc + mod_c[2] * mixer_merge(proj_c, o_c, hyena_filter_spectra(n_ctx, p), p, lam_init)
    x = x_mixed

    h2 = modulate(rms_norm(x, p['norm2_g']), mod[3], mod[4]).reshape(b * n_lat, d)
    if ctx_out:
        h2c = modulate(rms_norm(xc, p['norm2_g']), mod_c[3], mod_c[4]).reshape(b * n_ctx, d)
        y = moe_ffn(jnp.concatenate([h2c, h2], axis=0), p)
        xc = xc + mod_c[5] * y[:b * n_ctx].reshape(b, n_ctx, d)
        y_lat = y[b * n_ctx:]
    else:
        y_lat = moe_ffn(h2, p)
    x = x + mod[5] * y_lat.reshape(b, n_lat, d)
    return x, xc


def setup_inputs(seed: int = 0) -> dict:
    key = jax.random.key(seed)
    ks = jax.random.split(key, 35)
    D = D_MODEL
    hy_cols = (HY_ORDER + 1) * HY_WIDTH
    hy_out = HY_ORDER * 2 * HY_WIDTH

    def nrm(k, shape, scale):
        return jax.random.normal(k, shape, jnp.float32) * scale

    return {
        'x': nrm(ks[0], (BATCH, SEQ, D), 1.0),
        'c': nrm(ks[1], (BATCH, D), 1.0),
        'ctx': nrm(ks[2], (BATCH, CTX_LEN, D), 1.0),
        'c_ctx': nrm(ks[3], (D,), 1.0),
        'w_mod': nrm(ks[4], (DEPTH, D, 6 * D), 0.5 * D ** -0.5),
        'b_mod': nrm(ks[5], (DEPTH, 6 * D), 0.02),
        'norm1_g': 1.0 + nrm(ks[6], (DEPTH, D), 0.02),
        'norm2_g': 1.0 + nrm(ks[7], (DEPTH, D), 0.02),
        'w_in': nrm(ks[8], (DEPTH, D, IN_COLS), D ** -0.5),
        'hy_conv_w': nrm(ks[9], (DEPTH, HY_SHORT, hy_cols), HY_SHORT ** -0.5),
        'hy_conv_b': nrm(ks[10], (DEPTH, hy_cols), 0.02),
        'hy_w1': nrm(ks[11], (DEPTH, HY_EMB_DIM, HY_FILTER_ORDER), HY_EMB_DIM ** -0.5),
        'hy_b1': nrm(ks[12], (DEPTH, HY_FILTER_ORDER), 0.02),
        'hy_freq1': 1.0 + nrm(ks[13], (DEPTH, HY_FILTER_ORDER), 0.02),
        'hy_w2': nrm(ks[14], (DEPTH, HY_FILTER_ORDER, HY_FILTER_ORDER), HY_FILTER_ORDER ** -0.5),
        'hy_b2': nrm(ks[15], (DEPTH, HY_FILTER_ORDER), 0.02),
        'hy_freq2': 1.0 + nrm(ks[16], (DEPTH, HY_FILTER_ORDER), 0.02),
        'hy_w3': nrm(ks[17], (DEPTH, HY_FILTER_ORDER, hy_out), HY_FILTER_ORDER ** -0.5),
        'hy_b3': nrm(ks[18], (DEPTH, hy_out), 0.02),
        'hy_bias': nrm(ks[19], (DEPTH, HY_ORDER, HY_WIDTH), 1.0),
        'q_norm_g': 1.0 + nrm(ks[20], (DEPTH, DA_QK_DIM), 0.02),
        'k_norm_g': 1.0 + nrm(ks[21], (DEPTH, DA_QK_DIM), 0.02),
        'lam_q': nrm(ks[22], (DEPTH, 2, DA_QK_DIM), 0.1),
        'lam_k': nrm(ks[23], (DEPTH, 2, DA_QK_DIM), 0.1),
        'subln_g': 1.0 + nrm(ks[24], (DEPTH, DA_V_DIM), 0.02),
        'w_f': nrm(ks[25], (DEPTH, FN_WIDTH, D), FN_WIDTH ** -0.5),
        'w_h': nrm(ks[26], (DEPTH, HY_WIDTH, D), HY_WIDTH ** -0.5),
        'w_a': nrm(ks[27], (DEPTH, DA_WIDTH, D), DA_WIDTH ** -0.5),
        'w_o': nrm(ks[28], (DEPTH, D, D), D ** -0.5),
        'w_router': nrm(ks[29], (DEPTH, D, N_EXPERTS), D ** -0.5),
        'b_router': nrm(ks[30], (DEPTH, N_EXPERTS), 0.01),
        'w_e1': nrm(ks[31], (DEPTH, N_EXPERTS, D, 2 * D_EXPERT), D ** -0.5),
        'b_e1': nrm(ks[32], (DEPTH, N_EXPERTS, 2 * D_EXPERT), 0.02),
        'w_e2': nrm(ks[33], (DEPTH, N_EXPERTS, D_EXPERT, D), D_EXPERT ** -0.5),
        'b_e2': nrm(ks[34], (DEPTH, N_EXPERTS, D), 0.02),
    }


def reference(x, c, ctx, c_ctx, w_mod, b_mod, norm1_g, norm2_g, w_in, hy_conv_w, hy_conv_b,
              hy_w1, hy_b1, hy_freq1, hy_w2, hy_b2, hy_freq2, hy_w3, hy_b3, hy_bias,
              q_norm_g, k_norm_g, lam_q, lam_k, subln_g, w_f, w_h, w_a, w_o,
              w_router, b_router, w_e1, b_e1, w_e2, b_e2):
    xc = ctx
    for l in range(DEPTH):
        p = {
            'w_mod': w_mod[l], 'b_mod': b_mod[l], 'norm1_g': norm1_g[l], 'norm2_g': norm2_g[l],
            'w_in': w_in[l], 'hy_conv_w': hy_conv_w[l], 'hy_conv_b': hy_conv_b[l],
            'hy_w1': hy_w1[l], 'hy_b1': hy_b1[l], 'hy_freq1': hy_freq1[l],
            'hy_w2': hy_w2[l], 'hy_b2': hy_b2[l], 'hy_freq2': hy_freq2[l],
            'hy_w3': hy_w3[l], 'hy_b3': hy_b3[l], 'hy_bias': hy_bias[l],
            'q_norm_g': q_norm_g[l], 'k_norm_g': k_norm_g[l], 'lam_q': lam_q[l], 'lam_k': lam_k[l],
            'subln_g': subln_g[l], 'w_f': w_f[l], 'w_h': w_h[l], 'w_a': w_a[l], 'w_o': w_o[l],
            'w_router': w_router[l], 'b_router': b_router[l],
            'w_e1': w_e1[l], 'b_e1': b_e1[l], 'w_e2': w_e2[l], 'b_e2': b_e2[l],
        }
        x, xc = hybrid_layer(l, x, xc, c, c_ctx, p, l < DEPTH - 1)
    return x
```

```cpp
#include <hip/hip_runtime.h>
#include <hip/hip_cooperative_groups.h>
#include <cstdio>
namespace cg = cooperative_groups;

#define DI __device__ __forceinline__
typedef unsigned short u16;
typedef __attribute__((ext_vector_type(8))) short bf16x8;
typedef __attribute__((ext_vector_type(4))) short s16x4;
typedef __attribute__((ext_vector_type(16))) float f32x16;
typedef __bf16 bf2_t __attribute__((ext_vector_type(2)));
typedef float fl2_t __attribute__((ext_vector_type(2)));
#define MFMA16(a, b, c) __builtin_amdgcn_mfma_f32_32x32x16_bf16((a), (b), (c), 0, 0, 0)

constexpr int NT = 512;
constexpr int LDS_BYTES = 160 * 1024;
constexpr int NB = 4, L = 8192, D = 1024, T = NB * L, LC = 256, TC = NB * LC, TA = T + TC;
constexpr int NC = 5632, OFF_HY = 256, OFF_Q = 1024, OFF_V = 2048, OFF_G = 2560;
constexpr int LK = L + LC;
constexpr int NR = TA * 4 + 32 * 256;
constexpr float LOG2E = 1.4426950408889634f;

constexpr size_t WL_WIN = 0;
constexpr size_t WL_WF = WL_WIN + (size_t)NC * D * 2;
constexpr size_t WL_WH = WL_WF + (size_t)D * 256 * 2;
constexpr size_t WL_WA = WL_WH + (size_t)D * 256 * 2;
constexpr size_t WL_WO = WL_WA + (size_t)D * 512 * 2;
constexpr size_t WL_WE1 = WL_WO + (size_t)D * D * 2;
constexpr size_t WL_WE2 = WL_WE1 + (size_t)32 * 2048 * 1024 * 2;
constexpr size_t WL_SIZE = WL_WE2 + (size_t)32 * 1024 * 1024 * 2;
constexpr size_t O_WT = 0;
constexpr size_t O_MOD = O_WT + 2 * WL_SIZE;
constexpr size_t O_Z2 = O_MOD + 2 * 5 * 6144 * 4;
constexpr size_t O_Z2C = O_Z2 + (size_t)2 * L * 64 * 4;
constexpr size_t O_SPEC = O_Z2C + (size_t)LC * 64 * 4;
constexpr size_t O_FILTC = O_SPEC + (size_t)2 * 2 * 256 * 16384 * 8;
constexpr size_t O_XA = O_FILTC + (size_t)2 * 256 * 512 * 4;
constexpr size_t O_H = O_XA + (size_t)TA * D * 4;
constexpr size_t O_PROJ = O_H + (size_t)TA * D * 2;
constexpr size_t O_QN = O_PROJ + (size_t)TA * NC * 2;
constexpr size_t O_KN = O_QN + (size_t)NB * 4 * 2 * LK * 64 * 2;
constexpr size_t O_VT = O_KN + (size_t)NB * 4 * 2 * LK * 64 * 2;
constexpr size_t O_FM = O_VT + (size_t)NB * 4 * 128 * LK * 2;
constexpr size_t O_HY = O_FM + (size_t)TA * 256 * 2;
constexpr size_t O_O = O_HY + (size_t)TA * 256 * 2;
constexpr size_t O_MERGED = O_O + (size_t)TA * 512 * 2;
constexpr size_t O_HYSCR = O_MERGED + (size_t)TA * D * 2;
constexpr size_t O_YEND0 = O_HYSCR + (size_t)256 * 4 * 8192 * 8;
constexpr size_t O_Y = O_QN;
constexpr size_t Y_BYTES = (size_t)NR * D * 2;
constexpr size_t O_SMALL = (O_YEND0 > O_Y + Y_BYTES) ? O_YEND0 : (O_Y + Y_BYTES);
constexpr size_t O_TOKE = O_SMALL;
constexpr size_t O_TOKG = O_TOKE + (size_t)TA * 16;
constexpr size_t O_TOKLP = O_TOKG + (size_t)TA * 16;
constexpr size_t O_TOKSLOT = O_TOKLP + (size_t)TA * 16;
constexpr size_t O_CNT = O_TOKSLOT + (size_t)TA * 16;
constexpr size_t O_ROWTOK = O_CNT + 256 * 32 * 4;
constexpr size_t O_TILEE = O_ROWTOK + (size_t)NR * 4;
constexpr size_t O_ZT = O_TILEE + 4096;
constexpr size_t O_GF = O_ZT + (size_t)NB * 1024 * L * 2;
constexpr size_t O_FMT = O_GF + (size_t)3 * TA * 1024 * 2;
constexpr size_t O_HYT = O_FMT + (size_t)NB * 256 * L * 2;
constexpr size_t O_BAR = O_HYT + (size_t)NB * 256 * L * 2;
constexpr size_t WS_NEED = O_BAR + 16384;
static_assert((size_t)NR * D * 2 <= (size_t)TA * NC * 2, "ACT must fit in PROJ");

struct P {
  const float* in[35];
  float* out;
  unsigned char* ws;
  unsigned long long ws_size;
};
enum { I_X = 0, I_C, I_CTX, I_CCTX, I_WMOD, I_BMOD, I_N1G, I_N2G, I_WIN, I_HCW, I_HCB, I_HW1, I_HB1, I_HF1, I_HW2, I_HB2,
       I_HF2, I_HW3, I_HB3, I_HBIAS, I_QNG, I_KNG, I_LAMQ, I_LAMK, I_SUBG, I_WF, I_WH, I_WA, I_WO, I_WR, I_BR, I_WE1, I_BE1, I_WE2, I_BE2 };

DI float bf2f(u16 v) { return __uint_as_float(((unsigned)v) << 16); }
DI unsigned pack2(float a, float b) { fl2_t f = {a, b}; bf2_t r = __builtin_convertvector(f, bf2_t); return __builtin_bit_cast(unsigned, r); }
DI u16 f2bf(float a) { return (u16)(pack2(a, 0.f) & 0xffffu); }
DI float lo16(unsigned u) { return __uint_as_float(u << 16); }
DI float hi16(unsigned u) { return __uint_as_float(u & 0xffff0000u); }
DI float sin_t(float turns) { return __builtin_amdgcn_sinf(__builtin_amdgcn_fractf(turns)); }
DI float cos_t(float turns) { return __builtin_amdgcn_cosf(__builtin_amdgcn_fractf(turns)); }
DI int otid() { int t = threadIdx.x; asm volatile("" : "+v"(t)); return t; }
DI float shx(float v, int o) { int lane = otid() & 63; return __builtin_bit_cast(float, __builtin_amdgcn_ds_bpermute((lane ^ o) << 2, __builtin_bit_cast(int, v))); }
DI float wave_sum(float v) { for (int o = 32; o >= 1; o >>= 1) v += shx(v, o); return v; }
DI float wave_max(float v) { for (int o = 32; o >= 1; o >>= 1) v = fmaxf(v, shx(v, o)); return v; }
DI float sigmoidf_(float x) { return 1.f / (1.f + __expf(-x)); }
DI size_t boff(int row, int k, int K) { return ((size_t)(row >> 8) * (K >> 6) + (k >> 6)) * 16384 + (row & 255) * 64 + (k & 63); }
DI size_t boff128(int row, int k, int K) { return ((size_t)(row >> 7) * (K >> 6) + (k >> 6)) * 8192 + (row & 127) * 64 + (k & 63); }
DI int crow(int i, int hh) { return (i & 3) + 8 * (i >> 2) + 4 * hh; }
DI float lam_init_of(int l) { return l == 0 ? 0.2f : 0.35550906f; }

DI float block_sum(float v, float* red) {
  v = wave_sum(v);
  __syncthreads();
  if ((otid() & 63) == 0) red[otid() >> 6] = v;
  __syncthreads();
  float s = 0.f;
  for (int i = 0; i < NT / 64; ++i) s += red[i];
  return s;
}

DI int phys(int p) { return p + (p >> 4); }
DI float2 cmul(float2 a, float2 b) { return make_float2(a.x * b.x - a.y * b.y, a.x * b.y + a.y * b.x); }

template <int N, bool INV>
DI void fft_lds(float2* s) {
  constexpr int LG = (N == 16384) ? 14 : (N == 8192) ? 13 : 9;
  const int tid = otid();
  if (!INV) {
    if (LG & 1) {
      __syncthreads();
      constexpr int h = N / 2;
#pragma unroll 4
      for (int j = tid; j < h; j += NT) {
        float f = (float)j * (1.0f / N);
        float2 w = make_float2(cos_t(f), -sin_t(f));
        float2 a = s[phys(j)], b = s[phys(j + h)];
        s[phys(j)] = make_float2(a.x + b.x, a.y + b.y);
        s[phys(j + h)] = cmul(make_float2(a.x - b.x, a.y - b.y), w);
      }
    }
    for (int lq = (LG & 1) ? LG - 3 : LG - 2; lq >= 0; lq -= 2) {
      const int q = 1 << lq;
      __syncthreads();
      const float inv4q = 1.0f / (float)(4 * q);
#pragma unroll 4
      for (int it = 0; it < N / 4 / NT; ++it) {
        int idx = tid + it * NT;
        int j = idx & (q - 1), blk = idx >> lq;
        int p0 = blk * 4 * q + j;
        float f = (float)j * inv4q;
        float2 t1 = make_float2(cos_t(f), -sin_t(f));
        float2 t2 = cmul(t1, t1);
        float2 x0 = s[phys(p0)], x1 = s[phys(p0 + q)], x2 = s[phys(p0 + 2 * q)], x3 = s[phys(p0 + 3 * q)];
        float2 a0 = make_float2(x0.x + x2.x, x0.y + x2.y);
        float2 a2 = cmul(make_float2(x0.x - x2.x, x0.y - x2.y), t1);
        float2 a1 = make_float2(x1.x + x3.x, x1.y + x3.y);
        float2 d3 = make_float2(x1.x - x3.x, x1.y - x3.y);
        float2 a3 = cmul(make_float2(d3.y, -d3.x), t1);
        s[phys(p0)] = make_float2(a0.x + a1.x, a0.y + a1.y);
        s[phys(p0 + q)] = cmul(make_float2(a0.x - a1.x, a0.y - a1.y), t2);
        s[phys(p0 + 2 * q)] = make_float2(a2.x + a3.x, a2.y + a3.y);
        s[phys(p0 + 3 * q)] = cmul(make_float2(a2.x - a3.x, a2.y - a3.y), t2);
      }
    }
  } else {
    constexpr int top = (LG & 1) ? N / 8 : N / 4;
    for (int lq = 0; (1 << lq) <= top; lq += 2) {
      const int q = 1 << lq;
      __syncthreads();
      const float inv4q = 1.0f / (float)(4 * q);
#pragma unroll 4
      for (int it = 0; it < N / 4 / NT; ++it) {
        int idx = tid + it * NT;
        int j = idx & (q - 1), blk = idx >> lq;
        int p0 = blk * 4 * q + j;
        float f = (float)j * inv4q;
        float2 t1 = make_float2(cos_t(f), sin_t(f));
        float2 t2 = cmul(t1, t1);
        float2 x0 = s[phys(p0)], x1 = s[phys(p0 + q)], x2 = s[phys(p0 + 2 * q)], x3 = s[phys(p0 + 3 * q)];
        float2 b = cmul(x1, t2);
        float2 a0 = make_float2(x0.x + b.x, x0.y + b.y), a1 = make_float2(x0.x - b.x, x0.y - b.y);
        b = cmul(x3, t2);
        float2 a2 = make_float2(x2.x + b.x, x2.y + b.y), a3 = make_float2(x2.x - b.x, x2.y - b.y);
        b = cmul(a2, t1);
        s[phys(p0)] = make_float2(a0.x + b.x, a0.y + b.y);
        s[phys(p0 + 2 * q)] = make_float2(a0.x - b.x, a0.y - b.y);
        float2 c3 = cmul(a3, t1);
        b = make_float2(-c3.y, c3.x);
        s[phys(p0 + q)] = make_float2(a1.x + b.x, a1.y + b.y);
        s[phys(p0 + 3 * q)] = make_float2(a1.x - b.x, a1.y - b.y);
      }
    }
    if (LG & 1) {
      __syncthreads();
      constexpr int h = N / 2;
#pragma unroll 4
      for (int j = tid; j < h; j += NT) {
        float f = (float)j * (1.0f / N);
        float2 w = make_float2(cos_t(f), sin_t(f));
        float2 a = s[phys(j)], b = cmul(s[phys(j + h)], w);
        s[phys(j)] = make_float2(a.x + b.x, a.y + b.y);
        s[phys(j + h)] = make_float2(a.x - b.x, a.y - b.y);
      }
    }
  }
  __syncthreads();
}

DI void convT(const float* __restrict__ src, int K, int N, u16* __restrict__ dst, int nbatch, bool perm, float* sm, int blockR = 0) {
  const int tk = K / 64, tn = N / 256, per = tk * tn, total = per * nbatch;
  const int tid = otid();
  for (int t = blockIdx.x; t < total; t += gridDim.x) {
    int bt = t / per, rr = t % per, kt = rr / tn, nt = rr % tn;
    const float* sp = src + (size_t)bt * K * N + (size_t)(kt * 64) * N + nt * 256;
    u16* dp = dst + (size_t)bt * K * N;
    int kr = tid >> 3, c8 = (tid & 7) * 8;
    float4 a[4], b[4];
#pragma unroll
    for (int q = 0; q < 4; ++q) {
      a[q] = *(const float4*)(sp + (size_t)kr * N + q * 64 + c8);
      b[q] = *(const float4*)(sp + (size_t)kr * N + q * 64 + c8 + 4);
    }
    __syncthreads();
#pragma unroll
    for (int q = 0; q < 4; ++q) {
      float* row = sm + kr * 257 + q * 64 + c8;
      row[0] = a[q].x; row[1] = a[q].y; row[2] = a[q].z; row[3] = a[q].w; row[4] = b[q].x; row[5] = b[q].y; row[6] = b[q].z; row[7] = b[q].w;
    }
    __syncthreads();
#pragma unroll
    for (int q = 0; q < 4; ++q) {
      int n = (tid >> 3) + 64 * q, k8 = (tid & 7) * 8;
      float v[8];
#pragma unroll
      for (int j = 0; j < 8; ++j) v[j] = sm[(k8 + j) * 257 + n];
      int ng = nt * 256 + n;
      if (perm) { int j2 = ng >> 1; ng = (j2 >> 5) * 64 + ((ng & 1) ? 32 : 0) + (j2 & 31); }
      uint4 o = make_uint4(pack2(v[0], v[1]), pack2(v[2], v[3]), pack2(v[4], v[5]), pack2(v[6], v[7]));
      size_t doff = blockR == 256 ? boff(ng, kt * 64 + k8, K) : blockR == 128 ? boff128(ng, kt * 64 + k8, K) : (size_t)ng * K + kt * 64 + k8;
      *(uint4*)(dp + doff) = o;
    }
  }
  __syncthreads();
}

DI void mod_phase(const P& p, float* sm) {
  const int tid = otid();
  float* sl = sm;
  float* red = sm + 5 * 1024;
  __syncthreads();
  for (int i = tid; i < 5 * 1024; i += NT) {
    int r = i >> 10, d = i & 1023;
    float c = (r < 4) ? p.in[I_C][r * 1024 + d] : p.in[I_CCTX][d];
    sl[i] = c / (1.f + __expf(-c));
  }
  __syncthreads();
  float* MOD = (float*)(p.ws + O_MOD);
  for (int it = blockIdx.x; it < 2 * 96; it += gridDim.x) {
    int l = it / 96, c0 = (it % 96) * 64;
    int col = tid & 63, ds = tid >> 6;
    const float* w = p.in[I_WMOD] + (size_t)l * 1024 * 6144 + c0 + col;
    float acc[5] = {0.f, 0.f, 0.f, 0.f, 0.f};
    for (int d = ds * 128; d < ds * 128 + 128; ++d) {
      float wv = w[(size_t)d * 6144];
#pragma unroll
      for (int r = 0; r < 5; ++r) acc[r] += sl[r * 1024 + d] * wv;
    }
    __syncthreads();
#pragma unroll
    for (int r = 0; r < 5; ++r) red[(ds * 5 + r) * 64 + col] = acc[r];
    __syncthreads();
    if (tid < 320) {
      int r = tid >> 6, cc = tid & 63;
      float s = 0.f;
      for (int k = 0; k < 8; ++k) s += red[(k * 5 + r) * 64 + cc];
      MOD[(l * 5 + r) * 6144 + c0 + cc] = s + p.in[I_BMOD][l * 6144 + c0 + cc];
    }
  }
  __syncthreads();
}

DI void z2_phase(const P& p, float* sm) {
  const int tid = otid();
  const int tt = tid >> 6, j = tid & 63;
  float* emb = sm;
  float* z1 = sm + 8 * 33;
  const int n_lat = L / 8, n_ctx = LC / 8;
  for (int it = blockIdx.x; it < 2 * n_lat + n_ctx; it += gridDim.x) {
    int l, Lf, t0; float* dst;
    if (it < 2 * n_lat) { l = it / n_lat; Lf = L; t0 = (it % n_lat) * 8; dst = (float*)(p.ws + O_Z2) + (size_t)l * L * 64; }
    else { l = 0; Lf = LC; t0 = (it - 2 * n_lat) * 8; dst = (float*)(p.ws + O_Z2C); }
    int t = t0 + tt;
    __syncthreads();
    if (j < 33) {
      float v;
      if (j == 0) v = (float)t / (float)(Lf - 1);
      else {
        int k = (j - 1) & 15;
        float band = 1e-4f + (float)k * ((15.f - 1e-4f) / 15.f);
        float turns = band * ((float)t / (float)Lf);
        v = (j <= 16) ? cos_t(turns) : -sin_t(turns);
      }
      emb[tt * 33 + j] = v;
    }
    __syncthreads();
    const float* w1 = p.in[I_HW1] + l * 33 * 64;
    float a = p.in[I_HB1][l * 64 + j];
    for (int i = 0; i < 33; ++i) a += emb[tt * 33 + i] * w1[i * 64 + j];
    z1[tt * 64 + j] = sin_t(p.in[I_HF1][l * 64 + j] * a * 0.15915494309189535f);
    __syncthreads();
    const float* w2 = p.in[I_HW2] + l * 64 * 64;
    float a2 = p.in[I_HB2][l * 64 + j];
    for (int i = 0; i < 64; ++i) a2 += z1[tt * 64 + i] * w2[i * 64 + j];
    dst[(size_t)t * 64 + j] = sin_t(p.in[I_HF2][l * 64 + j] * a2 * 0.15915494309189535f);
  }
  __syncthreads();
}

DI float hy_delta(int c) { return 4.605170185988091f * (1.f / 1.5f + (float)c * (1.f / 255.f) * (1.f / 0.3f - 1.f / 1.5f)); }

DI void filter_phase(const P& p, unsigned char* lds) {
  float2* s = (float2*)lds;
  float* w3s_ = (float*)(lds + 17408 * 8);
  float* red = w3s_ + 256;
  for (int it = blockIdx.x; it < 512 + 256; it += gridDim.x) {
    const int tid = otid();
    const bool lat = it < 512;
    const int l = lat ? (it >> 8) : 0, c = it & 255;
    const int Lf = lat ? L : LC;
    const float* z2 = lat ? (const float*)(p.ws + O_Z2) + (size_t)l * L * 64 : (const float*)(p.ws + O_Z2C);
    __syncthreads();
    if (tid < 256) {
      int od = tid >> 6, i = tid & 63;
      w3s_[tid] = p.in[I_HW3][(size_t)l * 64 * 1024 + i * 1024 + od * 256 + c];
    }
    __syncthreads();
    const float delta = hy_delta(c);
    float lsum0 = 0.f, lsum1 = 0.f;
    float2* park = (float2*)(p.ws + O_HYSCR) + (size_t)blockIdx.x * 4 * 8192;
#pragma unroll 1
    for (int k = 0; k < 16; ++k) {
      const int t = tid + k * NT;
      if (t < Lf) {
        const float4* zr = (const float4*)(z2 + (size_t)t * 64);
        const float* b3p = p.in[I_HB3] + l * 1024 + c;
        float a0 = b3p[0], a1 = b3p[256], a2 = b3p[512], a3 = b3p[768];
        const float* w3s = w3s_;
        asm volatile("" : "+v"(w3s));
#pragma unroll
        for (int i = 0; i < 16; ++i) {
          float4 z = zr[i];
          a0 += z.x * w3s[4 * i] + z.y * w3s[4 * i + 1] + z.z * w3s[4 * i + 2] + z.w * w3s[4 * i + 3];
          a1 += z.x * w3s[64 + 4 * i] + z.y * w3s[64 + 4 * i + 1] + z.z * w3s[64 + 4 * i + 2] + z.w * w3s[64 + 4 * i + 3];
          a2 += z.x * w3s[128 + 4 * i] + z.y * w3s[128 + 4 * i + 1] + z.z * w3s[128 + 4 * i + 2] + z.w * w3s[128 + 4 * i + 3];
          a3 += z.x * w3s[192 + 4 * i] + z.y * w3s[192 + 4 * i + 1] + z.z * w3s[192 + 4 * i + 2] + z.w * w3s[192 + 4 * i + 3];
        }
        float dec = __expf(-((float)t / (float)(Lf - 1)) * delta);
        a0 *= dec; a1 *= dec; a2 *= dec; a3 *= dec;
        s[phys(t)] = make_float2(a0, 0.f);
        lsum0 += fabsf(a0);
        lsum1 += fabsf(a2);
        if (t >= 1) { s[phys(2 * Lf - t)] = make_float2(a1, 0.f); lsum0 += fabsf(a1); lsum1 += fabsf(a3); }
        else s[phys(Lf)] = make_float2(0.f, 0.f);
        park[t] = make_float2(a2, a3);
      }
    }
#pragma unroll 1
    for (int o = 0; o < 2; ++o) {
      const int tid = otid();
      if (o == 1) {
        __syncthreads();
#pragma unroll 4
        for (int k = 0; k < 16; ++k) {
          const int t = tid + k * NT;
          if (t < Lf) {
            float2 pv = park[t];
            s[phys(t)] = make_float2(pv.x, 0.f);
            if (t >= 1) s[phys(2 * Lf - t)] = make_float2(pv.y, 0.f);
            else s[phys(Lf)] = make_float2(0.f, 0.f);
          }
        }
      }
      float tot = block_sum(o == 0 ? lsum0 : lsum1, red);
      float inv = 1.f / tot;
      if (lat) {
        fft_lds<16384, false>(s);
        float2* dst = (float2*)(p.ws + O_SPEC) + ((size_t)(l * 2 + o) * 256 + c) * 16384;
#pragma unroll 8
        for (int i = tid; i < 16384; i += NT) { float2 v = s[phys(i)]; dst[i] = make_float2(v.x * inv, v.y * inv); }
      } else {
        float* dst = (float*)(p.ws + O_FILTC) + (size_t)(o * 256 + c) * 512;
        dst[tid] = s[phys(tid)].x * inv;
      }
    }
  }
  __syncthreads();
}

DI void norm_mod_store(const float (&xv)[16], const float* g, const float* shift, const float* scale, u16* Hb, int row, int lane) {
  float ss = 0.f;
#pragma unroll
  for (int i = 0; i < 16; ++i) ss += xv[i] * xv[i];
  ss = wave_sum(ss);
  float rinv = rsqrtf(ss * (1.f / 1024.f) + 1e-6f);
#pragma unroll
  for (int i = 0; i < 4; ++i) {
    int c = (i * 64 + lane) * 4;
    float4 gv = *(const float4*)(g + c), sh = *(const float4*)(shift + c), sc = *(const float4*)(scale + c);
    float h0 = xv[4 * i] * rinv * gv.x * (1.f + sc.x) + sh.x;
    float h1 = xv[4 * i + 1] * rinv * gv.y * (1.f + sc.y) + sh.y;
    float h2 = xv[4 * i + 2] * rinv * gv.z * (1.f + sc.z) + sh.z;
    float h3 = xv[4 * i + 3] * rinv * gv.w * (1.f + sc.w) + sh.w;
    *(uint2*)(Hb + boff(row, c, 1024)) = make_uint2(pack2(h0, h1), pack2(h2, h3));
  }
}

DI void norm1_layer0(const P& p) {
  const int lane = otid() & 63, gw = blockIdx.x * (NT / 64) + (otid() >> 6), nw = gridDim.x * (NT / 64);
  const float* MOD = (const float*)(p.ws + O_MOD);
  u16* H = (u16*)(p.ws + O_H);
  for (int row = gw; row < TA; row += nw) {
    const float* xr = row < T ? p.in[I_X] + (size_t)row * D : p.in[I_CTX] + (size_t)(row - T) * D;
    int mr = row < T ? (row >> 13) : 4;
    float xv[16];
#pragma unroll
    for (int i = 0; i < 4; ++i) { float4 v = *(const float4*)(xr + (i * 64 + lane) * 4); xv[4 * i] = v.x; xv[4 * i + 1] = v.y; xv[4 * i + 2] = v.z; xv[4 * i + 3] = v.w; }
    norm_mod_store(xv, p.in[I_N1G], MOD + mr * 6144, MOD + mr * 6144 + 1024, H, row, lane);
  }
}

constexpr int G_AST = 144;
constexpr int G_ABYTES = 256 * G_AST, G_BBYTES = 128 * G_AST, G_STAGE = G_ABYTES + G_BBYTES;

#define G_LOADR(S, ko) do { S##0 = *(const uint4*)(a0p + (ko)); S##1 = *(const uint4*)(a1p + (ko)); S##2 = *(const uint4*)(a2p + (ko)); \
    S##3 = *(const uint4*)(a3p + (ko)); S##4 = *(const uint4*)(b0p + (ko)); S##5 = *(const uint4*)(b1p + (ko)); } while (0)
#define G_STORER(S, nb) do { *(uint4*)((nb) + wofs) = S##0; *(uint4*)((nb) + wofs + 64 * G_AST) = S##1; *(uint4*)((nb) + wofs + 128 * G_AST) = S##2; \
    *(uint4*)((nb) + wofs + 192 * G_AST) = S##3; *(uint4*)((nb) + G_ABYTES + wofs) = S##4; *(uint4*)((nb) + G_ABYTES + wofs + 64 * G_AST) = S##5; } while (0)

DI void gemm_compute(f32x16 (&acc)[2][2], const unsigned char* As, const unsigned char* Bs) {
  bf16x8 a0 = *(const bf16x8*)(As), a1 = *(const bf16x8*)(As + 32 * G_AST);
  bf16x8 b0 = *(const bf16x8*)(Bs), b1 = *(const bf16x8*)(Bs + 32 * G_AST);
#pragma unroll
  for (int ks = 0; ks < 4; ++ks) {
    bf16x8 na0 = a0, na1 = a1, nb0 = b0, nb1 = b1;
    if (ks < 3) {
      na0 = *(const bf16x8*)(As + (ks + 1) * 32); na1 = *(const bf16x8*)(As + 32 * G_AST + (ks + 1) * 32);
      nb0 = *(const bf16x8*)(Bs + (ks + 1) * 32); nb1 = *(const bf16x8*)(Bs + 32 * G_AST + (ks + 1) * 32);
    }
    acc[0][0] = MFMA16(a0, b0, acc[0][0]);
    acc[0][1] = MFMA16(a0, b1, acc[0][1]);
    acc[1][0] = MFMA16(a1, b0, acc[1][0]);
    acc[1][1] = MFMA16(a1, b1, acc[1][1]);
    a0 = na0; a1 = na1; b0 = nb0; b1 = nb1;
  }
}

DI void gemm_main(f32x16 (&acc)[2][2], const u16* const (&ap)[4], const u16* const (&bp)[2], int K, unsigned char* lds) {
  const int tid = otid(), lane = tid & 63, w = tid >> 6, r = lane & 31, hh = lane >> 5;
  const int wm = w >> 1, wn = w & 1;
  const int wofs = (tid >> 3) * G_AST + (tid & 7) * 16;
  const u16* a0p = ap[0]; const u16* a1p = ap[1]; const u16* a2p = ap[2]; const u16* a3p = ap[3];
  const u16* b0p = bp[0]; const u16* b1p = bp[1];
  uint4 P0, P1, P2, P3, P4, P5;
  const int nk = K >> 6;
  const bool late = w >= 4;
  G_LOADR(P, 0);
  G_STORER(P, lds);
  if (late && nk > 1) G_LOADR(P, 64);
  __syncthreads();
  const unsigned char* As0 = lds + (wm * 64 + r) * G_AST + hh * 16;
  const unsigned char* Bs0 = lds + G_ABYTES + (wn * 64 + r) * G_AST + hh * 16;
  if (!late) {
    for (int kt = 0; kt < nk; ++kt) {
      const bool more = kt + 1 < nk;
      if (more) G_LOADR(P, (kt + 1) * 64);
      __builtin_amdgcn_sched_barrier(0);
      gemm_compute(acc, As0 + (kt & 1) * G_STAGE, Bs0 + (kt & 1) * G_STAGE);
      __builtin_amdgcn_sched_barrier(0);
      if (more) G_STORER(P, lds + ((kt + 1) & 1) * G_STAGE);
      __syncthreads();
    }
  } else {
    for (int kt = 0; kt < nk; ++kt) {
      if (kt + 1 < nk) G_STORER(P, lds + ((kt + 1) & 1) * G_STAGE);
      __builtin_amdgcn_sched_barrier(0);
      if (kt + 2 < nk) G_LOADR(P, (kt + 2) * 64);
      __builtin_amdgcn_sched_barrier(0);
      gemm_compute(acc, As0 + (kt & 1) * G_STAGE, Bs0 + (kt & 1) * G_STAGE);
      __syncthreads();
    }
  }
}

DI void acc_zero(f32x16 (&acc)[2][2]) {
#pragma unroll
  for (int a = 0; a < 2; ++a)
#pragma unroll
    for (int b = 0; b < 2; ++b)
#pragma unroll
      for (int i = 0; i < 16; ++i) acc[a][b][i] = 0.f;
}

constexpr int G2_ABYTES = 256 * G_AST, G2_STAGE = 2 * G2_ABYTES;
#define G2_LOADR(kt_) do { const size_t ko = (size_t)(kt_) * 16384; R0 = *(const uint4*)(a0p + ko); R1 = *(const uint4*)(a1p + ko); R2 = *(const uint4*)(a2p + ko); R3 = *(const uint4*)(a3p + ko); \
    R4 = *(const uint4*)(b0p + ko); R5 = *(const uint4*)(b0p + 4096 + ko); R6 = *(const uint4*)(b0p + 8192 + ko); R7 = *(const uint4*)(b0p + 12288 + ko); } while (0)
#define G2_STORER(nb) do { *(uint4*)((nb) + wofs) = R0; *(uint4*)((nb) + wofs + 64 * G_AST) = R1; *(uint4*)((nb) + wofs + 128 * G_AST) = R2; *(uint4*)((nb) + wofs + 192 * G_AST) = R3; \
    *(uint4*)((nb) + G2_ABYTES + wofs) = R4; *(uint4*)((nb) + G2_ABYTES + wofs + 64 * G_AST) = R5; *(uint4*)((nb) + G2_ABYTES + wofs + 128 * G_AST) = R6; \
    *(uint4*)((nb) + G2_ABYTES + wofs + 192 * G_AST) = R7; } while (0)

template <bool TR>
DI void gemm256_compute(f32x16 (&acc)[4][2], const unsigned char* As, const unsigned char* Bs) {
  __builtin_amdgcn_s_setprio(2);
  bf16x8 b0 = *(const bf16x8*)(Bs), b1 = *(const bf16x8*)(Bs + 32 * G_AST);
  bf16x8 a0 = *(const bf16x8*)(As), a1 = *(const bf16x8*)(As + 32 * G_AST), a2 = *(const bf16x8*)(As + 64 * G_AST), a3 = *(const bf16x8*)(As + 96 * G_AST);
#pragma unroll
  for (int ks = 0; ks < 4; ++ks) {
    bf16x8 nb0 = b0, nb1 = b1, na0 = a0, na1 = a1, na2 = a2, na3 = a3;
    if (ks < 3) {
      nb0 = *(const bf16x8*)(Bs + (ks + 1) * 32); nb1 = *(const bf16x8*)(Bs + 32 * G_AST + (ks + 1) * 32);
      na0 = *(const bf16x8*)(As + (ks + 1) * 32); na1 = *(const bf16x8*)(As + 32 * G_AST + (ks + 1) * 32);
      na2 = *(const bf16x8*)(As + 64 * G_AST + (ks + 1) * 32); na3 = *(const bf16x8*)(As + 96 * G_AST + (ks + 1) * 32);
    }
    if (TR) {
      acc[0][0] = MFMA16(b0, a0, acc[0][0]); acc[0][1] = MFMA16(b1, a0, acc[0][1]);
      acc[1][0] = MFMA16(b0, a1, acc[1][0]); acc[1][1] = MFMA16(b1, a1, acc[1][1]);
      acc[2][0] = MFMA16(b0, a2, acc[2][0]); acc[2][1] = MFMA16(b1, a2, acc[2][1]);
      acc[3][0] = MFMA16(b0, a3, acc[3][0]); acc[3][1] = MFMA16(b1, a3, acc[3][1]);
    } else {
      acc[0][0] = MFMA16(a0, b0, acc[0][0]); acc[0][1] = MFMA16(a0, b1, acc[0][1]);
      acc[1][0] = MFMA16(a1, b0, acc[1][0]); acc[1][1] = MFMA16(a1, b1, acc[1][1]);
      acc[2][0] = MFMA16(a2, b0, acc[2][0]); acc[2][1] = MFMA16(a2, b1, acc[2][1]);
      acc[3][0] = MFMA16(a3, b0, acc[3][0]); acc[3][1] = MFMA16(a3, b1, acc[3][1]);
    }
    if (ks < 3) {
      __builtin_amdgcn_sched_group_barrier(0x100, 6, 0);
      __builtin_amdgcn_sched_group_barrier(0x008, 8, 0);
    }
    b0 = nb0; b1 = nb1; a0 = na0; a1 = na1; a2 = na2; a3 = na3;
  }
  __builtin_amdgcn_s_setprio(0);
}

template <bool TR = false>
DI void gemm256(f32x16 (&acc)[4][2], const u16* const (&ap)[4], const u16* b0p, int K, unsigned char* lds) {
  const int tid = otid(), lane = tid & 63, w = tid >> 6, r = lane & 31, hh = lane >> 5;
  const int wm = w >> 2, wn = w & 3;
  const int wofs = (tid >> 3) * G_AST + (tid & 7) * 16;
  const u16* a0p = ap[0]; const u16* a1p = ap[1]; const u16* a2p = ap[2]; const u16* a3p = ap[3];
  uint4 R0, R1, R2, R3, R4, R5, R6, R7;
  const int nk = K >> 6;
  const bool late = w >= 4;
  G2_LOADR(0);
  G2_STORER(lds);
  if (late && nk > 1) G2_LOADR(1);
  __syncthreads();
  const unsigned char* As0 = lds + (wm * 128 + r) * G_AST + hh * 16;
  const unsigned char* Bs0 = lds + G2_ABYTES + (wn * 64 + r) * G_AST + hh * 16;
  if (!late) {
    for (int kt = 0; kt < nk; ++kt) {
      const bool more = kt + 1 < nk;
      if (more) G2_LOADR(kt + 1);
      __builtin_amdgcn_sched_barrier(0);
      gemm256_compute<TR>(acc, As0 + (kt & 1) * G2_STAGE, Bs0 + (kt & 1) * G2_STAGE);
      __builtin_amdgcn_sched_barrier(0);
      if (more) G2_STORER(lds + ((kt + 1) & 1) * G2_STAGE);
      __syncthreads();
    }
  } else {
    for (int kt = 0; kt < nk; ++kt) {
      if (kt + 1 < nk) G2_STORER(lds + ((kt + 1) & 1) * G2_STAGE);
      __builtin_amdgcn_sched_barrier(0);
      if (kt + 2 < nk) G2_LOADR(kt + 2);
      __builtin_amdgcn_sched_barrier(0);
      gemm256_compute<TR>(acc, As0 + (kt & 1) * G2_STAGE, Bs0 + (kt & 1) * G2_STAGE);
      __syncthreads();
    }
  }
}
DI void acc_zero4(f32x16 (&acc)[4][2]) {
#pragma unroll
  for (int a = 0; a < 4; ++a)
#pragma unroll
    for (int b = 0; b < 2; ++b)
#pragma unroll
      for (int i = 0; i < 16; ++i) acc[a][b][i] = 0.f;
}

DI void set_ap(const u16* (&ap)[4], const u16* A, int lda, int m0) {
  const int tid = otid();
#pragma unroll
  for (int i = 0; i < 4; ++i) ap[i] = A + (size_t)(m0 + (tid >> 3) + 64 * i) * lda + (tid & 7) * 8;
}
DI void set_bp(const u16* (&bp)[2], const u16* Bt, int ldb, int n0) {
  const int tid = otid();
#pragma unroll
  for (int i = 0; i < 2; ++i) bp[i] = Bt + (size_t)(n0 + (tid >> 3) + 64 * i) * ldb + (tid & 7) * 8;
}

template <class F>
DI void for_tiles(int ntm, int ntn, F f) {
  const int xcd = blockIdx.x & 7, lb = blockIdx.x >> 3, nlb = gridDim.x >> 3;
  const int total = ((ntm + 3) & ~3) * ntn;
  const int chunk = (total + 7) >> 3;
  for (int i = lb; i < chunk; i += nlb) {
    int idx = xcd * chunk + i;
    if (idx >= total) break;
    int panel = idx / (4 * ntn), within = idx - panel * 4 * ntn;
    int n = within >> 2, m = panel * 4 + (within & 3);
    if (m < ntm) f(m, n);
  }
}

DI void g1_phase(const P& p, int l, unsigned char* lds) {
  const u16* H = (const u16*)(p.ws + O_H);
  const u16* Wt = (const u16*)(p.ws + O_WT + l * WL_SIZE + WL_WIN);
  u16* PROJ = (u16*)(p.ws + O_PROJ);
  for_tiles(TA / 256, NC / 256, [&](int tm_, int tn_) {
    int m0 = tm_ * 256, n0 = tn_ * 256;
    const u16* ap[4];
    const int tid0 = otid();
#pragma unroll
    for (int i = 0; i < 4; ++i) ap[i] = H + (size_t)tm_ * 16 * 16384 + tid0 * 8 + i * 4096;
    const u16* b0p = Wt + (size_t)tn_ * 16 * 16384 + tid0 * 8;
    f32x16 acc[4][2]; acc_zero4(acc);
    if (tn_ >= 4 && tn_ < 8) {
      gemm256<true>(acc, ap, b0p, D, lds);
      const int tid = otid(), lane = tid & 63, w = tid >> 6, r = lane & 31, hh = lane >> 5, wm = w >> 2, wn = w & 3;
      const int grp = ((n0 - OFF_Q) >> 6) + wn, g8 = grp & 7;
      const bool isq = grp < 8, lat = tm_ < T / 256;
      const float* gg = p.in[isq ? I_QNG : I_KNG] + l * 64;
      const float post = isq ? (LOG2E * 0.125f) : 1.f;
      u16* dstb = (u16*)(p.ws + (isq ? O_QN : O_KN));
#pragma unroll 1
      for (int mt = 0; mt < 4; ++mt) {
        const int row = m0 + wm * 128 + mt * 32 + r;
        int bb, n, kpos;
        if (lat) { bb = row >> 13; n = row & (L - 1); kpos = n; } else { int rc = row - T; bb = rc >> 8; n = rc & 255; kpos = L + n; }
        f32x16 x0, x1;
        if (mt == 0) { x0 = acc[0][0]; x1 = acc[0][1]; } else if (mt == 1) { x0 = acc[1][0]; x1 = acc[1][1]; }
        else if (mt == 2) { x0 = acc[2][0]; x1 = acc[2][1]; } else { x0 = acc[3][0]; x1 = acc[3][1]; }
        float ss = 0.f;
#pragma unroll
        for (int i = 0; i < 16; ++i) ss += x0[i] * x0[i] + x1[i] * x1[i];
        ss += shx(ss, 32);
        const float rinv = rsqrtf(ss * (1.f / 64.f) + 1e-6f);
#pragma unroll
        for (int i = 0; i < 16; ++i) { x0[i] *= rinv * gg[crow(i, hh)]; x1[i] *= rinv * gg[32 + crow(i, hh)]; }
        if (lat) {
          const float prow = (float)(n >> 6), pcol = (float)(n & 63);
#pragma unroll
          for (int i = 0; i < 8; ++i) {
            const float invt = __builtin_amdgcn_exp2f(-(float)crow(i, hh) * (13.287712379549449f / 16.f)) * 0.15915494309189535f;
            float t0 = prow * invt, t1 = pcol * invt;
            float c0 = cos_t(t0), s0 = sin_t(t0), c1 = cos_t(t1), s1 = sin_t(t1);
            float a0 = x0[i], b0 = x0[i + 8], a1 = x1[i], b1 = x1[i + 8];
            x0[i] = a0 * c0 - b0 * s0; x0[i + 8] = b0 * c0 + a0 * s0;
            x1[i] = a1 * c1 - b1 * s1; x1[i + 8] = b1 * c1 + a1 * s1;
          }
        }
        u16* dst = dstb + ((size_t)(bb * 8 + g8) * LK + kpos) * 64 + 4 * hh;
#pragma unroll
        for (int g4 = 0; g4 < 4; ++g4) {
          *(uint2*)(dst + 8 * g4) = make_uint2(pack2(x0[4 * g4] * post, x0[4 * g4 + 1] * post), pack2(x0[4 * g4 + 2] * post, x0[4 * g4 + 3] * post));
          *(uint2*)(dst + 32 + 8 * g4) = make_uint2(pack2(x1[4 * g4] * post, x1[4 * g4 + 1] * post), pack2(x1[4 * g4 + 2] * post, x1[4 * g4 + 3] * post));
        }
      }
      return;
    }
    gemm256<false>(acc, ap, b0p, D, lds);
    const int tid = otid(), lane = tid & 63, w = tid >> 6, r = lane & 31, hh = lane >> 5, wm = w >> 2, wn = w & 3;
    if (tn_ >= 8 && tn_ < 10) {
      const bool lat = tm_ < T / 256;
      int bb, nbase;
      if (lat) { bb = m0 >> 13; nbase = (m0 & (L - 1)) + wm * 128; } else { int rc = m0 - T; bb = rc >> 8; nbase = L + (rc & 255) + wm * 128; }
      u16* vb = (u16*)(p.ws + O_VT) + ((size_t)bb * 512 + (n0 - OFF_V) + wn * 64 + r) * LK + nbase;
#pragma unroll
      for (int mt = 0; mt < 4; ++mt)
#pragma unroll
        for (int nt = 0; nt < 2; ++nt)
#pragma unroll
          for (int g4 = 0; g4 < 4; ++g4) {
            const int k16 = 8 * (g4 & 1) + 4 * hh;
            const int pk = (k16 == 4) ? 8 : (k16 == 8) ? 4 : k16;
            *(uint2*)(vb + (size_t)nt * 32 * LK + mt * 32 + 16 * (g4 >> 1) + pk) =
                make_uint2(pack2(acc[mt][nt][4 * g4], acc[mt][nt][4 * g4 + 1]), pack2(acc[mt][nt][4 * g4 + 2], acc[mt][nt][4 * g4 + 3]));
          }
      return;
    }
    if (tn_ >= 10) {
      const int br = (tn_ - 10) >> 2, tn2 = ((tn_ - 10) & 3) * 2 + (wn >> 1), wn2 = wn & 1;
      u16* gf = (u16*)(p.ws + O_GF) + (size_t)br * TA * 1024;
#pragma unroll
      for (int mt = 0; mt < 4; ++mt) {
        const int wave2 = (2 * wm + (mt >> 1)) * 2 + wn2, mt2 = mt & 1;
#pragma unroll
        for (int nt = 0; nt < 2; ++nt)
#pragma unroll
          for (int g4 = 0; g4 < 4; ++g4) {
            size_t idx = ((((((size_t)tm_ * 8 + tn2) * 8 + wave2) * 2 + mt2) * 2 + nt) * 4 + g4) * 64 + lane;
            *(uint2*)(gf + idx * 4) = make_uint2(pack2(sigmoidf_(acc[mt][nt][4 * g4]), sigmoidf_(acc[mt][nt][4 * g4 + 1])),
                                                 pack2(sigmoidf_(acc[mt][nt][4 * g4 + 2]), sigmoidf_(acc[mt][nt][4 * g4 + 3])));
          }
      }
    } else if (tn_ < 4 && tm_ < T / 256) {
      const int bb = m0 >> 13, nl = (m0 & (L - 1)) + wm * 128 + 4 * hh;
      u16* zb = (u16*)(p.ws + O_ZT) + ((size_t)bb * 1024 + n0 + wn * 64 + r) * L + nl;
#pragma unroll
      for (int mt = 0; mt < 4; ++mt)
#pragma unroll
        for (int nt = 0; nt < 2; ++nt)
#pragma unroll
          for (int g4 = 0; g4 < 4; ++g4)
            *(uint2*)(zb + (size_t)nt * 32 * L + mt * 32 + 8 * g4) =
                make_uint2(pack2(acc[mt][nt][4 * g4], acc[mt][nt][4 * g4 + 1]), pack2(acc[mt][nt][4 * g4 + 2], acc[mt][nt][4 * g4 + 3]));
    } else {
      u16* pbase = PROJ + (size_t)(m0 + wm * 128 + 4 * hh) * NC + n0 + wn * 64 + r;
#pragma unroll
      for (int mt = 0; mt < 4; ++mt)
#pragma unroll
        for (int nt = 0; nt < 2; ++nt)
#pragma unroll
          for (int i = 0; i < 16; ++i)
            pbase[(size_t)(mt * 32 + 8 * (i >> 2) + (i & 3)) * NC + nt * 32] = f2bf(acc[mt][nt][i]);
    }
  });
}

DI void prep_phase_tiles(const P& p, int l, unsigned char* lds, int job, int) {
  const int tid = otid();
  const u16* PROJ = (const u16*)(p.ws + O_PROJ);
  float2* rt = (float2*)lds;
  u16* vs = (u16*)(lds + 128 * 16 * 8);
  __syncthreads();
  for (int i = tid; i < 128 * 16; i += NT) {
    int pos = i >> 4, f = i & 15;
    float inv = exp2f(-(float)f * (13.287712379549449f / 16.f));
    float turns = (float)pos * inv * 0.15915494309189535f;
    rt[i] = make_float2(cos_t(turns), sin_t(turns));
  }
  const bool lat = job < 512;
  const int b = lat ? (job >> 7) : (job - 512) >> 2;
  const int n0 = lat ? (job & 127) * 64 : ((job - 512) & 3) * 64;
  const int row0 = lat ? b * L + n0 : T + b * LC + n0;
  const int kpos0 = lat ? n0 : L + n0;
#pragma unroll 8
  for (int i = tid; i < 64 * 64; i += NT) {
    int tk = i >> 6, ch = i & 63;
    uint4 v = *(const uint4*)(PROJ + (size_t)(row0 + tk) * NC + OFF_V + ch * 8);
    unsigned* d = (unsigned*)(vs + tk * 514 + ch * 8);
    d[0] = v.x; d[1] = v.y; d[2] = v.z; d[3] = v.w;
  }
  __syncthreads();
  const float* gq = p.in[I_QNG] + l * 64; const float* gk = p.in[I_KNG] + l * 64;
  for (int u = tid; u < 1024; u += NT) {
    int tk = u & 63, grp = u >> 6;
    const uint4* src = (const uint4*)(PROJ + (size_t)(row0 + tk) * NC + OFF_Q + grp * 64);
    float x[64];
#pragma unroll
    for (int i = 0; i < 8; ++i) {
      uint4 v = src[i];
      x[8 * i] = lo16(v.x); x[8 * i + 1] = hi16(v.x); x[8 * i + 2] = lo16(v.y); x[8 * i + 3] = hi16(v.y);
      x[8 * i + 4] = lo16(v.z); x[8 * i + 5] = hi16(v.z); x[8 * i + 6] = lo16(v.w); x[8 * i + 7] = hi16(v.w);
    }
    float ss = 0.f;
#pragma unroll
    for (int i = 0; i < 64; ++i) ss += x[i] * x[i];
    float rinv = rsqrtf(ss * (1.f / 64.f) + 1e-6f);
    const float* g = grp < 8 ? gq : gk;
    const float post = grp < 8 ? (LOG2E * 0.125f) : 1.f;
#pragma unroll
    for (int i = 0; i < 64; ++i) x[i] = x[i] * rinv * g[i];
    if (lat) {
      int n = n0 + tk;
      int prow = n >> 6, pcol = n & 63;
#pragma unroll
      for (int ax = 0; ax < 2; ++ax) {
        int pp = ax == 0 ? prow : pcol;
#pragma unroll
        for (int f = 0; f < 16; ++f) {
          float2 cs = rt[pp * 16 + f];
          float a = x[ax * 32 + f], bq = x[ax * 32 + 16 + f];
          x[ax * 32 + f] = a * cs.x - bq * cs.y;
          x[ax * 32 + 16 + f] = bq * cs.x + a * cs.y;
        }
      }
    }
    int g8 = grp & 7;
    u16* dst = (u16*)(p.ws + (grp < 8 ? O_QN : O_KN)) + ((size_t)(b * 8 + g8) * LK + kpos0 + tk) * 64;
#pragma unroll
    for (int i = 0; i < 8; ++i)
      ((uint4*)dst)[i] = make_uint4(pack2(x[8 * i] * post, x[8 * i + 1] * post), pack2(x[8 * i + 2] * post, x[8 * i + 3] * post),
                                    pack2(x[8 * i + 4] * post, x[8 * i + 5] * post), pack2(x[8 * i + 6] * post, x[8 * i + 7] * post));
  }
  u16* VT = (u16*)(p.ws + O_VT);
  for (int i = tid; i < 512 * 8; i += NT) {
    int he = i >> 3, tc = i & 7;
    u16 v[8];
#pragma unroll
    for (int j = 0; j < 8; ++j) v[j] = vs[(tc * 8 + j) * 514 + he];
    uint4 o = make_uint4(v[0] | ((unsigned)v[1] << 16), v[2] | ((unsigned)v[3] << 16), v[4] | ((unsigned)v[5] << 16), v[6] | ((unsigned)v[7] << 16));
    *(uint4*)(VT + ((size_t)(b * 512 + he)) * LK + kpos0 + tc * 8) = o;
  }
  __syncthreads();
}

DI float zval(const u16* PROJ, size_t rowbase, int n, int col) { return bf2f(PROJ[(rowbase + n) * NC + OFF_HY + col]); }
DI float ztval(const u16* ZT, int b, int n, int col) { return bf2f(ZT[((size_t)b * 1024 + OFF_HY + col) * L + n]); }

DI void hyena_lat_item(const P& p, int l, int c, int bp, unsigned char* lds) {
  const int tid = otid();
  const u16* PROJ = (const u16*)(p.ws + O_PROJ);
  float2* s = (float2*)lds;
  float2* scr = (float2*)(p.ws + O_HYSCR) + (size_t)blockIdx.x * 4 * 8192;
  const u16* ZT = (const u16*)(p.ws + O_ZT);
  const float* cw = p.in[I_HCW] + l * 3 * 768; const float* cb = p.in[I_HCB] + l * 768;
  float w[3][3], bs[3];
#pragma unroll
  for (int k = 0; k < 3; ++k) { bs[k] = cb[k * 256 + c];
#pragma unroll
    for (int j = 0; j < 3; ++j) w[k][j] = cw[j * 768 + k * 256 + c]; }
  const size_t rb0 = (size_t)(2 * bp) * L, rb1 = rb0 + L;
  __syncthreads();
#pragma unroll 1
  for (int ch = 0; ch < 2; ++ch) {
    const int n0 = ch * 4096 + tid * 8;
    float o[3][2][8];
#pragma unroll
    for (int k = 0; k < 3; ++k)
#pragma unroll
      for (int bq = 0; bq < 2; ++bq) {
        const u16* zr = ZT + ((size_t)(2 * bp + bq) * 1024 + OFF_HY + k * 256 + c) * L;
        uint4 v = *(const uint4*)(zr + n0);
        float x[10];
        x[0] = n0 > 0 ? bf2f(zr[n0 - 1]) : 0.f;
        x[9] = n0 + 8 < L ? bf2f(zr[n0 + 8]) : 0.f;
        x[1] = lo16(v.x); x[2] = hi16(v.x); x[3] = lo16(v.y); x[4] = hi16(v.y); x[5] = lo16(v.z); x[6] = hi16(v.z); x[7] = lo16(v.w); x[8] = hi16(v.w);
#pragma unroll
        for (int e = 0; e < 8; ++e) o[k][bq][e] = bs[k] + w[k][0] * x[e] + w[k][1] * x[e + 1] + w[k][2] * x[e + 2];
      }
#pragma unroll
    for (int e = 0; e < 8; ++e) {
      int n = n0 + e;
      s[phys(n)] = make_float2(o[0][0][e], o[0][1][e]);
      s[phys(n + L)] = make_float2(0.f, 0.f);
      scr[n] = make_float2(o[0][0][e], o[0][1][e]);
      scr[8192 + n] = make_float2(o[1][0][e], o[1][1][e]);
      scr[16384 + n] = make_float2(o[2][0][e], o[2][1][e]);
    }
  }
  const float invN = 1.f / 16384.f;
  for (int ord = 0; ord < 2; ++ord) {
    fft_lds<16384, false>(s);
    const float2* H = (const float2*)(p.ws + O_SPEC) + ((size_t)(l * 2 + ord) * 256 + c) * 16384;
#pragma unroll 8
    for (int i = tid; i < 16384; i += NT) { s[phys(i)] = cmul(s[phys(i)], H[i]); }
    fft_lds<16384, true>(s);
    const float bias = p.in[I_HBIAS][l * 512 + ord * 256 + c];
    if (ord == 0) {
      float2 y1v[16];
#pragma unroll
      for (int i = 0; i < 16; ++i) {
        int n = (i >> 3) * 4096 + tid * 8 + (i & 7);
        float2 cv = s[phys(n)], v = scr[n], x1 = scr[8192 + n];
        y1v[i] = make_float2(x1.x * (cv.x * invN + v.x * bias), x1.y * (cv.y * invN + v.y * bias));
        scr[24576 + n] = y1v[i];
      }
      __syncthreads();
#pragma unroll
      for (int i = 0; i < 16; ++i) { int n = (i >> 3) * 4096 + tid * 8 + (i & 7); s[phys(n)] = y1v[i]; s[phys(n + L)] = make_float2(0.f, 0.f); }
    } else {
      u16* HYT = (u16*)(p.ws + O_HYT);
#pragma unroll
      for (int ch = 0; ch < 2; ++ch) {
        float r0[8], r1[8];
#pragma unroll
        for (int e = 0; e < 8; ++e) {
          int n = ch * 4096 + tid * 8 + e;
          float2 cv = s[phys(n)], y1 = scr[24576 + n], x2 = scr[16384 + n];
          r0[e] = x2.x * (cv.x * invN + y1.x * bias);
          r1[e] = x2.y * (cv.y * invN + y1.y * bias);
        }
        *(uint4*)(HYT + ((size_t)(2 * bp) * 256 + c) * L + ch * 4096 + tid * 8) = make_uint4(pack2(r0[0], r0[1]), pack2(r0[2], r0[3]), pack2(r0[4], r0[5]), pack2(r0[6], r0[7]));
        *(uint4*)(HYT + ((size_t)(2 * bp + 1) * 256 + c) * L + ch * 4096 + tid * 8) = make_uint4(pack2(r1[0], r1[1]), pack2(r1[2], r1[3]), pack2(r1[4], r1[5]), pack2(r1[6], r1[7]));
      }
    }
  }
  __syncthreads();
}

DI void fourier_lat_item(const P& p, int b, int g, int m, unsigned char* lds) {
  const int tid = otid();
  const u16* PROJ = (const u16*)(p.ws + O_PROJ);
  float2* s = (float2*)lds;
  float2* tw = (float2*)(lds + 17408 * 8);
  __syncthreads();
  if (tid < 64) { float f = (float)tid * (1.f / 64.f); tw[tid] = make_float2(cos_t(f), -sin_t(f)); }
  __syncthreads();
  {
    const u16* ZT = (const u16*)(p.ws + O_ZT) + ((size_t)b * 1024 + g * 64) * L + tid * 8;
    float re[16], im[16];
#pragma unroll
    for (int i = 0; i < 16; ++i) { re[i] = 0.f; im[i] = 0.f; }
#pragma unroll 8
    for (int j = 0; j < 64; ++j) {
      float2 t = tw[(m * j) & 63];
#pragma unroll
      for (int c = 0; c < 2; ++c) {
        uint4 v = *(const uint4*)(ZT + (size_t)j * L + c * 4096);
        float x[8] = {lo16(v.x), hi16(v.x), lo16(v.y), hi16(v.y), lo16(v.z), hi16(v.z), lo16(v.w), hi16(v.w)};
#pragma unroll
        for (int e = 0; e < 8; ++e) { re[c * 8 + e] += x[e] * t.x; im[c * 8 + e] += x[e] * t.y; }
      }
    }
#pragma unroll
    for (int i = 0; i < 16; ++i) s[phys((i >> 3) * 4096 + tid * 8 + (i & 7))] = make_float2(re[i], im[i]);
  }
  fft_lds<8192, false>(s);
  u16* FMT = (u16*)(p.ws + O_FMT) + ((size_t)b * 256 + g * 64) * L;
  const float sc = 0.0013810679320049757f;
  const bool mirror = (m >= 1 && m <= 31);
#pragma unroll
  for (int ch = 0; ch < 2; ++ch) {
    const int k0 = ch * 4096 + tid * 8;
    float v[8], vm[8];
#pragma unroll
    for (int e = 0; e < 8; ++e) {
      int k = k0 + e;
      v[e] = s[phys((int)(__brev((unsigned)k) >> 19))].x * sc;
      vm[e] = s[phys((int)(__brev((unsigned)((L - k) & (L - 1))) >> 19))].x * sc;
    }
    *(uint4*)(FMT + (size_t)m * L + k0) = make_uint4(pack2(v[0], v[1]), pack2(v[2], v[3]), pack2(v[4], v[5]), pack2(v[6], v[7]));
    if (mirror) *(uint4*)(FMT + (size_t)(64 - m) * L + k0) = make_uint4(pack2(vm[0], vm[1]), pack2(vm[2], vm[3]), pack2(vm[4], vm[5]), pack2(vm[6], vm[7]));
  }
  __syncthreads();
}

DI void transpose_job(const P& p, int job, unsigned char* lds) {
  const int tid = otid();
  const int which = job >> 9, b = (job >> 7) & 3, nt = job & 127;
  const u16* src = (const u16*)(p.ws + (which ? O_HYT : O_FMT)) + (size_t)b * 256 * L + nt * 64;
  u16* dst = (u16*)(p.ws + (which ? O_HY : O_FM)) + ((size_t)b * L + nt * 64) * 256;
  u16* sm = (u16*)lds;
  __syncthreads();
  {
    const int c = tid >> 1, half = tid & 1;
    const uint4* sp = (const uint4*)(src + (size_t)c * L + half * 32);
#pragma unroll
    for (int q = 0; q < 4; ++q) {
      uint4 v = sp[q];
      unsigned wds[4] = {v.x, v.y, v.z, v.w};
#pragma unroll
      for (int e = 0; e < 4; ++e) {
        int n = half * 32 + q * 8 + 2 * e;
        sm[n * 264 + c] = (u16)(wds[e] & 0xffffu);
        sm[(n + 1) * 264 + c] = (u16)(wds[e] >> 16);
      }
    }
  }
  __syncthreads();
#pragma unroll
  for (int i = 0; i < 4; ++i) {
    int id = tid + NT * i, n = id >> 5, cc = id & 31;
    uint4 v = *(const uint4*)(sm + n * 264 + cc * 8);
    *(uint4*)(dst + (size_t)n * 256 + cc * 8) = v;
  }
}

DI void fourier_ctx_item(const P& p, int b, int g, int mc, unsigned char* lds) {
  const int tid = otid();
  const u16* PROJ = (const u16*)(p.ws + O_PROJ);
  float* u = (float*)lds;
  float2* ab = (float2*)(lds + 256 * 65 * 4);
  float2* tw64 = ab + 256 * 16;
  float2* tw256 = tw64 + 64;
  __syncthreads();
  if (tid < 64) { float f = (float)tid * (1.f / 64.f); tw64[tid] = make_float2(cos_t(f), -sin_t(f)); }
  if (tid < 256) { float f = (float)tid * (1.f / 256.f); tw256[tid] = make_float2(cos_t(f), -sin_t(f)); }
  for (int i = tid; i < 256 * 64; i += NT) { int n = i >> 6, j = i & 63; u[n * 65 + j] = bf2f(PROJ[(size_t)(T + b * LC + n) * NC + g * 64 + j]); }
  __syncthreads();
  for (int i = tid; i < 256 * 16; i += NT) {
    int n = i >> 4, mm = i & 15, m = mc * 16 + mm;
    float re = 0.f, im = 0.f;
    for (int j = 0; j < 64; ++j) { float2 t = tw64[(m * j) & 63]; float x = u[n * 65 + j]; re += x * t.x; im += x * t.y; }
    ab[n * 16 + mm] = make_float2(re, im);
  }
  __syncthreads();
  u16* FM = (u16*)(p.ws + O_FM);
  for (int i = tid; i < 256 * 16; i += NT) {
    int k = i >> 4, mm = i & 15;
    float y = 0.f;
    for (int n = 0; n < 256; ++n) { float2 t = tw256[(k * n) & 255]; float2 z = ab[n * 16 + mm]; y += z.x * t.x - z.y * t.y; }
    FM[(size_t)(T + b * LC + k) * 256 + g * 64 + mc * 16 + mm] = f2bf(y * (1.f / 128.f));
  }
  __syncthreads();
}

DI void hyena_ctx_item(const P& p, int l, int c, unsigned char* lds) {
  const int tid = otid();
  const u16* PROJ = (const u16*)(p.ws + O_PROJ);
  float* f0 = (float*)lds; float* f1 = f0 + 512; float* sv = f1 + 512;
  const float* FC = (const float*)(p.ws + O_FILTC);
  __syncthreads();
  f0[tid] = FC[(size_t)(0 * 256 + c) * 512 + tid];
  f1[tid] = FC[(size_t)(1 * 256 + c) * 512 + tid];
  const float* cw = p.in[I_HCW] + l * 3 * 768; const float* cb = p.in[I_HCB] + l * 768;
  const float bias0 = p.in[I_HBIAS][l * 512 + c], bias1 = p.in[I_HBIAS][l * 512 + 256 + c];
  const int bb = tid >> 8, t = tid & 255;
  u16* HY = (u16*)(p.ws + O_HY);
  for (int pass = 0; pass < 2; ++pass) {
    int b = pass * 2 + bb;
    size_t rb = (size_t)T + b * LC;
    float o[3];
#pragma unroll
    for (int k = 0; k < 3; ++k) {
      int col = k * 256 + c; float a = cb[col];
#pragma unroll
      for (int j = 0; j < 3; ++j) { int nn = t + j - 1; if (nn >= 0 && nn < LC) a += cw[j * 768 + col] * zval(PROJ, rb, nn, col); }
      o[k] = a;
    }
    __syncthreads();
    sv[bb * 256 + t] = o[0];
    __syncthreads();
    float a = 0.f;
    for (int s2 = 0; s2 < 256; ++s2) a += f0[(t - s2) & 511] * sv[bb * 256 + s2];
    float y1 = o[1] * (a + o[0] * bias0);
    __syncthreads();
    sv[bb * 256 + t] = y1;
    __syncthreads();
    float a2 = 0.f;
    for (int s2 = 0; s2 < 256; ++s2) a2 += f1[(t - s2) & 511] * sv[bb * 256 + s2];
    HY[(rb + t) * 256 + c] = f2bf(o[2] * (a2 + y1 * bias1));
  }
  __syncthreads();
}

#ifndef ATT_KT_PRAGMA
#define ATT_KT_PRAGMA _Pragma("unroll 1")
#endif
#ifndef ATT_SB
#define ATT_SB __builtin_amdgcn_sched_barrier(0)
#endif
constexpr int AT_KB = 64 * G_AST, AT_VB = 128 * G_AST, AT_STAGE = 2 * AT_KB + AT_VB;

DI void attn_item(const P& p, int l, int b, int h, int qpos0, int key0, int nkeys, int out_row0, unsigned char* lds,
                  float lam, float lam_init) {
  const int tid = otid(), lane = tid & 63, w = tid >> 6, r = lane & 31, hh = lane >> 5;
  const u16* QN = (const u16*)(p.ws + O_QN) + (size_t)(b * 8 + h * 2) * LK * 64;
  const u16* KN = (const u16*)(p.ws + O_KN) + (size_t)(b * 8 + h * 2) * LK * 64;
  const u16* VT = (const u16*)(p.ws + O_VT) + (size_t)(b * 512 + h * 128) * LK;
  unsigned char* qs = lds + 2 * AT_STAGE + w * (64 * G_AST);
  __syncthreads();
#pragma unroll
  for (int i = 0; i < 8; ++i) {
    int id = lane + 64 * i, m = id >> 8, row = (id >> 3) & 31, ch = id & 7;
    uint4 v = *(const uint4*)(QN + (size_t)m * LK * 64 + (size_t)(qpos0 + w * 32 + row) * 64 + ch * 8);
    *(uint4*)(qs + (m * 32 + row) * G_AST + ch * 16) = v;
  }
  const unsigned char* qrd = qs + r * G_AST + hh * 16;
  f32x16 O[2][4];
#pragma unroll
  for (int m = 0; m < 2; ++m)
#pragma unroll
    for (int vt = 0; vt < 4; ++vt)
#pragma unroll
      for (int i = 0; i < 16; ++i) O[m][vt][i] = 0.f;
  float lsum[2] = {0.f, 0.f};
  const int ntiles = nkeys >> 6;
  const u16* kbase0 = KN + (size_t)key0 * 64;
  const u16* vbase0 = VT + key0;
  {
    const unsigned koff = tid * 8;
    const unsigned voff = (tid >> 3) * LK + (tid & 7) * 8;
    const int kw = (tid >> 3) * G_AST + (tid & 7) * 16;
    uint4 rk0 = *(const uint4*)(kbase0 + koff), rk1 = *(const uint4*)(kbase0 + (size_t)LK * 64 + koff);
    uint4 rv0 = *(const uint4*)(vbase0 + voff), rv1 = *(const uint4*)(vbase0 + (size_t)64 * LK + voff);
    __syncthreads();
    *(uint4*)(lds + kw) = rk0; *(uint4*)(lds + AT_KB + kw) = rk1;
    *(uint4*)(lds + 2 * AT_KB + kw) = rv0; *(uint4*)(lds + 2 * AT_KB + 64 * G_AST + kw) = rv1;
  }
  __syncthreads();
  for (int t = 0; t < ntiles; ++t) {
    const bool more = t + 1 < ntiles;
    const unsigned char* st = lds + (t & 1) * AT_STAGE;
    uint4 rk0, rk1, rv0, rv1;
    if (more) {
      const int tid2 = otid();
      const unsigned koff = tid2 * 8, voff = (tid2 >> 3) * LK + (tid2 & 7) * 8;
      const u16* kb_ = kbase0 + (size_t)(t + 1) * 4096;
      const u16* vb_ = vbase0 + (t + 1) * 64;
      rk0 = *(const uint4*)(kb_ + koff); rk1 = *(const uint4*)(kb_ + (size_t)LK * 64 + koff);
      rv0 = *(const uint4*)(vb_ + voff); rv1 = *(const uint4*)(vb_ + (size_t)64 * LK + voff);
    }
    __builtin_amdgcn_sched_barrier(0);
ATT_KT_PRAGMA
    for (int kt = 0; kt < 2; ++kt) {
      {
        const unsigned char* kb = st + (kt * 32 + r) * G_AST + hh * 16;
        const unsigned char* vb = st + 2 * AT_KB + r * G_AST + (kt * 32 + 8 * hh) * 2;
        f32x16 S0, S1;
#pragma unroll
        for (int i = 0; i < 16; ++i) { S0[i] = 0.f; S1[i] = 0.f; }
        bf16x8 k0 = *(const bf16x8*)(kb), k1 = *(const bf16x8*)(kb + 32), k2 = *(const bf16x8*)(kb + 64), k3 = *(const bf16x8*)(kb + 96);
        bf16x8 q0 = *(const bf16x8*)(qrd), q1 = *(const bf16x8*)(qrd + 32), q2 = *(const bf16x8*)(qrd + 64), q3 = *(const bf16x8*)(qrd + 96);
        __builtin_amdgcn_sched_barrier(0);
        S0 = MFMA16(k0, q0, S0); S0 = MFMA16(k1, q1, S0); S0 = MFMA16(k2, q2, S0); S0 = MFMA16(k3, q3, S0);
        __builtin_amdgcn_sched_barrier(0);
        k0 = *(const bf16x8*)(kb + AT_KB); k1 = *(const bf16x8*)(kb + AT_KB + 32);
        q0 = *(const bf16x8*)(qrd + 32 * G_AST); q1 = *(const bf16x8*)(qrd + 32 * G_AST + 32);
        S1 = MFMA16(k0, q0, S1); S1 = MFMA16(k1, q1, S1);
        k0 = *(const bf16x8*)(kb + AT_KB + 64); k1 = *(const bf16x8*)(kb + AT_KB + 96);
        q0 = *(const bf16x8*)(qrd + 32 * G_AST + 64); q1 = *(const bf16x8*)(qrd + 32 * G_AST + 96);
        S1 = MFMA16(k0, q0, S1); S1 = MFMA16(k1, q1, S1);
        float ls0 = 0.f;
#pragma unroll
        for (int i = 0; i < 16; ++i) { S0[i] = __builtin_amdgcn_exp2f(S0[i]); ls0 += S0[i]; }
        lsum[0] += ls0;
        bf16x8 pa0 = __builtin_bit_cast(bf16x8, make_uint4(pack2(S0[0], S0[1]), pack2(S0[2], S0[3]), pack2(S0[4], S0[5]), pack2(S0[6], S0[7])));
        bf16x8 pb0 = __builtin_bit_cast(bf16x8, make_uint4(pack2(S0[8], S0[9]), pack2(S0[10], S0[11]), pack2(S0[12], S0[13]), pack2(S0[14], S0[15])));
        __builtin_amdgcn_sched_barrier(0);
        bf16x8 v0 = *(const bf16x8*)(vb), v1 = *(const bf16x8*)(vb + 32 * G_AST), v2 = *(const bf16x8*)(vb + 64 * G_AST), v3 = *(const bf16x8*)(vb + 96 * G_AST);
        O[0][0] = MFMA16(v0, pa0, O[0][0]); O[0][1] = MFMA16(v1, pa0, O[0][1]); O[0][2] = MFMA16(v2, pa0, O[0][2]); O[0][3] = MFMA16(v3, pa0, O[0][3]);
        float ls1 = 0.f;
#pragma unroll
        for (int i = 0; i < 16; ++i) { S1[i] = __builtin_amdgcn_exp2f(S1[i]); ls1 += S1[i]; }
        lsum[1] += ls1;
        bf16x8 pa1 = __builtin_bit_cast(bf16x8, make_uint4(pack2(S1[0], S1[1]), pack2(S1[2], S1[3]), pack2(S1[4], S1[5]), pack2(S1[6], S1[7])));
        bf16x8 pb1 = __builtin_bit_cast(bf16x8, make_uint4(pack2(S1[8], S1[9]), pack2(S1[10], S1[11]), pack2(S1[12], S1[13]), pack2(S1[14], S1[15])));
        __builtin_amdgcn_sched_barrier(0);
        bf16x8 w0 = *(const bf16x8*)(vb + 32), w1 = *(const bf16x8*)(vb + 32 * G_AST + 32), w2 = *(const bf16x8*)(vb + 64 * G_AST + 32), w3 = *(const bf16x8*)(vb + 96 * G_AST + 32);
        O[0][0] = MFMA16(w0, pb0, O[0][0]); O[0][1] = MFMA16(w1, pb0, O[0][1]); O[0][2] = MFMA16(w2, pb0, O[0][2]); O[0][3] = MFMA16(w3, pb0, O[0][3]);
        O[1][0] = MFMA16(v0, pa1, O[1][0]); O[1][1] = MFMA16(v1, pa1, O[1][1]); O[1][2] = MFMA16(v2, pa1, O[1][2]); O[1][3] = MFMA16(v3, pa1, O[1][3]);
        O[1][0] = MFMA16(w0, pb1, O[1][0]); O[1][1] = MFMA16(w1, pb1, O[1][1]); O[1][2] = MFMA16(w2, pb1, O[1][2]); O[1][3] = MFMA16(w3, pb1, O[1][3]);
        ATT_SB;
      }
    }
    if (more) {
      const int tid3 = otid();
      const int kw = (tid3 >> 3) * G_AST + (tid3 & 7) * 16;
      unsigned char* nb = lds + ((t + 1) & 1) * AT_STAGE;
      *(uint4*)(nb + kw) = rk0; *(uint4*)(nb + AT_KB + kw) = rk1;
      *(uint4*)(nb + 2 * AT_KB + kw) = rv0; *(uint4*)(nb + 2 * AT_KB + 64 * G_AST + kw) = rv1;
    }
    __syncthreads();
  }
  float l0 = lsum[0] + shx(lsum[0], 32), l1 = lsum[1] + shx(lsum[1], 32);
  float i0 = 1.f / l0, i1 = lam / l1;
  float ssq = 0.f;
#pragma unroll
  for (int vt = 0; vt < 4; ++vt)
#pragma unroll
    for (int i = 0; i < 16; ++i) { float o = O[0][vt][i] * i0 - O[1][vt][i] * i1; O[0][vt][i] = o; ssq += o * o; }
  ssq += shx(ssq, 32);
  float rn = rsqrtf(ssq * (1.f / 128.f) + 1e-5f) * (1.f - lam_init);
  const float* sg = p.in[I_SUBG] + l * 128;
  u16* OO = (u16*)(p.ws + O_O) + (size_t)(out_row0 + w * 32 + r) * 512 + h * 128;
#pragma unroll
  for (int vt = 0; vt < 4; ++vt)
#pragma unroll
    for (int g4 = 0; g4 < 4; ++g4) {
      int e0 = 32 * vt + 8 * g4 + 4 * hh;
      float4 gv = *(const float4*)(sg + e0);
      *(uint2*)(OO + e0) = make_uint2(pack2(O[0][vt][4 * g4] * rn * gv.x, O[0][vt][4 * g4 + 1] * rn * gv.y),
                                      pack2(O[0][vt][4 * g4 + 2] * rn * gv.z, O[0][vt][4 * g4 + 3] * rn * gv.w));
    }
}

DI void attn_phase(const P& p, int l, unsigned char* lds) {
  const int lane = otid() & 63;
  float s0 = p.in[I_LAMQ][l * 128 + lane] * p.in[I_LAMK][l * 128 + lane];
  float s1 = p.in[I_LAMQ][l * 128 + 64 + lane] * p.in[I_LAMK][l * 128 + 64 + lane];
  s0 = wave_sum(s0); s1 = wave_sum(s1);
  const float lam_init = lam_init_of(l);
  const float lam = __expf(s0) - __expf(s1) + lam_init;
  const int n_lat = NB * 4 * (L / 256), n_ctx = (l == 0) ? NB * 4 : 0, n_att = n_lat + n_ctx;
  const int n_hy = 512, n_fm = 16 * 33, n_fc = (l == 0) ? 64 : 0, n_hc = (l == 0) ? 256 : 0;
  const int total = n_att + n_hy + n_fm + n_fc + n_hc;
  for (int it = blockIdx.x; it < total; it += gridDim.x) {
    int k = it;
    if (k < n_att) {
      int b, h, qpos0, key0, nkeys, orow;
      if (k < n_lat) { int qb = k & 31, bh = k >> 5; b = bh >> 2; h = bh & 3; qpos0 = qb * 256; key0 = 0; nkeys = LK; orow = b * L + qb * 256; }
      else { int bh = k - n_lat; b = bh >> 2; h = bh & 3; qpos0 = L; key0 = L; nkeys = LC; orow = T + b * LC; }
      attn_item(p, l, b, h, qpos0, key0, nkeys, orow, lds, lam, lam_init);
      continue;
    }
    k -= n_att;
    if (k < n_hy) { hyena_lat_item(p, l, k >> 1, k & 1, lds); continue; }
    k -= n_hy;
    if (k < n_fm) { int bg = k / 33; fourier_lat_item(p, bg >> 2, bg & 3, k % 33, lds); continue; }
    k -= n_fm;
    if (k < n_fc) { fourier_ctx_item(p, k >> 4, (k >> 2) & 3, k & 3, lds); continue; }
    k -= n_fc;
    hyena_ctx_item(p, l, k, lds);
  }
}

DI void transpose_phase(const P& p, unsigned char* lds) {
  for (int it = blockIdx.x; it < 1024; it += gridDim.x) transpose_job(p, it, lds);
}

DI void merge_phase(const P& p, int l, int rows, unsigned char* lds) {
  u16* MG = (u16*)(p.ws + O_MERGED);
  const unsigned char* WL = p.ws + O_WT + l * WL_SIZE;
  const int tid = otid(), lane = tid & 63, w = tid >> 6, r = lane & 31, hh = lane >> 5, wm = w >> 1, wn = w & 1;
  for_tiles(rows / 256, D / 128, [&](int tm_, int tn_) {
    int m0 = tm_ * 256, n0 = tn_ * 128;
    f32x16 tot[2][2]; acc_zero(tot);
#pragma unroll 1
    for (int br = 0; br < 3; ++br) {
      const u16* A = (const u16*)(p.ws + (br == 0 ? O_FM : br == 1 ? O_HY : O_O));
      const int K = br == 2 ? 512 : 256;
      const u16* Wt = (const u16*)(WL + (br == 0 ? WL_WF : br == 1 ? WL_WH : WL_WA));
      const u16* ap[4]; const u16* bp[2];
      set_ap(ap, A, K, m0); set_bp(bp, Wt, K, n0);
      f32x16 acc[2][2]; acc_zero(acc);
      gemm_main(acc, ap, bp, K, lds);
      size_t fb = ((((size_t)tm_ * 8 + tn_) * 8 + w) * 16) * 64 + lane;
      asm volatile("" : "+v"(fb));
      const u16* gf = (const u16*)(p.ws + O_GF) + (size_t)br * TA * 1024;
#pragma unroll
      for (int mt = 0; mt < 2; ++mt)
#pragma unroll
        for (int nt = 0; nt < 2; ++nt)
#pragma unroll
          for (int g4 = 0; g4 < 4; ++g4) {
            uint2 gv = *(const uint2*)(gf + (fb + (size_t)(((mt * 2 + nt) * 4 + g4) * 64)) * 4);
            tot[mt][nt][4 * g4] += lo16(gv.x) * acc[mt][nt][4 * g4];
            tot[mt][nt][4 * g4 + 1] += hi16(gv.x) * acc[mt][nt][4 * g4 + 1];
            tot[mt][nt][4 * g4 + 2] += lo16(gv.y) * acc[mt][nt][4 * g4 + 2];
            tot[mt][nt][4 * g4 + 3] += hi16(gv.y) * acc[mt][nt][4 * g4 + 3];
          }
    }
    u16* pm = MG + (size_t)(m0 + wm * 64 + 4 * hh) * D + n0 + wn * 64 + r;
#pragma unroll
    for (int mt = 0; mt < 2; ++mt)
#pragma unroll
      for (int nt = 0; nt < 2; ++nt)
#pragma unroll
        for (int i = 0; i < 16; ++i)
          pm[(size_t)(mt * 32 + 8 * (i >> 2) + (i & 3)) * D + nt * 32] = f2bf(tot[mt][nt][i]);
  });
}

DI void wo_phase(const P& p, int l, int rows, unsigned char* lds) {
  const u16* MG = (const u16*)(p.ws + O_MERGED);
  const u16* Wt = (const u16*)(p.ws + O_WT + l * WL_SIZE + WL_WO);
  float* XA = (float*)(p.ws + O_XA);
  const float* MOD = (const float*)(p.ws + O_MOD) + l * 5 * 6144;
  const int lane = otid() & 63, w = otid() >> 6, r = lane & 31, hh = lane >> 5, wm = w >> 1, wn = w & 1;
  for_tiles(rows / 256, D / 128, [&](int tm_, int tn_) {
    int m0 = tm_ * 256, n0 = tn_ * 128;
    const u16* ap[4]; const u16* bp[2];
    set_ap(ap, MG, D, m0); set_bp(bp, Wt, D, n0);
    f32x16 acc[2][2]; acc_zero(acc);
    gemm_main(acc, ap, bp, D, lds);
#pragma unroll
    for (int mt = 0; mt < 2; ++mt)
#pragma unroll
      for (int nt = 0; nt < 2; ++nt)
#pragma unroll
        for (int i = 0; i < 16; ++i) {
          int row = m0 + wm * 64 + mt * 32 + crow(i, hh), col = n0 + wn * 64 + nt * 32 + r;
          float xin;
          if (l == 0) xin = row < T ? p.in[I_X][(size_t)row * D + col] : p.in[I_CTX][(size_t)(row - T) * D + col];
          else xin = XA[(size_t)row * D + col];
          int mr = row < T ? (row >> 13) : 4;
          XA[(size_t)row * D + col] = xin + MOD[mr * 6144 + 2 * 1024 + col] * acc[mt][nt][i];
        }
  });
}

DI void router_phase(const P& p, int l, int ntok, unsigned char* lds) {
  const int tid = otid(), lane = tid & 63, w = tid >> 6, r = lane & 31, hh = lane >> 5;
  float* tile = (float*)lds;
  int* lcnt = (int*)(lds + 32 * 1025 * 4);
  const float* XA = (const float*)(p.ws + O_XA);
  const float* MOD = (const float*)(p.ws + O_MOD) + l * 5 * 6144;
  u16* H = (u16*)(p.ws + O_H);
  const float* wr = p.in[I_WR] + (size_t)l * 1024 * 32;
  const float* br = p.in[I_BR] + l * 32;
  int* TOKE = (int*)(p.ws + O_TOKE); float* TOKG = (float*)(p.ws + O_TOKG); int* TOKLP = (int*)(p.ws + O_TOKLP);
  const int per = ntok / gridDim.x;
  const int tbase = blockIdx.x * per;
  __syncthreads();
  if (tid < 32) lcnt[tid] = 0;
  __syncthreads();
  for (int c0 = 0; c0 < per; c0 += 32) {
#pragma unroll 2
    for (int q = 0; q < 4; ++q) {
      int tl = w * 4 + q;
      int tok = tbase + c0 + tl;
      bool valid = (c0 + tl) < per;
      if (!valid) tok = tbase;
      const float* xr = XA + (size_t)tok * D;
      int mr = tok < T ? (tok >> 13) : 4;
      float xv[16];
#pragma unroll
      for (int i = 0; i < 4; ++i) { float4 v = *(const float4*)(xr + (i * 64 + lane) * 4); xv[4 * i] = v.x; xv[4 * i + 1] = v.y; xv[4 * i + 2] = v.z; xv[4 * i + 3] = v.w; }
      float ss = 0.f;
#pragma unroll
      for (int i = 0; i < 16; ++i) ss += xv[i] * xv[i];
      ss = wave_sum(ss);
      float rinv = rsqrtf(ss * (1.f / 1024.f) + 1e-6f);
      const float* g = p.in[I_N2G] + l * 1024; const float* sh = MOD + mr * 6144 + 3 * 1024; const float* sc = MOD + mr * 6144 + 4 * 1024;
#pragma unroll
      for (int i = 0; i < 4; ++i) {
        int c = (i * 64 + lane) * 4;
        float4 gv = *(const float4*)(g + c), shv = *(const float4*)(sh + c), scv = *(const float4*)(sc + c);
        float h0 = xv[4 * i] * rinv * gv.x * (1.f + scv.x) + shv.x;
        float h1 = xv[4 * i + 1] * rinv * gv.y * (1.f + scv.y) + shv.y;
        float h2 = xv[4 * i + 2] * rinv * gv.z * (1.f + scv.z) + shv.z;
        float h3 = xv[4 * i + 3] * rinv * gv.w * (1.f + scv.w) + shv.w;
        float* tr = tile + tl * 1025 + c;
        tr[0] = h0; tr[1] = h1; tr[2] = h2; tr[3] = h3;
        if (valid) *(uint2*)(H + boff(tok, c, 1024)) = make_uint2(pack2(h0, h1), pack2(h2, h3));
      }
    }
    __syncthreads();
    f32x16 acc;
#pragma unroll
    for (int i = 0; i < 16; ++i) acc[i] = 0.f;
    {
      const float* ar = tile + r * 1025 + w * 128 + hh;
      const float* brp = wr + (size_t)(w * 128 + hh) * 32 + r;
#pragma unroll 8
      for (int s2 = 0; s2 < 64; ++s2) acc = __builtin_amdgcn_mfma_f32_32x32x2f32(ar[2 * s2], brp[(size_t)2 * s2 * 32], acc, 0, 0, 0);
    }
    __syncthreads();
    float* part = tile;
#pragma unroll
    for (int i = 0; i < 16; ++i) part[(w * 32 + crow(i, hh)) * 33 + r] = acc[i];
    __syncthreads();
#pragma unroll
    for (int q = 0; q < 4; ++q) {
      int tl = w * 4 + q;
      int tok = tbase + c0 + tl;
      bool valid = (c0 + tl) < per;
      float v = br[r];
#pragma unroll
      for (int k = 0; k < 8; ++k) v += part[(k * 32 + tl) * 33 + r];
      int se[4]; float sv[4];
#pragma unroll
      for (int k = 0; k < 4; ++k) {
        float m = wave_max(v);
        unsigned long long mask = __ballot(v == m);
        int idx = __ffsll((long long)mask) - 1;
        se[k] = idx & 31; sv[k] = m;
        if (r == (idx & 31)) v = -3.0e38f;
      }
      float e1 = __expf(sv[1] - sv[0]), e2 = __expf(sv[2] - sv[0]), e3 = __expf(sv[3] - sv[0]);
      float inv = 1.f / (1.f + e1 + e2 + e3);
      if (valid && lane < 4) {
        int e = lane == 0 ? se[0] : lane == 1 ? se[1] : lane == 2 ? se[2] : se[3];
        float gt = (lane == 0 ? 1.f : lane == 1 ? e1 : lane == 2 ? e2 : e3) * inv;
        int lp = atomicAdd(&lcnt[e], 1);
        TOKE[tok * 4 + lane] = e; TOKG[tok * 4 + lane] = gt; TOKLP[tok * 4 + lane] = lp;
      }
    }
    __syncthreads();
  }
  if (tid < 32) ((int*)(p.ws + O_CNT))[blockIdx.x * 32 + tid] = lcnt[tid];
  __syncthreads();
}

DI void slot_phase(const P& p, int ntok, unsigned char* lds) {
  const int tid = otid();
  int* cnt = (int*)lds;
  const int G = gridDim.x;
  int* total = cnt + G * 32; int* base = total + 32; int* pstart = base + 32; int* padded = pstart + 40;
  const int* CNT = (const int*)(p.ws + O_CNT);
  __syncthreads();
  for (int i = tid; i < G * 32; i += NT) cnt[i] = CNT[i];
  __syncthreads();
  if (tid < 32) {
    int s = 0, bsum = 0;
    for (int b = 0; b < G; ++b) { int v = cnt[b * 32 + tid]; if (b < (int)blockIdx.x) bsum += v; s += v; }
    total[tid] = s; base[tid] = bsum; padded[tid] = (s + 255) & ~255;
  }
  __syncthreads();
  if (tid == 0) { int a = 0; for (int e = 0; e < 32; ++e) { pstart[e] = a; a += padded[e]; } pstart[32] = a; }
  __syncthreads();
  int* TOKE = (int*)(p.ws + O_TOKE); int* TOKLP = (int*)(p.ws + O_TOKLP); int* TOKSLOT = (int*)(p.ws + O_TOKSLOT);
  int* ROWTOK = (int*)(p.ws + O_ROWTOK); int* TILEE = (int*)(p.ws + O_TILEE);
  const int per = ntok / G, tbase = blockIdx.x * per;
  for (int i = tid; i < per * 4; i += NT) {
    int idx = tbase * 4 + i;
    int e = TOKE[idx];
    int slot = pstart[e] + base[e] + TOKLP[idx];
    TOKSLOT[idx] = slot; ROWTOK[slot] = idx >> 2;
  }
  if (blockIdx.x < 32) {
    int e = blockIdx.x;
    for (int s2 = pstart[e] + total[e] + tid; s2 < pstart[e] + padded[e]; s2 += NT) ROWTOK[s2] = 0;
  }
  if (blockIdx.x == 0) {
    int nt = pstart[32] >> 8;
    if (tid == 0) TILEE[1023] = nt;
    for (int i = tid; i < nt; i += NT) {
      int row = i << 8, e = 0;
      for (int k = 1; k < 32; ++k) if (row >= pstart[k]) e = k;
      TILEE[i] = e;
    }
  }
  __syncthreads();
}

DI void moe1_phase(const P& p, int l, unsigned char* lds) {
  const u16* H = (const u16*)(p.ws + O_H);
  u16* ACT = (u16*)(p.ws + O_PROJ);
  const int* ROWTOK = (const int*)(p.ws + O_ROWTOK); const int* TILEE = (const int*)(p.ws + O_TILEE);
  const int ntm = TILEE[1023];
  const int tid = otid(), lane = tid & 63, w = tid >> 6, r = lane & 31, hh = lane >> 5, wm = w >> 2, wn = w & 3;
  for_tiles(ntm, 8, [&](int mt_, int tn_) {
    int n0 = tn_ * 256, m0 = mt_ * 256, e = TILEE[mt_];
    const u16* Wt = (const u16*)(p.ws + O_WT + l * WL_SIZE + WL_WE1) + (size_t)e * 2048 * 1024;
    const u16* ap[4];
#pragma unroll
    for (int i = 0; i < 4; ++i) ap[i] = H + boff(ROWTOK[m0 + (tid >> 3) + 64 * i], (tid & 7) * 8, 1024);
    const u16* b0p = Wt + (size_t)tn_ * 16 * 16384 + tid * 8;
    f32x16 acc[4][2]; acc_zero4(acc);
    gemm256(acc, ap, b0p, D, lds);
    const int j = (n0 >> 1) + wn * 32 + r;
    const float* b1 = p.in[I_BE1] + (size_t)(l * 32 + e) * 2048;
    const float bg = b1[2 * j], bl = b1[2 * j + 1];
    u16* abase = ACT + boff(m0 + wm * 128 + 4 * hh, j, 1024);
#pragma unroll
    for (int mt = 0; mt < 4; ++mt)
#pragma unroll
      for (int i = 0; i < 16; ++i) {
        float ug = fminf(acc[mt][0][i] + bg, 7.f);
        float ul = fminf(fmaxf(acc[mt][1][i] + bl, -7.f), 7.f);
        float a = ug * sigmoidf_(1.702f * ug) * (ul + 1.f);
        abase[(mt * 32 + 8 * (i >> 2) + (i & 3)) * 64] = f2bf(a);
      }
  });
}

DI void moe2_phase(const P& p, int l, unsigned char* lds) {
  const u16* ACT = (const u16*)(p.ws + O_PROJ);
  u16* Y = (u16*)(p.ws + O_Y);
  const int* TILEE = (const int*)(p.ws + O_TILEE);
  const int ntm = TILEE[1023];
  const int tid = otid(), lane = tid & 63, w = tid >> 6, r = lane & 31, hh = lane >> 5, wm = w >> 2, wn = w & 3;
  for_tiles(ntm, 4, [&](int mt_, int tn_) {
    int n0 = tn_ * 256, m0 = mt_ * 256, e = TILEE[mt_];
    const u16* Wt = (const u16*)(p.ws + O_WT + l * WL_SIZE + WL_WE2) + (size_t)e * 1024 * 1024;
    const u16* ap[4];
#pragma unroll
    for (int i = 0; i < 4; ++i) ap[i] = ACT + (size_t)mt_ * 16 * 16384 + tid * 8 + i * 4096;
    const u16* b0p = Wt + (size_t)tn_ * 16 * 16384 + tid * 8;
    f32x16 acc[4][2]; acc_zero4(acc);
    gemm256(acc, ap, b0p, 1024, lds);
    const float* b2 = p.in[I_BE2] + (size_t)(l * 32 + e) * 1024;
    u16* ybase = Y + (size_t)(m0 + wm * 128 + 4 * hh) * 1024 + n0 + wn * 64 + r;
#pragma unroll
    for (int nt = 0; nt < 2; ++nt) {
      float bv = b2[n0 + wn * 64 + nt * 32 + r];
#pragma unroll
      for (int mt = 0; mt < 4; ++mt)
#pragma unroll
        for (int i = 0; i < 16; ++i)
          ybase[(size_t)(mt * 32 + 8 * (i >> 2) + (i & 3)) * 1024 + nt * 32] = f2bf(acc[mt][nt][i] + bv);
    }
  });
}

DI void combine_phase(const P& p, int l, int ntok) {
  const int lane = otid() & 63, gw = blockIdx.x * (NT / 64) + (otid() >> 6), nw = gridDim.x * (NT / 64);
  float* XA = (float*)(p.ws + O_XA);
  const float* MOD = (const float*)(p.ws + O_MOD) + l * 5 * 6144;
  const float* MODN = (const float*)(p.ws + O_MOD) + (l + 1) * 5 * 6144;
  const u16* Y = (const u16*)(p.ws + O_Y);
  const int* TOKSLOT = (const int*)(p.ws + O_TOKSLOT); const float* TOKG = (const float*)(p.ws + O_TOKG);
  u16* H = (u16*)(p.ws + O_H);
  for (int row = gw; row < ntok; row += nw) {
    int mr = row < T ? (row >> 13) : 4;
    int4 sl = *(const int4*)(TOKSLOT + row * 4);
    float4 gt = *(const float4*)(TOKG + row * 4);
    float xv[16];
#pragma unroll
    for (int i = 0; i < 4; ++i) {
      int c = (i * 64 + lane) * 4;
      float4 x = *(const float4*)(XA + (size_t)row * D + c);
      float4 m5 = *(const float4*)(MOD + mr * 6144 + 5 * 1024 + c);
      uint2 y0 = *(const uint2*)(Y + (size_t)sl.x * 1024 + c), y1 = *(const uint2*)(Y + (size_t)sl.y * 1024 + c);
      uint2 y2 = *(const uint2*)(Y + (size_t)sl.z * 1024 + c), y3 = *(const uint2*)(Y + (size_t)sl.w * 1024 + c);
      float a0 = gt.x * lo16(y0.x) + gt.y * lo16(y1.x) + gt.z * lo16(y2.x) + gt.w * lo16(y3.x);
      float a1 = gt.x * hi16(y0.x) + gt.y * hi16(y1.x) + gt.z * hi16(y2.x) + gt.w * hi16(y3.x);
      float a2 = gt.x * lo16(y0.y) + gt.y * lo16(y1.y) + gt.z * lo16(y2.y) + gt.w * lo16(y3.y);
      float a3 = gt.x * hi16(y0.y) + gt.y * hi16(y1.y) + gt.z * hi16(y2.y) + gt.w * hi16(y3.y);
      xv[4 * i] = x.x + m5.x * a0; xv[4 * i + 1] = x.y + m5.y * a1; xv[4 * i + 2] = x.z + m5.z * a2; xv[4 * i + 3] = x.w + m5.w * a3;
      float4 o = make_float4(xv[4 * i], xv[4 * i + 1], xv[4 * i + 2], xv[4 * i + 3]);
      if (l == 1) *(float4*)(p.out + (size_t)row * D + c) = o;
      else *(float4*)(XA + (size_t)row * D + c) = o;
    }
    if (l == 0) norm_mod_store(xv, p.in[I_N1G] + 1024, MODN + mr * 6144, MODN + mr * 6144 + 1024, H, row, lane);
  }
}


#define XB_TMO      128
#define XB_XCNT(j)  (256  + 64 * (j))
#define XB_XSUB(j)  (1280 + 64 * (j))
#define XB_XGEN(j)  (2304 + 64 * (j))
#define XB_TOP      3328
#define XB_TOPGEN   3392
#define XCD_BAR_WORDS 3456
#define XB_SPIN_CAP (1u << 22)
#define LAS __attribute__((address_space(3)))
DI unsigned xb_ld(unsigned* p) { return __hip_atomic_load(p, __ATOMIC_RELAXED, __HIP_MEMORY_SCOPE_AGENT); }
DI unsigned xb_add(unsigned* p, unsigned v) { return __hip_atomic_fetch_add(p, v, __ATOMIC_RELAXED, __HIP_MEMORY_SCOPE_AGENT); }
DI unsigned xb_xcc_id() { return (unsigned)__builtin_amdgcn_s_getreg((3 << 11) | 20) & 0xFu; }
#define XB_SPIN(cond, bar) do { unsigned _sp = 0; while (cond) { __builtin_amdgcn_s_sleep(1); \
    if ((++_sp & 255u) == 0u) { if (xb_ld(&(bar)[XB_TMO])) break; if (_sp > XB_SPIN_CAP) { atomicAdd(&(bar)[XB_TMO], 1u); break; } } } } while (0)
struct XcdBarrier { unsigned* bar; unsigned x; volatile LAS unsigned* st; };
DI XcdBarrier xcd_barrier_post(unsigned* bar, volatile LAS unsigned* st) {
  XcdBarrier b; b.bar = bar; b.x = xb_xcc_id(); b.st = st;
  if (threadIdx.x == 0) (void)xb_add(&bar[XB_XCNT(b.x)], 1u);
  return b;
}
DI void xcd_barrier_complete(unsigned* bar, unsigned x, unsigned& nloc, unsigned& nx) {
  const unsigned G = gridDim.x * gridDim.y * gridDim.z;
  unsigned sum, cnt, mine, sp = 0u;
  for (;;) {
    sum = 0u; cnt = 0u; mine = 0u;
#pragma unroll
    for (unsigned j = 0; j < 16; ++j) { const unsigned c = xb_ld(&bar[XB_XCNT(j)]); sum += c; cnt += (c > 0u) ? 1u : 0u; mine = (j == x) ? c : mine; }
    if (sum == G) break;
    __builtin_amdgcn_s_sleep(1);
    if ((++sp & 255u) == 0u) { if (xb_ld(&bar[XB_TMO])) break; if (sp > XB_SPIN_CAP) { atomicAdd(&bar[XB_TMO], 1u); break; } }
  }
  nloc = mine > 0u ? mine : 1u; nx = cnt > 0u ? cnt : 1u;
}
DI void xcd_barrier(const XcdBarrier& b) {
  asm volatile("s_waitcnt vmcnt(0)" ::: "memory");
  __syncthreads();
  if (threadIdx.x == 0) {
    unsigned* bar = b.bar;
    __builtin_amdgcn_s_waitcnt(0);
    unsigned nloc = b.st[0], nx = b.st[1];
    if (nloc == 0u) { xcd_barrier_complete(bar, b.x, nloc, nx); b.st[0] = nloc; b.st[1] = nx; }
    const unsigned old = xb_add(&bar[XB_XSUB(b.x)], 1u);
    const unsigned gen = old / nloc;
    if (old + 1u == (gen + 1u) * nloc) {
      __builtin_amdgcn_fence(__ATOMIC_RELEASE, "agent");
      asm volatile("s_waitcnt vmcnt(0)" ::: "memory");
      const unsigned og = xb_add(&bar[XB_TOP], 1u);
      const unsigned tg = og / nx;
      if (og + 1u == (tg + 1u) * nx) xb_add(&bar[XB_TOPGEN], 1u);
      else XB_SPIN(xb_ld(&bar[XB_TOPGEN]) == tg, bar);
      __builtin_amdgcn_fence(__ATOMIC_ACQUIRE, "agent");
      xb_add(&bar[XB_XGEN(b.x)], 1u);
      asm volatile("s_waitcnt vmcnt(0)" ::: "memory");
    } else {
      XB_SPIN(xb_ld(&bar[XB_XGEN(b.x)]) == gen, bar);
      __builtin_amdgcn_fence(__ATOMIC_ACQUIRE, "agent");
      asm volatile("s_waitcnt vmcnt(0)" ::: "memory");
    }
  }
  __syncthreads();
}

#ifndef PM
#define PM 0xFFFF
#endif
#ifndef REP
#define REP 0
#endif
#define RUNP(bit, call) do { call; if (REP & (1 << (bit))) { GSYNC(); call; } } while (0)
__global__ void __launch_bounds__(NT) fwd_megakernel(P p) {
  cg::grid_group grid = cg::this_grid();
  extern __shared__ __attribute__((aligned(16))) unsigned char lds[];
  if (p.ws_size < WS_NEED) { if (blockIdx.x == 0 && otid() == 0) p.out[0] = 1e30f; return; }
  volatile LAS unsigned* xst = (volatile LAS unsigned*)(lds + LDS_BYTES - 16);
  if (threadIdx.x < 2) xst[threadIdx.x] = 0u;
  __syncthreads();
  (void)xcd_barrier_post((unsigned*)(p.ws + O_BAR), xst);
#define GSYNC() do { XcdBarrier xb_; unsigned* bp_ = (unsigned*)(p.ws + O_BAR); asm volatile("" : "+s"(bp_)); xb_.bar = bp_; xb_.x = xb_xcc_id(); \
    xb_.st = (volatile LAS unsigned*)(lds + LDS_BYTES - 16); xcd_barrier(xb_); } while (0)

  for (int rep = 0; rep < 1 + ((REP >> 0) & 1); ++rep) {
    if (rep) GSYNC();
    for (int l = 0; l < 2; ++l) {
      unsigned char* WL = p.ws + O_WT + l * WL_SIZE;
      convT(p.in[I_WE1] + (size_t)l * 32 * 1024 * 2048, 1024, 2048, (u16*)(WL + WL_WE1), 32, true, (float*)lds, 256);
      convT(p.in[I_WE2] + (size_t)l * 32 * 1024 * 1024, 1024, 1024, (u16*)(WL + WL_WE2), 32, false, (float*)lds, 256);
      convT(p.in[I_WIN] + (size_t)l * 1024 * NC, 1024, NC, (u16*)(WL + WL_WIN), 1, false, (float*)lds, 256);
      convT(p.in[I_WO] + (size_t)l * 1024 * 1024, 1024, 1024, (u16*)(WL + WL_WO), 1, false, (float*)lds);
      convT(p.in[I_WA] + (size_t)l * 512 * 1024, 512, 1024, (u16*)(WL + WL_WA), 1, false, (float*)lds);
      convT(p.in[I_WF] + (size_t)l * 256 * 1024, 256, 1024, (u16*)(WL + WL_WF), 1, false, (float*)lds);
      convT(p.in[I_WH] + (size_t)l * 256 * 1024, 256, 1024, (u16*)(WL + WL_WH), 1, false, (float*)lds);
    }
    mod_phase(p, (float*)lds);
    z2_phase(p, (float*)lds);
  }
  grid.sync();
  RUNP(1, filter_phase(p, lds));
  norm1_layer0(p);
  GSYNC();

  for (int l = 0; l < 2; ++l) {
    const int rows = (l == 0) ? TA : T;
    RUNP(2, g1_phase(p, l, lds));
    GSYNC();
    RUNP(4, attn_phase(p, l, lds));
    GSYNC();
    transpose_phase(p, lds);
    GSYNC();
    RUNP(5, merge_phase(p, l, rows, lds));
    GSYNC();
    if (PM & 256) wo_phase(p, l, rows, lds);
    GSYNC();
    RUNP(6, router_phase(p, l, rows, lds));
    GSYNC();
    RUNP(6, slot_phase(p, rows, lds));
    GSYNC();
    RUNP(7, moe1_phase(p, l, lds));
    GSYNC();
    RUNP(8, moe2_phase(p, l, lds));
    GSYNC();
    if (PM & 8192) combine_phase(p, l, rows);
    if (l == 0) GSYNC();
  }
}

extern "C" void kernel_launch(void* const* d_in, const int* in_sizes, int n_in, void* d_out, int out_size,
                              void* d_ws, size_t ws_size, hipStream_t stream) {
  static int grid_blocks = 0;
  if (!grid_blocks) {
    int dev = 0, cus = 0, per_cu = 0;
    (void)hipGetDevice(&dev);
    (void)hipDeviceGetAttribute(&cus, hipDeviceAttributeMultiprocessorCount, dev);
    if (hipFuncSetAttribute((const void*)fwd_megakernel, hipFuncAttributeMaxDynamicSharedMemorySize, LDS_BYTES) != hipSuccess)
      fprintf(stderr, "hipFuncSetAttribute failed\n");
    (void)hipOccupancyMaxActiveBlocksPerMultiprocessor(&per_cu, (const void*)fwd_megakernel, NT, LDS_BYTES);
    if (per_cu < 1) per_cu = 1;
    grid_blocks = cus * per_cu;
    if (grid_blocks > 256) grid_blocks = 256;
    if (grid_blocks != 256) fprintf(stderr, "unexpected grid %d\n", grid_blocks);
    fprintf(stderr, "grid %d (cus %d per_cu %d) ws %zu need %zu\n", grid_blocks, cus, per_cu, ws_size, (size_t)WS_NEED);
  }
  P p{};
  for (int i = 0; i < 35 && i < n_in; ++i) p.in[i] = (const float*)d_in[i];
  p.out = (float*)d_out;
  p.ws = (unsigned char*)d_ws;
  p.ws_size = (unsigned long long)ws_size;
  (void)hipMemsetAsync((unsigned char*)d_ws + O_BAR, 0, XCD_BAR_WORDS * 4, stream);
  void* args[] = {&p};
  hipError_t e = hipLaunchCooperativeKernel((void*)fwd_megakernel, dim3(grid_blocks), dim3(NT), args, LDS_BYTES, stream);
  if (e != hipSuccess) fprintf(stderr, "cooperative launch failed: %s (grid %d)\n", hipGetErrorString(e), grid_blocks);
}
```

```cpp
#include <hip/hip_runtime.h>
#include <hip/hip_cooperative_groups.h>
#include <cstdio>
namespace cg = cooperative_groups;

#define DI __device__ __forceinline__
typedef unsigned short u16;
typedef __attribute__((ext_vector_type(8))) short bf16x8;
typedef __attribute__((ext_vector_type(4))) short s16x4;
typedef __attribute__((ext_vector_type(16))) float f32x16;
typedef __bf16 bf2_t __attribute__((ext_vector_type(2)));
typedef float fl2_t __attribute__((ext_vector_type(2)));
#define MFMA16(a, b, c) __builtin_amdgcn_mfma_f32_32x32x16_bf16((a), (b), (c), 0, 0, 0)

constexpr int NT = 512;
constexpr int LDS_BYTES = 160 * 1024;
constexpr int NB = 4, L = 8192, D = 1024, T = NB * L, LC = 256, TC = NB * LC, TA = T + TC;
constexpr int NC = 5632, OFF_HY = 256, OFF_Q = 1024, OFF_V = 2048, OFF_G = 2560;
constexpr int LK = L + LC;
constexpr int NR = TA * 4 + 32 * 256;
constexpr float LOG2E = 1.4426950408889634f;

constexpr size_t WL_WIN = 0;
constexpr size_t WL_WF = WL_WIN + (size_t)NC * D * 2;
constexpr size_t WL_WH = WL_WF + (size_t)D * 256 * 2;
constexpr size_t WL_WA = WL_WH + (size_t)D * 256 * 2;
constexpr size_t WL_WO = WL_WA + (size_t)D * 512 * 2;
constexpr size_t WL_WE1 = WL_WO + (size_t)D * D * 2;
constexpr size_t WL_WE2 = WL_WE1 + (size_t)32 * 2048 * 1024 * 2;
constexpr size_t WL_SIZE = WL_WE2 + (size_t)32 * 1024 * 1024 * 2;
constexpr size_t O_WT = 0;
constexpr size_t O_MOD = O_WT + 2 * WL_SIZE;
constexpr size_t O_Z2 = O_MOD + 2 * 5 * 6144 * 4;
constexpr size_t O_Z2C = O_Z2 + (size_t)2 * L * 64 * 4;
constexpr size_t O_SPEC = O_Z2C + (size_t)LC * 64 * 4;
constexpr size_t O_FILTC = O_SPEC + (size_t)2 * 2 * 256 * 16384 * 8;
constexpr size_t O_XA = O_FILTC + (size_t)2 * 256 * 512 * 4;
constexpr size_t O_H = O_XA + (size_t)TA * D * 4;
constexpr size_t O_PROJ = O_H + (size_t)TA * D * 2;
constexpr size_t O_QN = O_PROJ + (size_t)TA * NC * 2;
constexpr size_t O_KN = O_QN + (size_t)NB * 4 * 2 * LK * 64 * 2;
constexpr size_t O_VT = O_KN + (size_t)NB * 4 * 2 * LK * 64 * 2;
constexpr size_t O_FM = O_VT + (size_t)NB * 4 * 128 * LK * 2;
constexpr size_t O_HY = O_FM + (size_t)TA * 256 * 2;
constexpr size_t O_O = O_HY + (size_t)TA * 256 * 2;
constexpr size_t O_MERGED = O_O + (size_t)TA * 512 * 2;
constexpr size_t O_HYSCR = O_MERGED + (size_t)TA * D * 2;
constexpr size_t O_YEND0 = O_HYSCR + (size_t)256 * 4 * 8192 * 8;
constexpr size_t O_Y = O_QN;
constexpr size_t Y_BYTES = (size_t)NR * D * 2;
constexpr size_t O_SMALL = (O_YEND0 > O_Y + Y_BYTES) ? O_YEND0 : (O_Y + Y_BYTES);
constexpr size_t O_TOKE = O_SMALL;
constexpr size_t O_TOKG = O_TOKE + (size_t)TA * 16;
constexpr size_t O_TOKLP = O_TOKG + (size_t)TA * 16;
constexpr size_t O_TOKSLOT = O_TOKLP + (size_t)TA * 16;
constexpr size_t O_CNT = O_TOKSLOT + (size_t)TA * 16;
constexpr size_t O_ROWTOK = O_CNT + 256 * 32 * 4;
constexpr size_t O_TILEE = O_ROWTOK + (size_t)NR * 4;
constexpr size_t O_ZT = O_TILEE + 4096;
constexpr size_t O_GF = O_ZT + (size_t)NB * 1024 * L * 2;
constexpr size_t O_FMT = O_GF + (size_t)3 * TA * 1024 * 2;
constexpr size_t O_HYT = O_FMT + (size_t)NB * 256 * L * 2;
constexpr size_t O_BAR = O_HYT + (size_t)NB * 256 * L * 2;
constexpr size_t WS_NEED = O_BAR + 16384;
static_assert((size_t)NR * D * 2 <= (size_t)TA * NC * 2, "ACT must fit in PROJ");

struct P {
  const float* in[35];
  float* out;
  unsigned char* ws;
  unsigned long long ws_size;
};
enum { I_X = 0, I_C, I_CTX, I_CCTX, I_WMOD, I_BMOD, I_N1G, I_N2G, I_WIN, I_HCW, I_HCB, I_HW1, I_HB1, I_HF1, I_HW2, I_HB2,
       I_HF2, I_HW3, I_HB3, I_HBIAS, I_QNG, I_KNG, I_LAMQ, I_LAMK, I_SUBG, I_WF, I_WH, I_WA, I_WO, I_WR, I_BR, I_WE1, I_BE1, I_WE2, I_BE2 };

DI float bf2f(u16 v) { return __uint_as_float(((unsigned)v) << 16); }
DI unsigned pack2(float a, float b) { fl2_t f = {a, b}; bf2_t r = __builtin_convertvector(f, bf2_t); return __builtin_bit_cast(unsigned, r); }
DI u16 f2bf(float a) { return (u16)(pack2(a, 0.f) & 0xffffu); }
DI float lo16(unsigned u) { return __uint_as_float(u << 16); }
DI float hi16(unsigned u) { return __uint_as_float(u & 0xffff0000u); }
DI float sin_t(float turns) { return __builtin_amdgcn_sinf(__builtin_amdgcn_fractf(turns)); }
DI float cos_t(float turns) { return __builtin_amdgcn_cosf(__builtin_amdgcn_fractf(turns)); }
DI int otid() { int t = threadIdx.x; asm volatile("" : "+v"(t)); return t; }
DI float shx(float v, int o) { int lane = otid() & 63; return __builtin_bit_cast(float, __builtin_amdgcn_ds_bpermute((lane ^ o) << 2, __builtin_bit_cast(int, v))); }
DI float wave_sum(float v) { for (int o = 32; o >= 1; o >>= 1) v += shx(v, o); return v; }
DI float wave_max(float v) { for (int o = 32; o >= 1; o >>= 1) v = fmaxf(v, shx(v, o)); return v; }
DI float sigmoidf_(float x) { return 1.f / (1.f + __expf(-x)); }
DI size_t boff(int row, int k, int K) { return ((size_t)(row >> 8) * (K >> 6) + (k >> 6)) * 16384 + (row & 255) * 64 + (k & 63); }
DI size_t boff128(int row, int k, int K) { return ((size_t)(row >> 7) * (K >> 6) + (k >> 6)) * 8192 + (row & 127) * 64 + (k & 63); }
DI int crow(int i, int hh) { return (i & 3) + 8 * (i >> 2) + 4 * hh; }
DI float lam_init_of(int l) { return l == 0 ? 0.2f : 0.35550906f; }

DI float block_sum(float v, float* red) {
  v = wave_sum(v);
  __syncthreads();
  if ((otid() & 63) == 0) red[otid() >> 6] = v;
  __syncthreads();
  float s = 0.f;
  for (int i = 0; i < NT / 64; ++i) s += red[i];
  return s;
}

DI int phys(int p) { return p + (p >> 4); }
DI float2 cmul(float2 a, float2 b) { return make_float2(a.x * b.x - a.y * b.y, a.x * b.y + a.y * b.x); }

template <int N, bool INV>
DI void fft_lds(float2* s) {
  constexpr int LG = (N == 16384) ? 14 : (N == 8192) ? 13 : 9;
  const int tid = otid();
  if (!INV) {
    if (LG & 1) {
      __syncthreads();
      constexpr int h = N / 2;
#pragma unroll 4
      for (int j = tid; j < h; j += NT) {
        float f = (float)j * (1.0f / N);
        float2 w = make_float2(cos_t(f), -sin_t(f));
        float2 a = s[phys(j)], b = s[phys(j + h)];
        s[phys(j)] = make_float2(a.x + b.x, a.y + b.y);
        s[phys(j + h)] = cmul(make_float2(a.x - b.x, a.y - b.y), w);
      }
    }
    for (int lq = (LG & 1) ? LG - 3 : LG - 2; lq >= 0; lq -= 2) {
      const int q = 1 << lq;
      __syncthreads();
      const float inv4q = 1.0f / (float)(4 * q);
#pragma unroll 4
      for (int it = 0; it < N / 4 / NT; ++it) {
        int idx = tid + it * NT;
        int j = idx & (q - 1), blk = idx >> lq;
        int p0 = blk * 4 * q + j;
        float f = (float)j * inv4q;
        float2 t1 = make_float2(cos_t(f), -sin_t(f));
        float2 t2 = cmul(t1, t1);
        float2 x0 = s[phys(p0)], x1 = s[phys(p0 + q)], x2 = s[phys(p0 + 2 * q)], x3 = s[phys(p0 + 3 * q)];
        float2 a0 = make_float2(x0.x + x2.x, x0.y + x2.y);
        float2 a2 = cmul(make_float2(x0.x - x2.x, x0.y - x2.y), t1);
        float2 a1 = make_float2(x1.x + x3.x, x1.y + x3.y);
        float2 d3 = make_float2(x1.x - x3.x, x1.y - x3.y);
        float2 a3 = cmul(make_float2(d3.y, -d3.x), t1);
        s[phys(p0)] = make_float2(a0.x + a1.x, a0.y + a1.y);
        s[phys(p0 + q)] = cmul(make_float2(a0.x - a1.x, a0.y - a1.y), t2);
        s[phys(p0 + 2 * q)] = make_float2(a2.x + a3.x, a2.y + a3.y);
        s[phys(p0 + 3 * q)] = cmul(make_float2(a2.x - a3.x, a2.y - a3.y), t2);
      }
    }
  } else {
    constexpr int top = (LG & 1) ? N / 8 : N / 4;
    for (int lq = 0; (1 << lq) <= top; lq += 2) {
      const int q = 1 << lq;
      __syncthreads();
      const float inv4q = 1.0f / (float)(4 * q);
#pragma unroll 4
      for (int it = 0; it < N / 4 / NT; ++it) {
        int idx = tid + it * NT;
        int j = idx & (q - 1), blk = idx >> lq;
        int p0 = blk * 4 * q + j;
        float f = (float)j * inv4q;
        float2 t1 = make_float2(cos_t(f), sin_t(f));
        float2 t2 = cmul(t1, t1);
        float2 x0 = s[phys(p0)], x1 = s[phys(p0 + q)], x2 = s[phys(p0 + 2 * q)], x3 = s[phys(p0 + 3 * q)];
        float2 b = cmul(x1, t2);
        float2 a0 = make_float2(x0.x + b.x, x0.y + b.y), a1 = make_float2(x0.x - b.x, x0.y - b.y);
        b = cmul(x3, t2);
        float2 a2 = make_float2(x2.x + b.x, x2.y + b.y), a3 = make_float2(x2.x - b.x, x2.y - b.y);
        b = cmul(a2, t1);
        s[phys(p0)] = make_float2(a0.x + b.x, a0.y + b.y);
        s[phys(p0 + 2 * q)] = make_float2(a0.x - b.x, a0.y - b.y);
        float2 c3 = cmul(a3, t1);
        b = make_float2(-c3.y, c3.x);
        s[phys(p0 + q)] = make_float2(a1.x + b.x, a1.y + b.y);
        s[phys(p0 + 3 * q)] = make_float2(a1.x - b.x, a1.y - b.y);
      }
    }
    if (LG & 1) {
      __syncthreads();
      constexpr int h = N / 2;
#pragma unroll 4
      for (int j = tid; j < h; j += NT) {
        float f = (float)j * (1.0f / N);
        float2 w = make_float2(cos_t(f), sin_t(f));
        float2 a = s[phys(j)], b = cmul(s[phys(j + h)], w);
        s[phys(j)] = make_float2(a.x + b.x, a.y + b.y);
        s[phys(j + h)] = make_float2(a.x - b.x, a.y - b.y);
      }
    }
  }
  __syncthreads();
}

DI void convT(const float* __restrict__ src, int K, int N, u16* __restrict__ dst, int nbatch, bool perm, float* sm, int blockR = 0) {
  const int tk = K / 64, tn = N / 256, per = tk * tn, total = per * nbatch;
  const int tid = otid();
  for (int t = blockIdx.x; t < total; t += gridDim.x) {
    int bt = t / per, rr = t % per, kt = rr / tn, nt = rr % tn;
    const float* sp = src + (size_t)bt * K * N + (size_t)(kt * 64) * N + nt * 256;
    u16* dp = dst + (size_t)bt * K * N;
    int kr = tid >> 3, c8 = (tid & 7) * 8;
    float4 a[4], b[4];
#pragma unroll
    for (int q = 0; q < 4; ++q) {
      a[q] = *(const float4*)(sp + (size_t)kr * N + q * 64 + c8);
      b[q] = *(const float4*)(sp + (size_t)kr * N + q * 64 + c8 + 4);
    }
    __syncthreads();
#pragma unroll
    for (int q = 0; q < 4; ++q) {
      float* row = sm + kr * 257 + q * 64 + c8;
      row[0] = a[q].x; row[1] = a[q].y; row[2] = a[q].z; row[3] = a[q].w; row[4] = b[q].x; row[5] = b[q].y; row[6] = b[q].z; row[7] = b[q].w;
    }
    __syncthreads();
#pragma unroll
    for (int q = 0; q < 4; ++q) {
      int n = (tid >> 3) + 64 * q, k8 = (tid & 7) * 8;
      float v[8];
#pragma unroll
      for (int j = 0; j < 8; ++j) v[j] = sm[(k8 + j) * 257 + n];
      int ng = nt * 256 + n;
      if (perm) { int j2 = ng >> 1; ng = (j2 >> 5) * 64 + ((ng & 1) ? 32 : 0) + (j2 & 31); }
      uint4 o = make_uint4(pack2(v[0], v[1]), pack2(v[2], v[3]), pack2(v[4], v[5]), pack2(v[6], v[7]));
      size_t doff = blockR == 256 ? boff(ng, kt * 64 + k8, K) : blockR == 128 ? boff128(ng, kt * 64 + k8, K) : (size_t)ng * K + kt * 64 + k8;
      *(uint4*)(dp + doff) = o;
    }
  }
  __syncthreads();
}

DI void mod_phase(const P& p, float* sm) {
  const int tid = otid();
  float* sl = sm;
  float* red = sm + 5 * 1024;
  __syncthreads();
  for (int i = tid; i < 5 * 1024; i += NT) {
    int r = i >> 10, d = i & 1023;
    float c = (r < 4) ? p.in[I_C][r * 1024 + d] : p.in[I_CCTX][d];
    sl[i] = c / (1.f + __expf(-c));
  }
  __syncthreads();
  float* MOD = (float*)(p.ws + O_MOD);
  for (int it = blockIdx.x; it < 2 * 96; it += gridDim.x) {
    int l = it / 96, c0 = (it % 96) * 64;
    int col = tid & 63, ds = tid >> 6;
    const float* w = p.in[I_WMOD] + (size_t)l * 1024 * 6144 + c0 + col;
    float acc[5] = {0.f, 0.f, 0.f, 0.f, 0.f};
    for (int d = ds * 128; d < ds * 128 + 128; ++d) {
      float wv = w[(size_t)d * 6144];
#pragma unroll
      for (int r = 0; r < 5; ++r) acc[r] += sl[r * 1024 + d] * wv;
    }
    __syncthreads();
#pragma unroll
    for (int r = 0; r < 5; ++r) red[(ds * 5 + r) * 64 + col] = acc[r];
    __syncthreads();
    if (tid < 320) {
      int r = tid >> 6, cc = tid & 63;
      float s = 0.f;
      for (int k = 0; k < 8; ++k) s += red[(k * 5 + r) * 64 + cc];
      MOD[(l * 5 + r) * 6144 + c0 + cc] = s + p.in[I_BMOD][l * 6144 + c0 + cc];
    }
  }
  __syncthreads();
}

DI void z2_phase(const P& p, float* sm) {
  const int tid = otid();
  const int tt = tid >> 6, j = tid & 63;
  float* emb = sm;
  float* z1 = sm + 8 * 33;
  const int n_lat = L / 8, n_ctx = LC / 8;
  for (int it = blockIdx.x; it < 2 * n_lat + n_ctx; it += gridDim.x) {
    int l, Lf, t0; float* dst;
    if (it < 2 * n_lat) { l = it / n_lat; Lf = L; t0 = (it % n_lat) * 8; dst = (float*)(p.ws + O_Z2) + (size_t)l * L * 64; }
    else { l = 0; Lf = LC; t0 = (it - 2 * n_lat) * 8; dst = (float*)(p.ws + O_Z2C); }
    int t = t0 + tt;
    __syncthreads();
    if (j < 33) {
      float v;
      if (j == 0) v = (float)t / (float)(Lf - 1);
      else {
        int k = (j - 1) & 15;
        float band = 1e-4f + (float)k * ((15.f - 1e-4f) / 15.f);
        float turns = band * ((float)t / (float)Lf);
        v = (j <= 16) ? cos_t(turns) : -sin_t(turns);
      }
      emb[tt * 33 + j] = v;
    }
    __syncthreads();
    const float* w1 = p.in[I_HW1] + l * 33 * 64;
    float a = p.in[I_HB1][l * 64 + j];
    for (int i = 0; i < 33; ++i) a += emb[tt * 33 + i] * w1[i * 64 + j];
    z1[tt * 64 + j] = sin_t(p.in[I_HF1][l * 64 + j] * a * 0.15915494309189535f);
    __syncthreads();
    const float* w2 = p.in[I_HW2] + l * 64 * 64;
    float a2 = p.in[I_HB2][l * 64 + j];
    for (int i = 0; i < 64; ++i) a2 += z1[tt * 64 + i] * w2[i * 64 + j];
    dst[(size_t)t * 64 + j] = sin_t(p.in[I_HF2][l * 64 + j] * a2 * 0.15915494309189535f);
  }
  __syncthreads();
}

DI float hy_delta(int c) { return 4.605170185988091f * (1.f / 1.5f + (float)c * (1.f / 255.f) * (1.f / 0.3f - 1.f / 1.5f)); }

DI void filter_phase(const P& p, unsigned char* lds) {
  float2* s = (float2*)lds;
  float* w3s_ = (float*)(lds + 17408 * 8);
  float* red = w3s_ + 256;
  for (int it = blockIdx.x; it < 512 + 256; it += gridDim.x) {
    const int tid = otid();
    const bool lat = it < 512;
    const int l = lat ? (it >> 8) : 0, c = it & 255;
    const int Lf = lat ? L : LC;
    const float* z2 = lat ? (const float*)(p.ws + O_Z2) + (size_t)l * L * 64 : (const float*)(p.ws + O_Z2C);
    __syncthreads();
    if (tid < 256) {
      int od = tid >> 6, i = tid & 63;
      w3s_[tid] = p.in[I_HW3][(size_t)l * 64 * 1024 + i * 1024 + od * 256 + c];
    }
    __syncthreads();
    const float delta = hy_delta(c);
    float lsum0 = 0.f, lsum1 = 0.f;
    float2* park = (float2*)(p.ws + O_HYSCR) + (size_t)blockIdx.x * 4 * 8192;
#pragma unroll 1
    for (int k = 0; k < 16; ++k) {
      const int t = tid + k * NT;
      if (t < Lf) {
        const float4* zr = (const float4*)(z2 + (size_t)t * 64);
        const float* b3p = p.in[I_HB3] + l * 1024 + c;
        float a0 = b3p[0], a1 = b3p[256], a2 = b3p[512], a3 = b3p[768];
        const float* w3s = w3s_;
        asm volatile("" : "+v"(w3s));
#pragma unroll
        for (int i = 0; i < 16; ++i) {
          float4 z = zr[i];
          a0 += z.x * w3s[4 * i] + z.y * w3s[4 * i + 1] + z.z * w3s[4 * i + 2] + z.w * w3s[4 * i + 3];
          a1 += z.x * w3s[64 + 4 * i] + z.y * w3s[64 + 4 * i + 1] + z.z * w3s[64 + 4 * i + 2] + z.w * w3s[64 + 4 * i + 3];
          a2 += z.x * w3s[128 + 4 * i] + z.y * w3s[128 + 4 * i + 1] + z.z * w3s[128 + 4 * i + 2] + z.w * w3s[128 + 4 * i + 3];
          a3 += z.x * w3s[192 + 4 * i] + z.y * w3s[192 + 4 * i + 1] + z.z * w3s[192 + 4 * i + 2] + z.w * w3s[192 + 4 * i + 3];
        }
        float dec = __expf(-((float)t / (float)(Lf - 1)) * delta);
        a0 *= dec; a1 *= dec; a2 *= dec; a3 *= dec;
        s[phys(t)] = make_float2(a0, 0.f);
        lsum0 += fabsf(a0);
        lsum1 += fabsf(a2);
        if (t >= 1) { s[phys(2 * Lf - t)] = make_float2(a1, 0.f); lsum0 += fabsf(a1); lsum1 += fabsf(a3); }
        else s[phys(Lf)] = make_float2(0.f, 0.f);
        park[t] = make_float2(a2, a3);
      }
    }
#pragma unroll 1
    for (int o = 0; o < 2; ++o) {
      const int tid = otid();
      if (o == 1) {
        __syncthreads();
#pragma unroll 4
        for (int k = 0; k < 16; ++k) {
          const int t = tid + k * NT;
          if (t < Lf) {
            float2 pv = park[t];
            s[phys(t)] = make_float2(pv.x, 0.f);
            if (t >= 1) s[phys(2 * Lf - t)] = make_float2(pv.y, 0.f);
            else s[phys(Lf)] = make_float2(0.f, 0.f);
          }
        }
      }
      float tot = block_sum(o == 0 ? lsum0 : lsum1, red);
      float inv = 1.f / tot;
      if (lat) {
        fft_lds<16384, false>(s);
        float2* dst = (float2*)(p.ws + O_SPEC) + ((size_t)(l * 2 + o) * 256 + c) * 16384;
#pragma unroll 8
        for (int i = tid; i < 16384; i += NT) { float2 v = s[phys(i)]; dst[i] = make_float2(v.x * inv, v.y * inv); }
      } else {
        float* dst = (float*)(p.ws + O_FILTC) + (size_t)(o * 256 + c) * 512;
        dst[tid] = s[phys(tid)].x * inv;
      }
    }
  }
  __syncthreads();
}

DI void norm_mod_store(const float (&xv)[16], const float* g, const float* shift, const float* scale, u16* Hb, int row, int lane) {
  float ss = 0.f;
#pragma unroll
  for (int i = 0; i < 16; ++i) ss += xv[i] * xv[i];
  ss = wave_sum(ss);
  float rinv = rsqrtf(ss * (1.f / 1024.f) + 1e-6f);
#pragma unroll
  for (int i = 0; i < 4; ++i) {
    int c = (i * 64 + lane) * 4;
    float4 gv = *(const float4*)(g + c), sh = *(const float4*)(shift + c), sc = *(const float4*)(scale + c);
    float h0 = xv[4 * i] * rinv * gv.x * (1.f + sc.x) + sh.x;
    float h1 = xv[4 * i + 1] * rinv * gv.y * (1.f + sc.y) + sh.y;
    float h2 = xv[4 * i + 2] * rinv * gv.z * (1.f + sc.z) + sh.z;
    float h3 = xv[4 * i + 3] * rinv * gv.w * (1.f + sc.w) + sh.w;
    *(uint2*)(Hb + boff(row, c, 1024)) = make_uint2(pack2(h0, h1), pack2(h2, h3));
  }
}

DI void norm1_layer0(const P& p) {
  const int lane = otid() & 63, gw = blockIdx.x * (NT / 64) + (otid() >> 6), nw = gridDim.x * (NT / 64);
  const float* MOD = (const float*)(p.ws + O_MOD);
  u16* H = (u16*)(p.ws + O_H);
  for (int row = gw; row < TA; row += nw) {
    const float* xr = row < T ? p.in[I_X] + (size_t)row * D : p.in[I_CTX] + (size_t)(row - T) * D;
    int mr = row < T ? (row >> 13) : 4;
    float xv[16];
#pragma unroll
    for (int i = 0; i < 4; ++i) { float4 v = *(const float4*)(xr + (i * 64 + lane) * 4); xv[4 * i] = v.x; xv[4 * i + 1] = v.y; xv[4 * i + 2] = v.z; xv[4 * i + 3] = v.w; }
    norm_mod_store(xv, p.in[I_N1G], MOD + mr * 6144, MOD + mr * 6144 + 1024, H, row, lane);
  }
}

constexpr int G_AST = 144;
constexpr int G_ABYTES = 256 * G_AST, G_BBYTES = 128 * G_AST, G_STAGE = G_ABYTES + G_BBYTES;

#define G_LOADR(S, ko) do { S##0 = *(const uint4*)(a0p + (ko)); S##1 = *(const uint4*)(a1p + (ko)); S##2 = *(const uint4*)(a2p + (ko)); \
    S##3 = *(const uint4*)(a3p + (ko)); S##4 = *(const uint4*)(b0p + (ko)); S##5 = *(const uint4*)(b1p + (ko)); } while (0)
#define G_STORER(S, nb) do { *(uint4*)((nb) + wofs) = S##0; *(uint4*)((nb) + wofs + 64 * G_AST) = S##1; *(uint4*)((nb) + wofs + 128 * G_AST) = S##2; \
    *(uint4*)((nb) + wofs + 192 * G_AST) = S##3; *(uint4*)((nb) + G_ABYTES + wofs) = S##4; *(uint4*)((nb) + G_ABYTES + wofs + 64 * G_AST) = S##5; } while (0)

DI void gemm_compute(f32x16 (&acc)[2][2], const unsigned char* As, const unsigned char* Bs) {
  bf16x8 a0 = *(const bf16x8*)(As), a1 = *(const bf16x8*)(As + 32 * G_AST);
  bf16x8 b0 = *(const bf16x8*)(Bs), b1 = *(const bf16x8*)(Bs + 32 * G_AST);
#pragma unroll
  for (int ks = 0; ks < 4; ++ks) {
    bf16x8 na0 = a0, na1 = a1, nb0 = b0, nb1 = b1;
    if (ks < 3) {
      na0 = *(const bf16x8*)(As + (ks + 1) * 32); na1 = *(const bf16x8*)(As + 32 * G_AST + (ks + 1) * 32);
      nb0 = *(const bf16x8*)(Bs + (ks + 1) * 32); nb1 = *(const bf16x8*)(Bs + 32 * G_AST + (ks + 1) * 32);
    }
    acc[0][0] = MFMA16(a0, b0, acc[0][0]);
    acc[0][1] = MFMA16(a0, b1, acc[0][1]);
    acc[1][0] = MFMA16(a1, b0, acc[1][0]);
    acc[1][1] = MFMA16(a1, b1, acc[1][1]);
    a0 = na0; a1 = na1; b0 = nb0; b1 = nb1;
  }
}

DI void gemm_main(f32x16 (&acc)[2][2], const u16* const (&ap)[4], const u16* const (&bp)[2], int K, unsigned char* lds) {
  const int tid = otid(), lane = tid & 63, w = tid >> 6, r = lane & 31, hh = lane >> 5;
  const int wm = w >> 1, wn = w & 1;
  const int wofs = (tid >> 3) * G_AST + (tid & 7) * 16;
  const u16* a0p = ap[0]; const u16* a1p = ap[1]; const u16* a2p = ap[2]; const u16* a3p = ap[3];
  const u16* b0p = bp[0]; const u16* b1p = bp[1];
  uint4 P0, P1, P2, P3, P4, P5, Q0, Q1, Q2, Q3, Q4, Q5;
  G_LOADR(P, 0);
  G_LOADR(Q, 64);
  G_STORER(P, lds);
  __syncthreads();
  const unsigned char* As0 = lds + (wm * 64 + r) * G_AST + hh * 16;
  const unsigned char* Bs0 = lds + G_ABYTES + (wn * 64 + r) * G_AST + hh * 16;
  const int nk = K >> 6;
  for (int kt = 0; kt < nk; kt += 2) {
    if (kt + 2 < nk) G_LOADR(P, (kt + 2) * 64);
    __builtin_amdgcn_sched_barrier(0);
    gemm_compute(acc, As0, Bs0);
    __builtin_amdgcn_sched_barrier(0);
    G_STORER(Q, lds + G_STAGE);
    __syncthreads();
    if (kt + 3 < nk) G_LOADR(Q, (kt + 3) * 64);
    __builtin_amdgcn_sched_barrier(0);
    gemm_compute(acc, As0 + G_STAGE, Bs0 + G_STAGE);
    __builtin_amdgcn_sched_barrier(0);
    if (kt + 2 < nk) G_STORER(P, lds);
    __syncthreads();
  }
}

DI void acc_zero(f32x16 (&acc)[2][2]) {
#pragma unroll
  for (int a = 0; a < 2; ++a)
#pragma unroll
    for (int b = 0; b < 2; ++b)
#pragma unroll
      for (int i = 0; i < 16; ++i) acc[a][b][i] = 0.f;
}

constexpr int G2_ABYTES = 256 * G_AST, G2_STAGE = 2 * G2_ABYTES;
#define G2_LOADR(kt_) do { const size_t ko = (size_t)(kt_) * 16384; R0 = *(const uint4*)(a0p + ko); R1 = *(const uint4*)(a1p + ko); R2 = *(const uint4*)(a2p + ko); R3 = *(const uint4*)(a3p + ko); \
    R4 = *(const uint4*)(b0p + ko); R5 = *(const uint4*)(b0p + 4096 + ko); R6 = *(const uint4*)(b0p + 8192 + ko); R7 = *(const uint4*)(b0p + 12288 + ko); } while (0)
#define G2_STORER(nb) do { *(uint4*)((nb) + wofs) = R0; *(uint4*)((nb) + wofs + 64 * G_AST) = R1; *(uint4*)((nb) + wofs + 128 * G_AST) = R2; *(uint4*)((nb) + wofs + 192 * G_AST) = R3; \
    *(uint4*)((nb) + G2_ABYTES + wofs) = R4; *(uint4*)((nb) + G2_ABYTES + wofs + 64 * G_AST) = R5; *(uint4*)((nb) + G2_ABYTES + wofs + 128 * G_AST) = R6; \
    *(uint4*)((nb) + G2_ABYTES + wofs + 192 * G_AST) = R7; } while (0)

template <bool TR>
DI void gemm256_compute(f32x16 (&acc)[4][2], const unsigned char* As, const unsigned char* Bs) {
  __builtin_amdgcn_s_setprio(2);
  bf16x8 b0 = *(const bf16x8*)(Bs), b1 = *(const bf16x8*)(Bs + 32 * G_AST);
  bf16x8 a0 = *(const bf16x8*)(As), a1 = *(const bf16x8*)(As + 32 * G_AST), a2 = *(const bf16x8*)(As + 64 * G_AST), a3 = *(const bf16x8*)(As + 96 * G_AST);
#pragma unroll
  for (int ks = 0; ks < 4; ++ks) {
    bf16x8 nb0 = b0, nb1 = b1, na0 = a0, na1 = a1, na2 = a2, na3 = a3;
    if (ks < 3) {
      nb0 = *(const bf16x8*)(Bs + (ks + 1) * 32); nb1 = *(const bf16x8*)(Bs + 32 * G_AST + (ks + 1) * 32);
      na0 = *(const bf16x8*)(As + (ks + 1) * 32); na1 = *(const bf16x8*)(As + 32 * G_AST + (ks + 1) * 32);
      na2 = *(const bf16x8*)(As + 64 * G_AST + (ks + 1) * 32); na3 = *(const bf16x8*)(As + 96 * G_AST + (ks + 1) * 32);
    }
    if (TR) {
      acc[0][0] = MFMA16(b0, a0, acc[0][0]); acc[0][1] = MFMA16(b1, a0, acc[0][1]);
      acc[1][0] = MFMA16(b0, a1, acc[1][0]); acc[1][1] = MFMA16(b1, a1, acc[1][1]);
      acc[2][0] = MFMA16(b0, a2, acc[2][0]); acc[2][1] = MFMA16(b1, a2, acc[2][1]);
      acc[3][0] = MFMA16(b0, a3, acc[3][0]); acc[3][1] = MFMA16(b1, a3, acc[3][1]);
    } else {
      acc[0][0] = MFMA16(a0, b0, acc[0][0]); acc[0][1] = MFMA16(a0, b1, acc[0][1]);
      acc[1][0] = MFMA16(a1, b0, acc[1][0]); acc[1][1] = MFMA16(a1, b1, acc[1][1]);
      acc[2][0] = MFMA16(a2, b0, acc[2][0]); acc[2][1] = MFMA16(a2, b1, acc[2][1]);
      acc[3][0] = MFMA16(a3, b0, acc[3][0]); acc[3][1] = MFMA16(a3, b1, acc[3][1]);
    }
    if (ks < 3) {
      __builtin_amdgcn_sched_group_barrier(0x100, 6, 0);
      __builtin_amdgcn_sched_group_barrier(0x008, 8, 0);
    }
    b0 = nb0; b1 = nb1; a0 = na0; a1 = na1; a2 = na2; a3 = na3;
  }
  __builtin_amdgcn_s_setprio(0);
}

template <bool TR = false>
DI void gemm256(f32x16 (&acc)[4][2], const u16* const (&ap)[4], const u16* b0p, int K, unsigned char* lds) {
  const int tid = otid(), lane = tid & 63, w = tid >> 6, r = lane & 31, hh = lane >> 5;
  const int wm = w >> 2, wn = w & 3;
  const int wofs = (tid >> 3) * G_AST + (tid & 7) * 16;
  const u16* a0p = ap[0]; const u16* a1p = ap[1]; const u16* a2p = ap[2]; const u16* a3p = ap[3];
  uint4 R0, R1, R2, R3, R4, R5, R6, R7;
  const int nk = K >> 6;
  const bool late = w >= 4;
  G2_LOADR(0);
  G2_STORER(lds);
  if (late && nk > 1) G2_LOADR(1);
  __syncthreads();
  const unsigned char* As0 = lds + (wm * 128 + r) * G_AST + hh * 16;
  const unsigned char* Bs0 = lds + G2_ABYTES + (wn * 64 + r) * G_AST + hh * 16;
  if (!late) {
    for (int kt = 0; kt < nk; ++kt) {
      const bool more = kt + 1 < nk;
      if (more) G2_LOADR(kt + 1);
      __builtin_amdgcn_sched_barrier(0);
      gemm256_compute<TR>(acc, As0 + (kt & 1) * G2_STAGE, Bs0 + (kt & 1) * G2_STAGE);
      __builtin_amdgcn_sched_barrier(0);
      if (more) G2_STORER(lds + ((kt + 1) & 1) * G2_STAGE);
      __syncthreads();
    }
  } else {
    for (int kt = 0; kt < nk; ++kt) {
      if (kt + 1 < nk) G2_STORER(lds + ((kt + 1) & 1) * G2_STAGE);
      __builtin_amdgcn_sched_barrier(0);
      if (kt + 2 < nk) G2_LOADR(kt + 2);
      __builtin_amdgcn_sched_barrier(0);
      gemm256_compute<TR>(acc, As0 + (kt & 1) * G2_STAGE, Bs0 + (kt & 1) * G2_STAGE);
      __syncthreads();
    }
  }
}
DI void acc_zero4(f32x16 (&acc)[4][2]) {
#pragma unroll
  for (int a = 0; a < 4; ++a)
#pragma unroll
    for (int b = 0; b < 2; ++b)
#pragma unroll
      for (int i = 0; i < 16; ++i) acc[a][b][i] = 0.f;
}

DI void set_ap(const u16* (&ap)[4], const u16* A, int lda, int m0) {
  const int tid = otid();
#pragma unroll
  for (int i = 0; i < 4; ++i) ap[i] = A + (size_t)(m0 + (tid >> 3) + 64 * i) * lda + (tid & 7) * 8;
}
DI void set_bp(const u16* (&bp)[2], const u16* Bt, int ldb, int n0) {
  const int tid = otid();
#pragma unroll
  for (int i = 0; i < 2; ++i) bp[i] = Bt + (size_t)(n0 + (tid >> 3) + 64 * i) * ldb + (tid & 7) * 8;
}

template <class F>
DI void for_tiles(int ntm, int ntn, F f) {
  const int xcd = blockIdx.x & 7, lb = blockIdx.x >> 3, nlb = gridDim.x >> 3;
  const int total = ((ntm + 3) & ~3) * ntn;
  const int chunk = (total + 7) >> 3;
  for (int i = lb; i < chunk; i += nlb) {
    int idx = xcd * chunk + i;
    if (idx >= total) break;
    int panel = idx / (4 * ntn), within = idx - panel * 4 * ntn;
    int n = within >> 2, m = panel * 4 + (within & 3);
    if (m < ntm) f(m, n);
  }
}

DI void g1_phase(const P& p, int l, unsigned char* lds) {
  const u16* H = (const u16*)(p.ws + O_H);
  const u16* Wt = (const u16*)(p.ws + O_WT + l * WL_SIZE + WL_WIN);
  u16* PROJ = (u16*)(p.ws + O_PROJ);
  for_tiles(TA / 256, NC / 256, [&](int tm_, int tn_) {
    int m0 = tm_ * 256, n0 = tn_ * 256;
    const u16* ap[4];
    const int tid0 = otid();
#pragma unroll
    for (int i = 0; i < 4; ++i) ap[i] = H + (size_t)tm_ * 16 * 16384 + tid0 * 8 + i * 4096;
    const u16* b0p = Wt + (size_t)tn_ * 16 * 16384 + tid0 * 8;
    f32x16 acc[4][2]; acc_zero4(acc);
    if (tn_ >= 4 && tn_ < 8) {
      gemm256<true>(acc, ap, b0p, D, lds);
      const int tid = otid(), lane = tid & 63, w = tid >> 6, r = lane & 31, hh = lane >> 5, wm = w >> 2, wn = w & 3;
      const int grp = ((n0 - OFF_Q) >> 6) + wn, g8 = grp & 7;
      const bool isq = grp < 8, lat = tm_ < T / 256;
      const float* gg = p.in[isq ? I_QNG : I_KNG] + l * 64;
      const float post = isq ? (LOG2E * 0.125f) : 1.f;
      u16* dstb = (u16*)(p.ws + (isq ? O_QN : O_KN));
#pragma unroll 1
      for (int mt = 0; mt < 4; ++mt) {
        const int row = m0 + wm * 128 + mt * 32 + r;
        int bb, n, kpos;
        if (lat) { bb = row >> 13; n = row & (L - 1); kpos = n; } else { int rc = row - T; bb = rc >> 8; n = rc & 255; kpos = L + n; }
        f32x16 x0, x1;
        if (mt == 0) { x0 = acc[0][0]; x1 = acc[0][1]; } else if (mt == 1) { x0 = acc[1][0]; x1 = acc[1][1]; }
        else if (mt == 2) { x0 = acc[2][0]; x1 = acc[2][1]; } else { x0 = acc[3][0]; x1 = acc[3][1]; }
        float ss = 0.f;
#pragma unroll
        for (int i = 0; i < 16; ++i) ss += x0[i] * x0[i] + x1[i] * x1[i];
        ss += shx(ss, 32);
        const float rinv = rsqrtf(ss * (1.f / 64.f) + 1e-6f);
#pragma unroll
        for (int i = 0; i < 16; ++i) { x0[i] *= rinv * gg[crow(i, hh)]; x1[i] *= rinv * gg[32 + crow(i, hh)]; }
        if (lat) {
          const float prow = (float)(n >> 6), pcol = (float)(n & 63);
#pragma unroll
          for (int i = 0; i < 8; ++i) {
            const float invt = __builtin_amdgcn_exp2f(-(float)crow(i, hh) * (13.287712379549449f / 16.f)) * 0.15915494309189535f;
            float t0 = prow * invt, t1 = pcol * invt;
            float c0 = cos_t(t0), s0 = sin_t(t0), c1 = cos_t(t1), s1 = sin_t(t1);
            float a0 = x0[i], b0 = x0[i + 8], a1 = x1[i], b1 = x1[i + 8];
            x0[i] = a0 * c0 - b0 * s0; x0[i + 8] = b0 * c0 + a0 * s0;
            x1[i] = a1 * c1 - b1 * s1; x1[i + 8] = b1 * c1 + a1 * s1;
          }
        }
        u16* dst = dstb + ((size_t)(bb * 8 + g8) * LK + kpos) * 64 + 4 * hh;
#pragma unroll
        for (int g4 = 0; g4 < 4; ++g4) {
          *(uint2*)(dst + 8 * g4) = make_uint2(pack2(x0[4 * g4] * post, x0[4 * g4 + 1] * post), pack2(x0[4 * g4 + 2] * post, x0[4 * g4 + 3] * post));
          *(uint2*)(dst + 32 + 8 * g4) = make_uint2(pack2(x1[4 * g4] * post, x1[4 * g4 + 1] * post), pack2(x1[4 * g4 + 2] * post, x1[4 * g4 + 3] * post));
        }
      }
      return;
    }
    gemm256<false>(acc, ap, b0p, D, lds);
    const int tid = otid(), lane = tid & 63, w = tid >> 6, r = lane & 31, hh = lane >> 5, wm = w >> 2, wn = w & 3;
    if (tn_ >= 8 && tn_ < 10) {
      const bool lat = tm_ < T / 256;
      int bb, nbase;
      if (lat) { bb = m0 >> 13; nbase = (m0 & (L - 1)) + wm * 128; } else { int rc = m0 - T; bb = rc >> 8; nbase = L + (rc & 255) + wm * 128; }
      u16* vb = (u16*)(p.ws + O_VT) + ((size_t)bb * 512 + (n0 - OFF_V) + wn * 64 + r) * LK + nbase;
#pragma unroll
      for (int mt = 0; mt < 4; ++mt)
#pragma unroll
        for (int nt = 0; nt < 2; ++nt)
#pragma unroll
          for (int g4 = 0; g4 < 4; ++g4) {
            const int k16 = 8 * (g4 & 1) + 4 * hh;
            const int pk = (k16 == 4) ? 8 : (k16 == 8) ? 4 : k16;
            *(uint2*)(vb + (size_t)nt * 32 * LK + mt * 32 + 16 * (g4 >> 1) + pk) =
                make_uint2(pack2(acc[mt][nt][4 * g4], acc[mt][nt][4 * g4 + 1]), pack2(acc[mt][nt][4 * g4 + 2], acc[mt][nt][4 * g4 + 3]));
          }
      return;
    }
    if (tn_ >= 10) {
      const int br = (tn_ - 10) >> 2, tn2 = ((tn_ - 10) & 3) * 2 + (wn >> 1), wn2 = wn & 1;
      u16* gf = (u16*)(p.ws + O_GF) + (size_t)br * TA * 1024;
#pragma unroll
      for (int mt = 0; mt < 4; ++mt) {
        const int wave2 = (2 * wm + (mt >> 1)) * 2 + wn2, mt2 = mt & 1;
#pragma unroll
        for (int nt = 0; nt < 2; ++nt)
#pragma unroll
          for (int g4 = 0; g4 < 4; ++g4) {
            size_t idx = ((((((size_t)tm_ * 8 + tn2) * 8 + wave2) * 2 + mt2) * 2 + nt) * 4 + g4) * 64 + lane;
            *(uint2*)(gf + idx * 4) = make_uint2(pack2(sigmoidf_(acc[mt][nt][4 * g4]), sigmoidf_(acc[mt][nt][4 * g4 + 1])),
                                                 pack2(sigmoidf_(acc[mt][nt][4 * g4 + 2]), sigmoidf_(acc[mt][nt][4 * g4 + 3])));
          }
      }
    } else if (tn_ < 4 && tm_ < T / 256) {
      const int bb = m0 >> 13, nl = (m0 & (L - 1)) + wm * 128 + 4 * hh;
      u16* zb = (u16*)(p.ws + O_ZT) + ((size_t)bb * 1024 + n0 + wn * 64 + r) * L + nl;
#pragma unroll
      for (int mt = 0; mt < 4; ++mt)
#pragma unroll
        for (int nt = 0; nt < 2; ++nt)
#pragma unroll
          for (int g4 = 0; g4 < 4; ++g4)
            *(uint2*)(zb + (size_t)nt * 32 * L + mt * 32 + 8 * g4) =
                make_uint2(pack2(acc[mt][nt][4 * g4], acc[mt][nt][4 * g4 + 1]), pack2(acc[mt][nt][4 * g4 + 2], acc[mt][nt][4 * g4 + 3]));
    } else {
      u16* pbase = PROJ + (size_t)(m0 + wm * 128 + 4 * hh) * NC + n0 + wn * 64 + r;
#pragma unroll
      for (int mt = 0; mt < 4; ++mt)
#pragma unroll
        for (int nt = 0; nt < 2; ++nt)
#pragma unroll
          for (int i = 0; i < 16; ++i)
            pbase[(size_t)(mt * 32 + 8 * (i >> 2) + (i & 3)) * NC + nt * 32] = f2bf(acc[mt][nt][i]);
    }
  });
}

DI void prep_phase_tiles(const P& p, int l, unsigned char* lds, int job, int) {
  const int tid = otid();
  const u16* PROJ = (const u16*)(p.ws + O_PROJ);
  float2* rt = (float2*)lds;
  u16* vs = (u16*)(lds + 128 * 16 * 8);
  __syncthreads();
  for (int i = tid; i < 128 * 16; i += NT) {
    int pos = i >> 4, f = i & 15;
    float inv = exp2f(-(float)f * (13.287712379549449f / 16.f));
    float turns = (float)pos * inv * 0.15915494309189535f;
    rt[i] = make_float2(cos_t(turns), sin_t(turns));
  }
  const bool lat = job < 512;
  const int b = lat ? (job >> 7) : (job - 512) >> 2;
  const int n0 = lat ? (job & 127) * 64 : ((job - 512) & 3) * 64;
  const int row0 = lat ? b * L + n0 : T + b * LC + n0;
  const int kpos0 = lat ? n0 : L + n0;
#pragma unroll 8
  for (int i = tid; i < 64 * 64; i += NT) {
    int tk = i >> 6, ch = i & 63;
    uint4 v = *(const uint4*)(PROJ + (size_t)(row0 + tk) * NC + OFF_V + ch * 8);
    unsigned* d = (unsigned*)(vs + tk * 514 + ch * 8);
    d[0] = v.x; d[1] = v.y; d[2] = v.z; d[3] = v.w;
  }
  __syncthreads();
  const float* gq = p.in[I_QNG] + l * 64; const float* gk = p.in[I_KNG] + l * 64;
  for (int u = tid; u < 1024; u += NT) {
    int tk = u & 63, grp = u >> 6;
    const uint4* src = (const uint4*)(PROJ + (size_t)(row0 + tk) * NC + OFF_Q + grp * 64);
    float x[64];
#pragma unroll
    for (int i = 0; i < 8; ++i) {
      uint4 v = src[i];
      x[8 * i] = lo16(v.x); x[8 * i + 1] = hi16(v.x); x[8 * i + 2] = lo16(v.y); x[8 * i + 3] = hi16(v.y);
      x[8 * i + 4] = lo16(v.z); x[8 * i + 5] = hi16(v.z); x[8 * i + 6] = lo16(v.w); x[8 * i + 7] = hi16(v.w);
    }
    float ss = 0.f;
#pragma unroll
    for (int i = 0; i < 64; ++i) ss += x[i] * x[i];
    float rinv = rsqrtf(ss * (1.f / 64.f) + 1e-6f);
    const float* g = grp < 8 ? gq : gk;
    const float post = grp < 8 ? (LOG2E * 0.125f) : 1.f;
#pragma unroll
    for (int i = 0; i < 64; ++i) x[i] = x[i] * rinv * g[i];
    if (lat) {
      int n = n0 + tk;
      int prow = n >> 6, pcol = n & 63;
#pragma unroll
      for (int ax = 0; ax < 2; ++ax) {
        int pp = ax == 0 ? prow : pcol;
#pragma unroll
        for (int f = 0; f < 16; ++f) {
          float2 cs = rt[pp * 16 + f];
          float a = x[ax * 32 + f], bq = x[ax * 32 + 16 + f];
          x[ax * 32 + f] = a * cs.x - bq * cs.y;
          x[ax * 32 + 16 + f] = bq * cs.x + a * cs.y;
        }
      }
    }
    int g8 = grp & 7;
    u16* dst = (u16*)(p.ws + (grp < 8 ? O_QN : O_KN)) + ((size_t)(b * 8 + g8) * LK + kpos0 + tk) * 64;
#pragma unroll
    for (int i = 0; i < 8; ++i)
      ((uint4*)dst)[i] = make_uint4(pack2(x[8 * i] * post, x[8 * i + 1] * post), pack2(x[8 * i + 2] * post, x[8 * i + 3] * post),
                                    pack2(x[8 * i + 4] * post, x[8 * i + 5] * post), pack2(x[8 * i + 6] * post, x[8 * i + 7] * post));
  }
  u16* VT = (u16*)(p.ws + O_VT);
  for (int i = tid; i < 512 * 8; i += NT) {
    int he = i >> 3, tc = i & 7;
    u16 v[8];
#pragma unroll
    for (int j = 0; j < 8; ++j) v[j] = vs[(tc * 8 + j) * 514 + he];
    uint4 o = make_uint4(v[0] | ((unsigned)v[1] << 16), v[2] | ((unsigned)v[3] << 16), v[4] | ((unsigned)v[5] << 16), v[6] | ((unsigned)v[7] << 16));
    *(uint4*)(VT + ((size_t)(b * 512 + he)) * LK + kpos0 + tc * 8) = o;
  }
  __syncthreads();
}

DI float zval(const u16* PROJ, size_t rowbase, int n, int col) { return bf2f(PROJ[(rowbase + n) * NC + OFF_HY + col]); }
DI float ztval(const u16* ZT, int b, int n, int col) { return bf2f(ZT[((size_t)b * 1024 + OFF_HY + col) * L + n]); }

DI void hyena_lat_item(const P& p, int l, int c, int bp, unsigned char* lds) {
  const int tid = otid();
  const u16* PROJ = (const u16*)(p.ws + O_PROJ);
  float2* s = (float2*)lds;
  float2* scr = (float2*)(p.ws + O_HYSCR) + (size_t)blockIdx.x * 4 * 8192;
  const u16* ZT = (const u16*)(p.ws + O_ZT);
  const float* cw = p.in[I_HCW] + l * 3 * 768; const float* cb = p.in[I_HCB] + l * 768;
  float w[3][3], bs[3];
#pragma unroll
  for (int k = 0; k < 3; ++k) { bs[k] = cb[k * 256 + c];
#pragma unroll
    for (int j = 0; j < 3; ++j) w[k][j] = cw[j * 768 + k * 256 + c]; }
  const size_t rb0 = (size_t)(2 * bp) * L, rb1 = rb0 + L;
  __syncthreads();
#pragma unroll 1
  for (int ch = 0; ch < 2; ++ch) {
    const int n0 = ch * 4096 + tid * 8;
    float o[3][2][8];
#pragma unroll
    for (int k = 0; k < 3; ++k)
#pragma unroll
      for (int bq = 0; bq < 2; ++bq) {
        const u16* zr = ZT + ((size_t)(2 * bp + bq) * 1024 + OFF_HY + k * 256 + c) * L;
        uint4 v = *(const uint4*)(zr + n0);
        float x[10];
        x[0] = n0 > 0 ? bf2f(zr[n0 - 1]) : 0.f;
        x[9] = n0 + 8 < L ? bf2f(zr[n0 + 8]) : 0.f;
        x[1] = lo16(v.x); x[2] = hi16(v.x); x[3] = lo16(v.y); x[4] = hi16(v.y); x[5] = lo16(v.z); x[6] = hi16(v.z); x[7] = lo16(v.w); x[8] = hi16(v.w);
#pragma unroll
        for (int e = 0; e < 8; ++e) o[k][bq][e] = bs[k] + w[k][0] * x[e] + w[k][1] * x[e + 1] + w[k][2] * x[e + 2];
      }
#pragma unroll
    for (int e = 0; e < 8; ++e) {
      int n = n0 + e;
      s[phys(n)] = make_float2(o[0][0][e], o[0][1][e]);
      s[phys(n + L)] = make_float2(0.f, 0.f);
      scr[n] = make_float2(o[0][0][e], o[0][1][e]);
      scr[8192 + n] = make_float2(o[1][0][e], o[1][1][e]);
      scr[16384 + n] = make_float2(o[2][0][e], o[2][1][e]);
    }
  }
  const float invN = 1.f / 16384.f;
  for (int ord = 0; ord < 2; ++ord) {
    fft_lds<16384, false>(s);
    const float2* H = (const float2*)(p.ws + O_SPEC) + ((size_t)(l * 2 + ord) * 256 + c) * 16384;
#pragma unroll 8
    for (int i = tid; i < 16384; i += NT) { s[phys(i)] = cmul(s[phys(i)], H[i]); }
    fft_lds<16384, true>(s);
    const float bias = p.in[I_HBIAS][l * 512 + ord * 256 + c];
    if (ord == 0) {
      float2 y1v[16];
#pragma unroll
      for (int i = 0; i < 16; ++i) {
        int n = (i >> 3) * 4096 + tid * 8 + (i & 7);
        float2 cv = s[phys(n)], v = scr[n], x1 = scr[8192 + n];
        y1v[i] = make_float2(x1.x * (cv.x * invN + v.x * bias), x1.y * (cv.y * invN + v.y * bias));
        scr[24576 + n] = y1v[i];
      }
      __syncthreads();
#pragma unroll
      for (int i = 0; i < 16; ++i) { int n = (i >> 3) * 4096 + tid * 8 + (i & 7); s[phys(n)] = y1v[i]; s[phys(n + L)] = make_float2(0.f, 0.f); }
    } else {
      u16* HYT = (u16*)(p.ws + O_HYT);
#pragma unroll
      for (int ch = 0; ch < 2; ++ch) {
        float r0[8], r1[8];
#pragma unroll
        for (int e = 0; e < 8; ++e) {
          int n = ch * 4096 + tid * 8 + e;
          float2 cv = s[phys(n)], y1 = scr[24576 + n], x2 = scr[16384 + n];
          r0[e] = x2.x * (cv.x * invN + y1.x * bias);
          r1[e] = x2.y * (cv.y * invN + y1.y * bias);
        }
        *(uint4*)(HYT + ((size_t)(2 * bp) * 256 + c) * L + ch * 4096 + tid * 8) = make_uint4(pack2(r0[0], r0[1]), pack2(r0[2], r0[3]), pack2(r0[4], r0[5]), pack2(r0[6], r0[7]));
        *(uint4*)(HYT + ((size_t)(2 * bp + 1) * 256 + c) * L + ch * 4096 + tid * 8) = make_uint4(pack2(r1[0], r1[1]), pack2(r1[2], r1[3]), pack2(r1[4], r1[5]), pack2(r1[6], r1[7]));
      }
    }
  }
  __syncthreads();
}

DI void fourier_out(const float2* s, u16* FMT, int m, int tid) {
  const float sc = 0.0013810679320049757f;
  const int col2 = (m == 0) ? 32 : 64 - m;
#pragma unroll
  for (int ch = 0; ch < 2; ++ch) {
    const int k0 = ch * 4096 + tid * 8;
    float v[8], vm[8];
#pragma unroll
    for (int e = 0; e < 8; ++e) {
      int k = k0 + e;
      float2 zp = s[phys((int)(__brev((unsigned)k) >> 19))];
      float2 zn = s[phys((int)(__brev((unsigned)((L - k) & (L - 1))) >> 19))];
      if (m == 0) { v[e] = 0.5f * (zp.x + zn.x) * sc; vm[e] = 0.5f * (zp.y + zn.y) * sc; }
      else { v[e] = zp.x * sc; vm[e] = zn.x * sc; }
    }
    *(uint4*)(FMT + (size_t)m * L + k0) = make_uint4(pack2(v[0], v[1]), pack2(v[2], v[3]), pack2(v[4], v[5]), pack2(v[6], v[7]));
    *(uint4*)(FMT + (size_t)col2 * L + k0) = make_uint4(pack2(vm[0], vm[1]), pack2(vm[2], vm[3]), pack2(vm[4], vm[5]), pack2(vm[6], vm[7]));
  }
}

DI void fourier_lat_item(const P& p, int b, int g, int mp, unsigned char* lds) {
  const int tid = otid();
  const int m0 = 2 * mp, m1 = m0 + 1;
  float2* s0 = (float2*)lds;
  float2* s1 = s0 + 8704;
  float2* tw = (float2*)(lds + 2 * 8704 * 8);
  __syncthreads();
  if (tid < 64) { float f = (float)tid * (1.f / 64.f); tw[tid] = make_float2(cos_t(f), -sin_t(f)); }
  __syncthreads();
  {
    const u16* ZT = (const u16*)(p.ws + O_ZT) + ((size_t)b * 1024 + g * 64) * L + tid * 8;
    float re0[16], im0[16], re1[16], im1[16];
#pragma unroll
    for (int i = 0; i < 16; ++i) { re0[i] = 0.f; im0[i] = 0.f; re1[i] = 0.f; im1[i] = 0.f; }
#pragma unroll 4
    for (int j = 0; j < 64; ++j) {
      float2 t0 = tw[(m0 * j) & 63];
      if (m0 == 0) t0 = make_float2(1.f, (j & 1) ? -1.f : 1.f);
      const float2 t1 = tw[(m1 * j) & 63];
#pragma unroll
      for (int c = 0; c < 2; ++c) {
        uint4 v = *(const uint4*)(ZT + (size_t)j * L + c * 4096);
        float x[8] = {lo16(v.x), hi16(v.x), lo16(v.y), hi16(v.y), lo16(v.z), hi16(v.z), lo16(v.w), hi16(v.w)};
#pragma unroll
        for (int e = 0; e < 8; ++e) {
          re0[c * 8 + e] += x[e] * t0.x; im0[c * 8 + e] += x[e] * t0.y;
          re1[c * 8 + e] += x[e] * t1.x; im1[c * 8 + e] += x[e] * t1.y;
        }
      }
    }
#pragma unroll
    for (int i = 0; i < 16; ++i) {
      const int n = (i >> 3) * 4096 + tid * 8 + (i & 7);
      s0[phys(n)] = make_float2(re0[i], im0[i]);
      s1[phys(n)] = make_float2(re1[i], im1[i]);
    }
  }
  fft_lds<8192, false>(s0);
  fft_lds<8192, false>(s1);
  u16* FMT = (u16*)(p.ws + O_FMT) + ((size_t)b * 256 + g * 64) * L;
  fourier_out(s0, FMT, m0, tid);
  fourier_out(s1, FMT, m1, tid);
  __syncthreads();
}

DI void transpose_job(const P& p, int job, unsigned char* lds) {
  const int tid = otid();
  const int which = job >> 9, b = (job >> 7) & 3, nt = job & 127;
  const u16* src = (const u16*)(p.ws + (which ? O_HYT : O_FMT)) + (size_t)b * 256 * L + nt * 64;
  u16* dst = (u16*)(p.ws + (which ? O_HY : O_FM)) + ((size_t)b * L + nt * 64) * 256;
  u16* sm = (u16*)lds;
  __syncthreads();
  {
    const int c = tid >> 1, half = tid & 1;
    const uint4* sp = (const uint4*)(src + (size_t)c * L + half * 32);
#pragma unroll
    for (int q = 0; q < 4; ++q) {
      uint4 v = sp[q];
      unsigned wds[4] = {v.x, v.y, v.z, v.w};
#pragma unroll
      for (int e = 0; e < 4; ++e) {
        int n = half * 32 + q * 8 + 2 * e;
        sm[n * 264 + c] = (u16)(wds[e] & 0xffffu);
        sm[(n + 1) * 264 + c] = (u16)(wds[e] >> 16);
      }
    }
  }
  __syncthreads();
#pragma unroll
  for (int i = 0; i < 4; ++i) {
    int id = tid + NT * i, n = id >> 5, cc = id & 31;
    uint4 v = *(const uint4*)(sm + n * 264 + cc * 8);
    *(uint4*)(dst + (size_t)n * 256 + cc * 8) = v;
  }
}

DI void fourier_ctx_item(const P& p, int b, int g, int mc, unsigned char* lds) {
  const int tid = otid();
  const u16* PROJ = (const u16*)(p.ws + O_PROJ);
  float* u = (float*)lds;
  float2* ab = (float2*)(lds + 256 * 65 * 4);
  float2* tw64 = ab + 256 * 16;
  float2* tw256 = tw64 + 64;
  __syncthreads();
  if (tid < 64) { float f = (float)tid * (1.f / 64.f); tw64[tid] = make_float2(cos_t(f), -sin_t(f)); }
  if (tid < 256) { float f = (float)tid * (1.f / 256.f); tw256[tid] = make_float2(cos_t(f), -sin_t(f)); }
  for (int i = tid; i < 256 * 64; i += NT) { int n = i >> 6, j = i & 63; u[n * 65 + j] = bf2f(PROJ[(size_t)(T + b * LC + n) * NC + g * 64 + j]); }
  __syncthreads();
  for (int i = tid; i < 256 * 16; i += NT) {
    int n = i >> 4, mm = i & 15, m = mc * 16 + mm;
    float re = 0.f, im = 0.f;
    for (int j = 0; j < 64; ++j) { float2 t = tw64[(m * j) & 63]; float x = u[n * 65 + j]; re += x * t.x; im += x * t.y; }
    ab[n * 16 + mm] = make_float2(re, im);
  }
  __syncthreads();
  u16* FM = (u16*)(p.ws + O_FM);
  for (int i = tid; i < 256 * 16; i += NT) {
    int k = i >> 4, mm = i & 15;
    float y = 0.f;
    for (int n = 0; n < 256; ++n) { float2 t = tw256[(k * n) & 255]; float2 z = ab[n * 16 + mm]; y += z.x * t.x - z.y * t.y; }
    FM[(size_t)(T + b * LC + k) * 256 + g * 64 + mc * 16 + mm] = f2bf(y * (1.f / 128.f));
  }
  __syncthreads();
}

DI void hyena_ctx_item(const P& p, int l, int c, unsigned char* lds) {
  const int tid = otid();
  const u16* PROJ = (const u16*)(p.ws + O_PROJ);
  float* f0 = (float*)lds; float* f1 = f0 + 512; float* sv = f1 + 512;
  const float* FC = (const float*)(p.ws + O_FILTC);
  __syncthreads();
  f0[tid] = FC[(size_t)(0 * 256 + c) * 512 + tid];
  f1[tid] = FC[(size_t)(1 * 256 + c) * 512 + tid];
  const float* cw = p.in[I_HCW] + l * 3 * 768; const float* cb = p.in[I_HCB] + l * 768;
  const float bias0 = p.in[I_HBIAS][l * 512 + c], bias1 = p.in[I_HBIAS][l * 512 + 256 + c];
  const int bb = tid >> 8, t = tid & 255;
  u16* HY = (u16*)(p.ws + O_HY);
  for (int pass = 0; pass < 2; ++pass) {
    int b = pass * 2 + bb;
    size_t rb = (size_t)T + b * LC;
    float o[3];
#pragma unroll
    for (int k = 0; k < 3; ++k) {
      int col = k * 256 + c; float a = cb[col];
#pragma unroll
      for (int j = 0; j < 3; ++j) { int nn = t + j - 1; if (nn >= 0 && nn < LC) a += cw[j * 768 + col] * zval(PROJ, rb, nn, col); }
      o[k] = a;
    }
    __syncthreads();
    sv[bb * 256 + t] = o[0];
    __syncthreads();
    float a = 0.f;
    for (int s2 = 0; s2 < 256; ++s2) a += f0[(t - s2) & 511] * sv[bb * 256 + s2];
    float y1 = o[1] * (a + o[0] * bias0);
    __syncthreads();
    sv[bb * 256 + t] = y1;
    __syncthreads();
    float a2 = 0.f;
    for (int s2 = 0; s2 < 256; ++s2) a2 += f1[(t - s2) & 511] * sv[bb * 256 + s2];
    HY[(rb + t) * 256 + c] = f2bf(o[2] * (a2 + y1 * bias1));
  }
  __syncthreads();
}

#ifndef ATT_KT_PRAGMA
#define ATT_KT_PRAGMA _Pragma("unroll 1")
#endif
#ifndef ATT_SB
#define ATT_SB __builtin_amdgcn_sched_barrier(0)
#endif
constexpr int AT_KB = 64 * G_AST, AT_VB = 128 * G_AST, AT_STAGE = 2 * AT_KB + AT_VB;

DI void attn_item(const P& p, int l, int b, int h, int qpos0, int key0, int nkeys, int out_row0, unsigned char* lds,
                  float lam, float lam_init) {
  const int tid = otid(), lane = tid & 63, w = tid >> 6, r = lane & 31, hh = lane >> 5;
  const u16* QN = (const u16*)(p.ws + O_QN) + (size_t)(b * 8 + h * 2) * LK * 64;
  const u16* KN = (const u16*)(p.ws + O_KN) + (size_t)(b * 8 + h * 2) * LK * 64;
  const u16* VT = (const u16*)(p.ws + O_VT) + (size_t)(b * 512 + h * 128) * LK;
  unsigned char* qs = lds + 2 * AT_STAGE + w * (64 * G_AST);
  __syncthreads();
#pragma unroll
  for (int i = 0; i < 8; ++i) {
    int id = lane + 64 * i, m = id >> 8, row = (id >> 3) & 31, ch = id & 7;
    uint4 v = *(const uint4*)(QN + (size_t)m * LK * 64 + (size_t)(qpos0 + w * 32 + row) * 64 + ch * 8);
    *(uint4*)(qs + (m * 32 + row) * G_AST + ch * 16) = v;
  }
  const unsigned char* qrd = qs + r * G_AST + hh * 16;
  f32x16 O[2][4];
#pragma unroll
  for (int m = 0; m < 2; ++m)
#pragma unroll
    for (int vt = 0; vt < 4; ++vt)
#pragma unroll
      for (int i = 0; i < 16; ++i) O[m][vt][i] = 0.f;
  float lsum[2] = {0.f, 0.f};
  const int ntiles = nkeys >> 6;
  const u16* kbase0 = KN + (size_t)key0 * 64;
  const u16* vbase0 = VT + key0;
  {
    const unsigned koff = tid * 8;
    const unsigned voff = (tid >> 3) * LK + (tid & 7) * 8;
    const int kw = (tid >> 3) * G_AST + (tid & 7) * 16;
    uint4 rk0 = *(const uint4*)(kbase0 + koff), rk1 = *(const uint4*)(kbase0 + (size_t)LK * 64 + koff);
    uint4 rv0 = *(const uint4*)(vbase0 + voff), rv1 = *(const uint4*)(vbase0 + (size_t)64 * LK + voff);
    __syncthreads();
    *(uint4*)(lds + kw) = rk0; *(uint4*)(lds + AT_KB + kw) = rk1;
    *(uint4*)(lds + 2 * AT_KB + kw) = rv0; *(uint4*)(lds + 2 * AT_KB + 64 * G_AST + kw) = rv1;
  }
  __syncthreads();
  for (int t = 0; t < ntiles; ++t) {
    const bool more = t + 1 < ntiles;
    const unsigned char* st = lds + (t & 1) * AT_STAGE;
    uint4 rk0, rk1, rv0, rv1;
    if (more) {
      const int tid2 = otid();
      const unsigned koff = tid2 * 8, voff = (tid2 >> 3) * LK + (tid2 & 7) * 8;
      const u16* kb_ = kbase0 + (size_t)(t + 1) * 4096;
      const u16* vb_ = vbase0 + (t + 1) * 64;
      rk0 = *(const uint4*)(kb_ + koff); rk1 = *(const uint4*)(kb_ + (size_t)LK * 64 + koff);
      rv0 = *(const uint4*)(vb_ + voff); rv1 = *(const uint4*)(vb_ + (size_t)64 * LK + voff);
    }
    __builtin_amdgcn_sched_barrier(0);
ATT_KT_PRAGMA
    for (int kt = 0; kt < 2; ++kt) {
      {
        const unsigned char* kb = st + (kt * 32 + r) * G_AST + hh * 16;
        const unsigned char* vb = st + 2 * AT_KB + r * G_AST + (kt * 32 + 8 * hh) * 2;
        f32x16 S0, S1;
#pragma unroll
        for (int i = 0; i < 16; ++i) { S0[i] = 0.f; S1[i] = 0.f; }
        bf16x8 k0 = *(const bf16x8*)(kb), k1 = *(const bf16x8*)(kb + 32), k2 = *(const bf16x8*)(kb + 64), k3 = *(const bf16x8*)(kb + 96);
        bf16x8 q0 = *(const bf16x8*)(qrd), q1 = *(const bf16x8*)(qrd + 32), q2 = *(const bf16x8*)(qrd + 64), q3 = *(const bf16x8*)(qrd + 96);
        __builtin_amdgcn_sched_barrier(0);
        S0 = MFMA16(k0, q0, S0); S0 = MFMA16(k1, q1, S0); S0 = MFMA16(k2, q2, S0); S0 = MFMA16(k3, q3, S0);
        __builtin_amdgcn_sched_barrier(0);
        k0 = *(const bf16x8*)(kb + AT_KB); k1 = *(const bf16x8*)(kb + AT_KB + 32);
        q0 = *(const bf16x8*)(qrd + 32 * G_AST); q1 = *(const bf16x8*)(qrd + 32 * G_AST + 32);
        S1 = MFMA16(k0, q0, S1); S1 = MFMA16(k1, q1, S1);
        k0 = *(const bf16x8*)(kb + AT_KB + 64); k1 = *(const bf16x8*)(kb + AT_KB + 96);
        q0 = *(const bf16x8*)(qrd + 32 * G_AST + 64); q1 = *(const bf16x8*)(qrd + 32 * G_AST + 96);
        S1 = MFMA16(k0, q0, S1); S1 = MFMA16(k1, q1, S1);
        float ls0 = 0.f;
#pragma unroll
        for (int i = 0; i < 16; ++i) { S0[i] = __builtin_amdgcn_exp2f(S0[i]); ls0 += S0[i]; }
        lsum[0] += ls0;
        bf16x8 pa0 = __builtin_bit_cast(bf16x8, make_uint4(pack2(S0[0], S0[1]), pack2(S0[2], S0[3]), pack2(S0[4], S0[5]), pack2(S0[6], S0[7])));
        bf16x8 pb0 = __builtin_bit_cast(bf16x8, make_uint4(pack2(S0[8], S0[9]), pack2(S0[10], S0[11]), pack2(S0[12], S0[13]), pack2(S0[14], S0[15])));
        __builtin_amdgcn_sched_barrier(0);
        bf16x8 v0 = *(const bf16x8*)(vb), v1 = *(const bf16x8*)(vb + 32 * G_AST), v2 = *(const bf16x8*)(vb + 64 * G_AST), v3 = *(const bf16x8*)(vb + 96 * G_AST);
        O[0][0] = MFMA16(v0, pa0, O[0][0]); O[0][1] = MFMA16(v1, pa0, O[0][1]); O[0][2] = MFMA16(v2, pa0, O[0][2]); O[0][3] = MFMA16(v3, pa0, O[0][3]);
        float ls1 = 0.f;
#pragma unroll
        for (int i = 0; i < 16; ++i) { S1[i] = __builtin_amdgcn_exp2f(S1[i]); ls1 += S1[i]; }
        lsum[1] += ls1;
        bf16x8 pa1 = __builtin_bit_cast(bf16x8, make_uint4(pack2(S1[0], S1[1]), pack2(S1[2], S1[3]), pack2(S1[4], S1[5]), pack2(S1[6], S1[7])));
        bf16x8 pb1 = __builtin_bit_cast(bf16x8, make_uint4(pack2(S1[8], S1[9]), pack2(S1[10], S1[11]), pack2(S1[12], S1[13]), pack2(S1[14], S1[15])));
        __builtin_amdgcn_sched_barrier(0);
        bf16x8 w0 = *(const bf16x8*)(vb + 32), w1 = *(const bf16x8*)(vb + 32 * G_AST + 32), w2 = *(const bf16x8*)(vb + 64 * G_AST + 32), w3 = *(const bf16x8*)(vb + 96 * G_AST + 32);
        O[0][0] = MFMA16(w0, pb0, O[0][0]); O[0][1] = MFMA16(w1, pb0, O[0][1]); O[0][2] = MFMA16(w2, pb0, O[0][2]); O[0][3] = MFMA16(w3, pb0, O[0][3]);
        O[1][0] = MFMA16(v0, pa1, O[1][0]); O[1][1] = MFMA16(v1, pa1, O[1][1]); O[1][2] = MFMA16(v2, pa1, O[1][2]); O[1][3] = MFMA16(v3, pa1, O[1][3]);
        O[1][0] = MFMA16(w0, pb1, O[1][0]); O[1][1] = MFMA16(w1, pb1, O[1][1]); O[1][2] = MFMA16(w2, pb1, O[1][2]); O[1][3] = MFMA16(w3, pb1, O[1][3]);
        ATT_SB;
      }
    }
    if (more) {
      const int tid3 = otid();
      const int kw = (tid3 >> 3) * G_AST + (tid3 & 7) * 16;
      unsigned char* nb = lds + ((t + 1) & 1) * AT_STAGE;
      *(uint4*)(nb + kw) = rk0; *(uint4*)(nb + AT_KB + kw) = rk1;
      *(uint4*)(nb + 2 * AT_KB + kw) = rv0; *(uint4*)(nb + 2 * AT_KB + 64 * G_AST + kw) = rv1;
    }
    __syncthreads();
  }
  float l0 = lsum[0] + shx(lsum[0], 32), l1 = lsum[1] + shx(lsum[1], 32);
  float i0 = 1.f / l0, i1 = lam / l1;
  float ssq = 0.f;
#pragma unroll
  for (int vt = 0; vt < 4; ++vt)
#pragma unroll
    for (int i = 0; i < 16; ++i) { float o = O[0][vt][i] * i0 - O[1][vt][i] * i1; O[0][vt][i] = o; ssq += o * o; }
  ssq += shx(ssq, 32);
  float rn = rsqrtf(ssq * (1.f / 128.f) + 1e-5f) * (1.f - lam_init);
  const float* sg = p.in[I_SUBG] + l * 128;
  u16* OO = (u16*)(p.ws + O_O) + (size_t)(out_row0 + w * 32 + r) * 512 + h * 128;
#pragma unroll
  for (int vt = 0; vt < 4; ++vt)
#pragma unroll
    for (int g4 = 0; g4 < 4; ++g4) {
      int e0 = 32 * vt + 8 * g4 + 4 * hh;
      float4 gv = *(const float4*)(sg + e0);
      *(uint2*)(OO + e0) = make_uint2(pack2(O[0][vt][4 * g4] * rn * gv.x, O[0][vt][4 * g4 + 1] * rn * gv.y),
                                      pack2(O[0][vt][4 * g4 + 2] * rn * gv.z, O[0][vt][4 * g4 + 3] * rn * gv.w));
    }
}

DI void attn_phase(const P& p, int l, unsigned char* lds) {
  const int lane = otid() & 63;
  float s0 = p.in[I_LAMQ][l * 128 + lane] * p.in[I_LAMK][l * 128 + lane];
  float s1 = p.in[I_LAMQ][l * 128 + 64 + lane] * p.in[I_LAMK][l * 128 + 64 + lane];
  s0 = wave_sum(s0); s1 = wave_sum(s1);
  const float lam_init = lam_init_of(l);
  const float lam = __expf(s0) - __expf(s1) + lam_init;
  const int n_lat = NB * 4 * (L / 256), n_ctx = (l == 0) ? NB * 4 : 0, n_att = n_lat + n_ctx;
  const int n_hy = 512, n_fm = 16 * 16, n_fc = (l == 0) ? 64 : 0, n_hc = (l == 0) ? 256 : 0;
  const int total = n_att + n_hy + n_fm + n_fc + n_hc;
  for (int it = blockIdx.x; it < total; it += gridDim.x) {
    int k = it;
    if (k < n_att) {
      int b, h, qpos0, key0, nkeys, orow;
      if (k < n_lat) { int qb = k & 31, bh = k >> 5; b = bh >> 2; h = bh & 3; qpos0 = qb * 256; key0 = 0; nkeys = LK; orow = b * L + qb * 256; }
      else { int bh = k - n_lat; b = bh >> 2; h = bh & 3; qpos0 = L; key0 = L; nkeys = LC; orow = T + b * LC; }
      attn_item(p, l, b, h, qpos0, key0, nkeys, orow, lds, lam, lam_init);
      continue;
    }
    k -= n_att;
    if (k < n_hy) { hyena_lat_item(p, l, k >> 1, k & 1, lds); continue; }
    k -= n_hy;
    if (k < n_fm) { fourier_lat_item(p, k >> 6, (k >> 4) & 3, k & 15, lds); continue; }
    k -= n_fm;
    if (k < n_fc) { fourier_ctx_item(p, k >> 4, (k >> 2) & 3, k & 3, lds); continue; }
    k -= n_fc;
    hyena_ctx_item(p, l, k, lds);
  }
}

DI void transpose_phase(const P& p, unsigned char* lds) {
  for (int it = blockIdx.x; it < 1024; it += gridDim.x) transpose_job(p, it, lds);
}

DI void merge_phase(const P& p, int l, int rows, unsigned char* lds) {
  u16* MG = (u16*)(p.ws + O_MERGED);
  const unsigned char* WL = p.ws + O_WT + l * WL_SIZE;
  const int tid = otid(), lane = tid & 63, w = tid >> 6, r = lane & 31, hh = lane >> 5, wm = w >> 1, wn = w & 1;
  for_tiles(rows / 256, D / 128, [&](int tm_, int tn_) {
    int m0 = tm_ * 256, n0 = tn_ * 128;
    f32x16 tot[2][2]; acc_zero(tot);
#pragma unroll 1
    for (int br = 0; br < 3; ++br) {
      const u16* A = (const u16*)(p.ws + (br == 0 ? O_FM : br == 1 ? O_HY : O_O));
      const int K = br == 2 ? 512 : 256;
      const u16* Wt = (const u16*)(WL + (br == 0 ? WL_WF : br == 1 ? WL_WH : WL_WA));
      const u16* ap[4]; const u16* bp[2];
      set_ap(ap, A, K, m0); set_bp(bp, Wt, K, n0);
      f32x16 acc[2][2]; acc_zero(acc);
      gemm_main(acc, ap, bp, K, lds);
      size_t fb = ((((size_t)tm_ * 8 + tn_) * 8 + w) * 16) * 64 + lane;
      asm volatile("" : "+v"(fb));
      const u16* gf = (const u16*)(p.ws + O_GF) + (size_t)br * TA * 1024;
#pragma unroll
      for (int mt = 0; mt < 2; ++mt)
#pragma unroll
        for (int nt = 0; nt < 2; ++nt)
#pragma unroll
          for (int g4 = 0; g4 < 4; ++g4) {
            uint2 gv = *(const uint2*)(gf + (fb + (size_t)(((mt * 2 + nt) * 4 + g4) * 64)) * 4);
            tot[mt][nt][4 * g4] += lo16(gv.x) * acc[mt][nt][4 * g4];
            tot[mt][nt][4 * g4 + 1] += hi16(gv.x) * acc[mt][nt][4 * g4 + 1];
            tot[mt][nt][4 * g4 + 2] += lo16(gv.y) * acc[mt][nt][4 * g4 + 2];
            tot[mt][nt][4 * g4 + 3] += hi16(gv.y) * acc[mt][nt][4 * g4 + 3];
          }
    }
    u16* pm = MG + (size_t)(m0 + wm * 64 + 4 * hh) * D + n0 + wn * 64 + r;
#pragma unroll
    for (int mt = 0; mt < 2; ++mt)
#pragma unroll
      for (int nt = 0; nt < 2; ++nt)
#pragma unroll
        for (int i = 0; i < 16; ++i)
          pm[(size_t)(mt * 32 + 8 * (i >> 2) + (i & 3)) * D + nt * 32] = f2bf(tot[mt][nt][i]);
  });
}

DI void wo_phase(const P& p, int l, int rows, unsigned char* lds) {
  const u16* MG = (const u16*)(p.ws + O_MERGED);
  const u16* Wt = (const u16*)(p.ws + O_WT + l * WL_SIZE + WL_WO);
  float* XA = (float*)(p.ws + O_XA);
  const float* MOD = (const float*)(p.ws + O_MOD) + l * 5 * 6144;
  const int lane = otid() & 63, w = otid() >> 6, r = lane & 31, hh = lane >> 5, wm = w >> 1, wn = w & 1;
  for_tiles(rows / 256, D / 128, [&](int tm_, int tn_) {
    int m0 = tm_ * 256, n0 = tn_ * 128;
    const u16* ap[4]; const u16* bp[2];
    set_ap(ap, MG, D, m0); set_bp(bp, Wt, D, n0);
    f32x16 acc[2][2]; acc_zero(acc);
    gemm_main(acc, ap, bp, D, lds);
#pragma unroll
    for (int mt = 0; mt < 2; ++mt)
#pragma unroll
      for (int nt = 0; nt < 2; ++nt)
#pragma unroll
        for (int i = 0; i < 16; ++i) {
          int row = m0 + wm * 64 + mt * 32 + crow(i, hh), col = n0 + wn * 64 + nt * 32 + r;
          float xin;
          if (l == 0) xin = row < T ? p.in[I_X][(size_t)row * D + col] : p.in[I_CTX][(size_t)(row - T) * D + col];
          else xin = XA[(size_t)row * D + col];
          int mr = row < T ? (row >> 13) : 4;
          XA[(size_t)row * D + col] = xin + MOD[mr * 6144 + 2 * 1024 + col] * acc[mt][nt][i];
        }
  });
}

DI void router_phase(const P& p, int l, int ntok, unsigned char* lds) {
  const int tid = otid(), lane = tid & 63, w = tid >> 6, r = lane & 31, hh = lane >> 5;
  float* tile = (float*)lds;
  int* lcnt = (int*)(lds + 32 * 1025 * 4);
  const float* XA = (const float*)(p.ws + O_XA);
  const float* MOD = (const float*)(p.ws + O_MOD) + l * 5 * 6144;
  u16* H = (u16*)(p.ws + O_H);
  const float* wr = p.in[I_WR] + (size_t)l * 1024 * 32;
  const float* br = p.in[I_BR] + l * 32;
  int* TOKE = (int*)(p.ws + O_TOKE); float* TOKG = (float*)(p.ws + O_TOKG); int* TOKLP = (int*)(p.ws + O_TOKLP);
  const int per = ntok / gridDim.x;
  const int tbase = blockIdx.x * per;
  __syncthreads();
  if (tid < 32) lcnt[tid] = 0;
  __syncthreads();
  for (int c0 = 0; c0 < per; c0 += 32) {
#pragma unroll 2
    for (int q = 0; q < 4; ++q) {
      int tl = w * 4 + q;
      int tok = tbase + c0 + tl;
      bool valid = (c0 + tl) < per;
      if (!valid) tok = tbase;
      const float* xr = XA + (size_t)tok * D;
      int mr = tok < T ? (tok >> 13) : 4;
      float xv[16];
#pragma unroll
      for (int i = 0; i < 4; ++i) { float4 v = *(const float4*)(xr + (i * 64 + lane) * 4); xv[4 * i] = v.x; xv[4 * i + 1] = v.y; xv[4 * i + 2] = v.z; xv[4 * i + 3] = v.w; }
      float ss = 0.f;
#pragma unroll
      for (int i = 0; i < 16; ++i) ss += xv[i] * xv[i];
      ss = wave_sum(ss);
      float rinv = rsqrtf(ss * (1.f / 1024.f) + 1e-6f);
      const float* g = p.in[I_N2G] + l * 1024; const float* sh = MOD + mr * 6144 + 3 * 1024; const float* sc = MOD + mr * 6144 + 4 * 1024;
#pragma unroll
      for (int i = 0; i < 4; ++i) {
        int c = (i * 64 + lane) * 4;
        float4 gv = *(const float4*)(g + c), shv = *(const float4*)(sh + c), scv = *(const float4*)(sc + c);
        float h0 = xv[4 * i] * rinv * gv.x * (1.f + scv.x) + shv.x;
        float h1 = xv[4 * i + 1] * rinv * gv.y * (1.f + scv.y) + shv.y;
        float h2 = xv[4 * i + 2] * rinv * gv.z * (1.f + scv.z) + shv.z;
        float h3 = xv[4 * i + 3] * rinv * gv.w * (1.f + scv.w) + shv.w;
        float* tr = tile + tl * 1025 + c;
        tr[0] = h0; tr[1] = h1; tr[2] = h2; tr[3] = h3;
        if (valid) *(uint2*)(H + boff(tok, c, 1024)) = make_uint2(pack2(h0, h1), pack2(h2, h3));
      }
    }
    __syncthreads();
    f32x16 acc;
#pragma unroll
    for (int i = 0; i < 16; ++i) acc[i] = 0.f;
    {
      const float* ar = tile + r * 1025 + w * 128 + hh;
      const float* brp = wr + (size_t)(w * 128 + hh) * 32 + r;
#pragma unroll 8
      for (int s2 = 0; s2 < 64; ++s2) acc = __builtin_amdgcn_mfma_f32_32x32x2f32(ar[2 * s2], brp[(size_t)2 * s2 * 32], acc, 0, 0, 0);
    }
    __syncthreads();
    float* part = tile;
#pragma unroll
    for (int i = 0; i < 16; ++i) part[(w * 32 + crow(i, hh)) * 33 + r] = acc[i];
    __syncthreads();
#pragma unroll
    for (int q = 0; q < 4; ++q) {
      int tl = w * 4 + q;
      int tok = tbase + c0 + tl;
      bool valid = (c0 + tl) < per;
      float v = br[r];
#pragma unroll
      for (int k = 0; k < 8; ++k) v += part[(k * 32 + tl) * 33 + r];
      int se[4]; float sv[4];
#pragma unroll
      for (int k = 0; k < 4; ++k) {
        float m = wave_max(v);
        unsigned long long mask = __ballot(v == m);
        int idx = __ffsll((long long)mask) - 1;
        se[k] = idx & 31; sv[k] = m;
        if (r == (idx & 31)) v = -3.0e38f;
      }
      float e1 = __expf(sv[1] - sv[0]), e2 = __expf(sv[2] - sv[0]), e3 = __expf(sv[3] - sv[0]);
      float inv = 1.f / (1.f + e1 + e2 + e3);
      if (valid && lane < 4) {
        int e = lane == 0 ? se[0] : lane == 1 ? se[1] : lane == 2 ? se[2] : se[3];
        float gt = (lane == 0 ? 1.f : lane == 1 ? e1 : lane == 2 ? e2 : e3) * inv;
        int lp = atomicAdd(&lcnt[e], 1);
        TOKE[tok * 4 + lane] = e; TOKG[tok * 4 + lane] = gt; TOKLP[tok * 4 + lane] = lp;
      }
    }
    __syncthreads();
  }
  if (tid < 32) ((int*)(p.ws + O_CNT))[blockIdx.x * 32 + tid] = lcnt[tid];
  __syncthreads();
}

DI void slot_phase(const P& p, int ntok, unsigned char* lds) {
  const int tid = otid();
  int* cnt = (int*)lds;
  const int G = gridDim.x;
  int* total = cnt + G * 32; int* base = total + 32; int* pstart = base + 32; int* padded = pstart + 40;
  const int* CNT = (const int*)(p.ws + O_CNT);
  __syncthreads();
  for (int i = tid; i < G * 32; i += NT) cnt[i] = CNT[i];
  __syncthreads();
  if (tid < 32) {
    int s = 0, bsum = 0;
    for (int b = 0; b < G; ++b) { int v = cnt[b * 32 + tid]; if (b < (int)blockIdx.x) bsum += v; s += v; }
    total[tid] = s; base[tid] = bsum; padded[tid] = (s + 255) & ~255;
  }
  __syncthreads();
  if (tid == 0) { int a = 0; for (int e = 0; e < 32; ++e) { pstart[e] = a; a += padded[e]; } pstart[32] = a; }
  __syncthreads();
  int* TOKE = (int*)(p.ws + O_TOKE); int* TOKLP = (int*)(p.ws + O_TOKLP); int* TOKSLOT = (int*)(p.ws + O_TOKSLOT);
  int* ROWTOK = (int*)(p.ws + O_ROWTOK); int* TILEE = (int*)(p.ws + O_TILEE);
  const int per = ntok / G, tbase = blockIdx.x * per;
  for (int i = tid; i < per * 4; i += NT) {
    int idx = tbase * 4 + i;
    int e = TOKE[idx];
    int slot = pstart[e] + base[e] + TOKLP[idx];
    TOKSLOT[idx] = slot; ROWTOK[slot] = idx >> 2;
  }
  if (blockIdx.x < 32) {
    int e = blockIdx.x;
    for (int s2 = pstart[e] + total[e] + tid; s2 < pstart[e] + padded[e]; s2 += NT) ROWTOK[s2] = 0;
  }
  if (blockIdx.x == 0) {
    int nt = pstart[32] >> 8;
    if (tid == 0) TILEE[1023] = nt;
    for (int i = tid; i < nt; i += NT) {
      int row = i << 8, e = 0;
      for (int k = 1; k < 32; ++k) if (row >= pstart[k]) e = k;
      TILEE[i] = e;
    }
  }
  __syncthreads();
}

DI void moe1_phase(const P& p, int l, unsigned char* lds) {
  const u16* H = (const u16*)(p.ws + O_H);
  u16* ACT = (u16*)(p.ws + O_PROJ);
  const int* ROWTOK = (const int*)(p.ws + O_ROWTOK); const int* TILEE = (const int*)(p.ws + O_TILEE);
  const int ntm = TILEE[1023];
  const int tid = otid(), lane = tid & 63, w = tid >> 6, r = lane & 31, hh = lane >> 5, wm = w >> 2, wn = w & 3;
  for_tiles(ntm, 8, [&](int mt_, int tn_) {
    int n0 = tn_ * 256, m0 = mt_ * 256, e = TILEE[mt_];
    const u16* Wt = (const u16*)(p.ws + O_WT + l * WL_SIZE + WL_WE1) + (size_t)e * 2048 * 1024;
    const u16* ap[4];
#pragma unroll
    for (int i = 0; i < 4; ++i) ap[i] = H + boff(ROWTOK[m0 + (tid >> 3) + 64 * i], (tid & 7) * 8, 1024);
    const u16* b0p = Wt + (size_t)tn_ * 16 * 16384 + tid * 8;
    f32x16 acc[4][2]; acc_zero4(acc);
    gemm256(acc, ap, b0p, D, lds);
    const int j = (n0 >> 1) + wn * 32 + r;
    const float* b1 = p.in[I_BE1] + (size_t)(l * 32 + e) * 2048;
    const float bg = b1[2 * j], bl = b1[2 * j + 1];
    u16* abase = ACT + boff(m0 + wm * 128 + 4 * hh, j, 1024);
#pragma unroll
    for (int mt = 0; mt < 4; ++mt)
#pragma unroll
      for (int i = 0; i < 16; ++i) {
        float ug = fminf(acc[mt][0][i] + bg, 7.f);
        float ul = fminf(fmaxf(acc[mt][1][i] + bl, -7.f), 7.f);
        float a = ug * sigmoidf_(1.702f * ug) * (ul + 1.f);
        abase[(mt * 32 + 8 * (i >> 2) + (i & 3)) * 64] = f2bf(a);
      }
  });
}

DI void moe2_phase(const P& p, int l, unsigned char* lds) {
  const u16* ACT = (const u16*)(p.ws + O_PROJ);
  u16* Y = (u16*)(p.ws + O_Y);
  const int* TILEE = (const int*)(p.ws + O_TILEE);
  const int ntm = TILEE[1023];
  const int tid = otid(), lane = tid & 63, w = tid >> 6, r = lane & 31, hh = lane >> 5, wm = w >> 2, wn = w & 3;
  for_tiles(ntm, 4, [&](int mt_, int tn_) {
    int n0 = tn_ * 256, m0 = mt_ * 256, e = TILEE[mt_];
    const u16* Wt = (const u16*)(p.ws + O_WT + l * WL_SIZE + WL_WE2) + (size_t)e * 1024 * 1024;
    const u16* ap[4];
#pragma unroll
    for (int i = 0; i < 4; ++i) ap[i] = ACT + (size_t)mt_ * 16 * 16384 + tid * 8 + i * 4096;
    const u16* b0p = Wt + (size_t)tn_ * 16 * 16384 + tid * 8;
    f32x16 acc[4][2]; acc_zero4(acc);
    gemm256(acc, ap, b0p, 1024, lds);
    const float* b2 = p.in[I_BE2] + (size_t)(l * 32 + e) * 1024;
    u16* ybase = Y + (size_t)(m0 + wm * 128 + 4 * hh) * 1024 + n0 + wn * 64 + r;
#pragma unroll
    for (int nt = 0; nt < 2; ++nt) {
      float bv = b2[n0 + wn * 64 + nt * 32 + r];
#pragma unroll
      for (int mt = 0; mt < 4; ++mt)
#pragma unroll
        for (int i = 0; i < 16; ++i)
          ybase[(size_t)(mt * 32 + 8 * (i >> 2) + (i & 3)) * 1024 + nt * 32] = f2bf(acc[mt][nt][i] + bv);
    }
  });
}

DI void combine_phase(const P& p, int l, int ntok) {
  const int lane = otid() & 63, gw = blockIdx.x * (NT / 64) + (otid() >> 6), nw = gridDim.x * (NT / 64);
  float* XA = (float*)(p.ws + O_XA);
  const float* MOD = (const float*)(p.ws + O_MOD) + l * 5 * 6144;
  const float* MODN = (const float*)(p.ws + O_MOD) + (l + 1) * 5 * 6144;
  const u16* Y = (const u16*)(p.ws + O_Y);
  const int* TOKSLOT = (const int*)(p.ws + O_TOKSLOT); const float* TOKG = (const float*)(p.ws + O_TOKG);
  u16* H = (u16*)(p.ws + O_H);
  for (int row = gw; row < ntok; row += nw) {
    int mr = row < T ? (row >> 13) : 4;
    int4 sl = *(const int4*)(TOKSLOT + row * 4);
    float4 gt = *(const float4*)(TOKG + row * 4);
    float xv[16];
#pragma unroll
    for (int i = 0; i < 4; ++i) {
      int c = (i * 64 + lane) * 4;
      float4 x = *(const float4*)(XA + (size_t)row * D + c);
      float4 m5 = *(const float4*)(MOD + mr * 6144 + 5 * 1024 + c);
      uint2 y0 = *(const uint2*)(Y + (size_t)sl.x * 1024 + c), y1 = *(const uint2*)(Y + (size_t)sl.y * 1024 + c);
      uint2 y2 = *(const uint2*)(Y + (size_t)sl.z * 1024 + c), y3 = *(const uint2*)(Y + (size_t)sl.w * 1024 + c);
      float a0 = gt.x * lo16(y0.x) + gt.y * lo16(y1.x) + gt.z * lo16(y2.x) + gt.w * lo16(y3.x);
      float a1 = gt.x * hi16(y0.x) + gt.y * hi16(y1.x) + gt.z * hi16(y2.x) + gt.w * hi16(y3.x);
      float a2 = gt.x * lo16(y0.y) + gt.y * lo16(y1.y) + gt.z * lo16(y2.y) + gt.w * lo16(y3.y);
      float a3 = gt.x * hi16(y0.y) + gt.y * hi16(y1.y) + gt.z * hi16(y2.y) + gt.w * hi16(y3.y);
      xv[4 * i] = x.x + m5.x * a0; xv[4 * i + 1] = x.y + m5.y * a1; xv[4 * i + 2] = x.z + m5.z * a2; xv[4 * i + 3] = x.w + m5.w * a3;
      float4 o = make_float4(xv[4 * i], xv[4 * i + 1], xv[4 * i + 2], xv[4 * i + 3]);
      if (l == 1) *(float4*)(p.out + (size_t)row * D + c) = o;
      else *(float4*)(XA + (size_t)row * D + c) = o;
    }
    if (l == 0) norm_mod_store(xv, p.in[I_N1G] + 1024, MODN + mr * 6144, MODN + mr * 6144 + 1024, H, row, lane);
  }
}


#define XB_TMO      128
#define XB_XCNT(j)  (256  + 64 * (j))
#define XB_XSUB(j)  (1280 + 64 * (j))
#define XB_XGEN(j)  (2304 + 64 * (j))
#define XB_TOP      3328
#define XB_TOPGEN   3392
#define XCD_BAR_WORDS 3456
#define XB_SPIN_CAP (1u << 22)
#define LAS __attribute__((address_space(3)))
DI unsigned xb_ld(unsigned* p) { return __hip_atomic_load(p, __ATOMIC_RELAXED, __HIP_MEMORY_SCOPE_AGENT); }
DI unsigned xb_add(unsigned* p, unsigned v) { return __hip_atomic_fetch_add(p, v, __ATOMIC_RELAXED, __HIP_MEMORY_SCOPE_AGENT); }
DI unsigned xb_xcc_id() { return (unsigned)__builtin_amdgcn_s_getreg((3 << 11) | 20) & 0xFu; }
#define XB_SPIN(cond, bar) do { unsigned _sp = 0; while (cond) { __builtin_amdgcn_s_sleep(1); \
    if ((++_sp & 255u) == 0u) { if (xb_ld(&(bar)[XB_TMO])) break; if (_sp > XB_SPIN_CAP) { atomicAdd(&(bar)[XB_TMO], 1u); break; } } } } while (0)
struct XcdBarrier { unsigned* bar; unsigned x; volatile LAS unsigned* st; };
DI XcdBarrier xcd_barrier_post(unsigned* bar, volatile LAS unsigned* st) {
  XcdBarrier b; b.bar = bar; b.x = xb_xcc_id(); b.st = st;
  if (threadIdx.x == 0) (void)xb_add(&bar[XB_XCNT(b.x)], 1u);
  return b;
}
DI void xcd_barrier_complete(unsigned* bar, unsigned x, unsigned& nloc, unsigned& nx) {
  const unsigned G = gridDim.x * gridDim.y * gridDim.z;
  unsigned sum, cnt, mine, sp = 0u;
  for (;;) {
    sum = 0u; cnt = 0u; mine = 0u;
#pragma unroll
    for (unsigned j = 0; j < 16; ++j) { const unsigned c = xb_ld(&bar[XB_XCNT(j)]); sum += c; cnt += (c > 0u) ? 1u : 0u; mine = (j == x) ? c : mine; }
    if (sum == G) break;
    __builtin_amdgcn_s_sleep(1);
    if ((++sp & 255u) == 0u) { if (xb_ld(&bar[XB_TMO])) break; if (sp > XB_SPIN_CAP) { atomicAdd(&bar[XB_TMO], 1u); break; } }
  }
  nloc = mine > 0u ? mine : 1u; nx = cnt > 0u ? cnt : 1u;
}
DI void xcd_barrier(const XcdBarrier& b) {
  asm volatile("s_waitcnt vmcnt(0)" ::: "memory");
  __syncthreads();
  if (threadIdx.x == 0) {
    unsigned* bar = b.bar;
    __builtin_amdgcn_s_waitcnt(0);
    unsigned nloc = b.st[0], nx = b.st[1];
    if (nloc == 0u) { xcd_barrier_complete(bar, b.x, nloc, nx); b.st[0] = nloc; b.st[1] = nx; }
    const unsigned old = xb_add(&bar[XB_XSUB(b.x)], 1u);
    const unsigned gen = old / nloc;
    if (old + 1u == (gen + 1u) * nloc) {
      __builtin_amdgcn_fence(__ATOMIC_RELEASE, "agent");
      asm volatile("s_waitcnt vmcnt(0)" ::: "memory");
      const unsigned og = xb_add(&bar[XB_TOP], 1u);
      const unsigned tg = og / nx;
      if (og + 1u == (tg + 1u) * nx) xb_add(&bar[XB_TOPGEN], 1u);
      else XB_SPIN(xb_ld(&bar[XB_TOPGEN]) == tg, bar);
      __builtin_amdgcn_fence(__ATOMIC_ACQUIRE, "agent");
      xb_add(&bar[XB_XGEN(b.x)], 1u);
      asm volatile("s_waitcnt vmcnt(0)" ::: "memory");
    } else {
      XB_SPIN(xb_ld(&bar[XB_XGEN(b.x)]) == gen, bar);
      __builtin_amdgcn_fence(__ATOMIC_ACQUIRE, "agent");
      asm volatile("s_waitcnt vmcnt(0)" ::: "memory");
    }
  }
  __syncthreads();
}

#ifndef PM
#define PM 0xFFFF
#endif
#ifndef REP
#define REP 0
#endif
#define RUNP(bit, call) do { call; if (REP & (1 << (bit))) { GSYNC(); call; } } while (0)
__global__ void __launch_bounds__(NT) fwd_megakernel(P p) {
  cg::grid_group grid = cg::this_grid();
  extern __shared__ __attribute__((aligned(16))) unsigned char lds[];
  if (p.ws_size < WS_NEED) { if (blockIdx.x == 0 && otid() == 0) p.out[0] = 1e30f; return; }
  volatile LAS unsigned* xst = (volatile LAS unsigned*)(lds + LDS_BYTES - 16);
  if (threadIdx.x < 2) xst[threadIdx.x] = 0u;
  __syncthreads();
  (void)xcd_barrier_post((unsigned*)(p.ws + O_BAR), xst);
#define GSYNC() do { XcdBarrier xb_; unsigned* bp_ = (unsigned*)(p.ws + O_BAR); asm volatile("" : "+s"(bp_)); xb_.bar = bp_; xb_.x = xb_xcc_id(); \
    xb_.st = (volatile LAS unsigned*)(lds + LDS_BYTES - 16); xcd_barrier(xb_); } while (0)

  for (int rep = 0; rep < 1 + ((REP >> 0) & 1); ++rep) {
    if (rep) GSYNC();
    for (int l = 0; l < 2; ++l) {
      unsigned char* WL = p.ws + O_WT + l * WL_SIZE;
      convT(p.in[I_WE1] + (size_t)l * 32 * 1024 * 2048, 1024, 2048, (u16*)(WL + WL_WE1), 32, true, (float*)lds, 256);
      convT(p.in[I_WE2] + (size_t)l * 32 * 1024 * 1024, 1024, 1024, (u16*)(WL + WL_WE2), 32, false, (float*)lds, 256);
      convT(p.in[I_WIN] + (size_t)l * 1024 * NC, 1024, NC, (u16*)(WL + WL_WIN), 1, false, (float*)lds, 256);
      convT(p.in[I_WO] + (size_t)l * 1024 * 1024, 1024, 1024, (u16*)(WL + WL_WO), 1, false, (float*)lds);
      convT(p.in[I_WA] + (size_t)l * 512 * 1024, 512, 1024, (u16*)(WL + WL_WA), 1, false, (float*)lds);
      convT(p.in[I_WF] + (size_t)l * 256 * 1024, 256, 1024, (u16*)(WL + WL_WF), 1, false, (float*)lds);
      convT(p.in[I_WH] + (size_t)l * 256 * 1024, 256, 1024, (u16*)(WL + WL_WH), 1, false, (float*)lds);
    }
    mod_phase(p, (float*)lds);
    z2_phase(p, (float*)lds);
  }
  grid.sync();
  RUNP(1, filter_phase(p, lds));
  norm1_layer0(p);
  GSYNC();

  for (int l = 0; l < 2; ++l) {
    const int rows = (l == 0) ? TA : T;
    RUNP(2, g1_phase(p, l, lds));
    GSYNC();
    RUNP(4, attn_phase(p, l, lds));
    GSYNC();
    transpose_phase(p, lds);
    GSYNC();
    RUNP(5, merge_phase(p, l, rows, lds));
    GSYNC();
    if (PM & 256) wo_phase(p, l, rows, lds);
    GSYNC();
    RUNP(6, router_phase(p, l, rows, lds));
    GSYNC();
    RUNP(6, slot_phase(p, rows, lds));
    GSYNC();
    RUNP(7, moe1_phase(p, l, lds));
    GSYNC();
    RUNP(8, moe2_phase(p, l, lds));
    GSYNC();
    if (PM & 8192) combine_phase(p, l, rows);
    if (l == 0) GSYNC();
  }
}

extern "C" void kernel_launch(void* const* d_in, const int* in_sizes, int n_in, void* d_out, int out_size,
                              void* d_ws, size_t ws_size, hipStream_t stream) {
  static int grid_blocks = 0;
  if (!grid_blocks) {
    int dev = 0, cus = 0, per_cu = 0;
    (void)hipGetDevice(&dev);
    (void)hipDeviceGetAttribute(&cus, hipDeviceAttributeMultiprocessorCount, dev);
    if (hipFuncSetAttribute((const void*)fwd_megakernel, hipFuncAttributeMaxDynamicSharedMemorySize, LDS_BYTES) != hipSuccess)
      fprintf(stderr, "hipFuncSetAttribute failed\n");
    (void)hipOccupancyMaxActiveBlocksPerMultiprocessor(&per_cu, (const void*)fwd_megakernel, NT, LDS_BYTES);
    if (per_cu < 1) per_cu = 1;
    grid_blocks = cus * per_cu;
    if (grid_blocks > 256) grid_blocks = 256;
    if (grid_blocks != 256) fprintf(stderr, "unexpected grid %d\n", grid_blocks);
    fprintf(stderr, "grid %d (cus %d per_cu %d) ws %zu need %zu\n", grid_blocks, cus, per_cu, ws_size, (size_t)WS_NEED);
  }
  P p{};
  for (int i = 0; i < 35 && i < n_in; ++i) p.in[i] = (const float*)d_in[i];
  p.out = (float*)d_out;
  p.ws = (unsigned char*)d_ws;
  p.ws_size = (unsigned long long)ws_size;
  (void)hipMemsetAsync((unsigned char*)d_ws + O_BAR, 0, XCD_BAR_WORDS * 4, stream);
  void* args[] = {&p};
  hipError_t e = hipLaunchCooperativeKernel((void*)fwd_megakernel, dim3(grid_blocks), dim3(NT), args, LDS_BYTES, stream);
  if (e != hipSuccess) fprintf(stderr, "cooperative launch failed: %s (grid %d)\n", hipGetErrorString(e), grid_blocks);
}
```

```cpp
#include <hip/hip_runtime.h>
#include <hip/hip_cooperative_groups.h>
#include <cstdio>
namespace cg = cooperative_groups;

#define DI __device__ __forceinline__
typedef unsigned short u16;
typedef __attribute__((ext_vector_type(8))) short bf16x8;
typedef __attribute__((ext_vector_type(4))) short s16x4;
typedef __attribute__((ext_vector_type(16))) float f32x16;
typedef __bf16 bf2_t __attribute__((ext_vector_type(2)));
typedef float fl2_t __attribute__((ext_vector_type(2)));
#define MFMA16(a, b, c) __builtin_amdgcn_mfma_f32_32x32x16_bf16((a), (b), (c), 0, 0, 0)

constexpr int NT = 512;
constexpr int LDS_BYTES = 160 * 1024;
constexpr int NB = 4, L = 8192, D = 1024, T = NB * L, LC = 256, TC = NB * LC, TA = T + TC;
constexpr int NC = 5632, OFF_HY = 256, OFF_Q = 1024, OFF_V = 2048, OFF_G = 2560;
constexpr int LK = L + LC;
constexpr int NR = TA * 4 + 32 * 256;
constexpr float LOG2E = 1.4426950408889634f;

constexpr size_t WL_WIN = 0;
constexpr size_t WL_WF = WL_WIN + (size_t)NC * D * 2;
constexpr size_t WL_WH = WL_WF + (size_t)D * 256 * 2;
constexpr size_t WL_WA = WL_WH + (size_t)D * 256 * 2;
constexpr size_t WL_WO = WL_WA + (size_t)D * 512 * 2;
constexpr size_t WL_WE1 = WL_WO + (size_t)D * D * 2;
constexpr size_t WL_WE2 = WL_WE1 + (size_t)32 * 2048 * 1024 * 2;
constexpr size_t WL_SIZE = WL_WE2 + (size_t)32 * 1024 * 1024 * 2;
constexpr size_t O_WT = 0;
constexpr size_t O_MOD = O_WT + 2 * WL_SIZE;
constexpr size_t O_Z2 = O_MOD + 2 * 5 * 6144 * 4;
constexpr size_t O_Z2C = O_Z2 + (size_t)2 * L * 64 * 4;
constexpr size_t O_SPEC = O_Z2C + (size_t)LC * 64 * 4;
constexpr size_t O_FILTC = O_SPEC + (size_t)2 * 2 * 256 * 16384 * 8;
constexpr size_t O_XA = O_FILTC + (size_t)2 * 256 * 512 * 4;
constexpr size_t O_H = O_XA + (size_t)TA * D * 4;
constexpr size_t O_PROJ = O_H + (size_t)TA * D * 2;
constexpr size_t O_QN = O_PROJ + (size_t)TA * NC * 2;
constexpr size_t O_KN = O_QN + (size_t)NB * 4 * 2 * LK * 64 * 2;
constexpr size_t O_VT = O_KN + (size_t)NB * 4 * 2 * LK * 64 * 2;
constexpr size_t O_FM = O_VT + (size_t)NB * 4 * 128 * LK * 2;
constexpr size_t O_HY = O_FM + (size_t)TA * 256 * 2;
constexpr size_t O_O = O_HY + (size_t)TA * 256 * 2;
constexpr size_t O_MERGED = O_O + (size_t)TA * 512 * 2;
constexpr size_t O_HYSCR = O_MERGED + (size_t)TA * D * 2;
constexpr size_t O_YEND0 = O_HYSCR + (size_t)256 * 4 * 8192 * 8;
constexpr size_t O_Y = O_QN;
constexpr size_t Y_BYTES = (size_t)NR * D * 2;
constexpr size_t O_SMALL = (O_YEND0 > O_Y + Y_BYTES) ? O_YEND0 : (O_Y + Y_BYTES);
constexpr size_t O_TOKE = O_SMALL;
constexpr size_t O_TOKG = O_TOKE + (size_t)TA * 16;
constexpr size_t O_TOKLP = O_TOKG + (size_t)TA * 16;
constexpr size_t O_TOKSLOT = O_TOKLP + (size_t)TA * 16;
constexpr size_t O_CNT = O_TOKSLOT + (size_t)TA * 16;
constexpr size_t O_ROWTOK = O_CNT + 256 * 32 * 4;
constexpr size_t O_TILEE = O_ROWTOK + (size_t)NR * 4;
constexpr size_t O_ZT = O_TILEE + 4096;
constexpr size_t O_GF = O_ZT + (size_t)NB * 1024 * L * 2;
constexpr size_t O_FMT = O_GF + (size_t)3 * TA * 1024 * 2;
constexpr size_t O_HYT = O_FMT + (size_t)NB * 256 * L * 2;
constexpr size_t O_BAR = O_HYT + (size_t)NB * 256 * L * 2;
constexpr size_t WS_NEED = O_BAR + 16384;
static_assert((size_t)NR * D * 2 <= (size_t)TA * NC * 2, "ACT must fit in PROJ");

struct P {
  const float* in[35];
  float* out;
  unsigned char* ws;
  unsigned long long ws_size;
};
enum { I_X = 0, I_C, I_CTX, I_CCTX, I_WMOD, I_BMOD, I_N1G, I_N2G, I_WIN, I_HCW, I_HCB, I_HW1, I_HB1, I_HF1, I_HW2, I_HB2,
       I_HF2, I_HW3, I_HB3, I_HBIAS, I_QNG, I_KNG, I_LAMQ, I_LAMK, I_SUBG, I_WF, I_WH, I_WA, I_WO, I_WR, I_BR, I_WE1, I_BE1, I_WE2, I_BE2 };

DI float bf2f(u16 v) { return __uint_as_float(((unsigned)v) << 16); }
DI unsigned pack2(float a, float b) { fl2_t f = {a, b}; bf2_t r = __builtin_convertvector(f, bf2_t); return __builtin_bit_cast(unsigned, r); }
DI u16 f2bf(float a) { return (u16)(pack2(a, 0.f) & 0xffffu); }
DI float lo16(unsigned u) { return __uint_as_float(u << 16); }
DI float hi16(unsigned u) { return __uint_as_float(u & 0xffff0000u); }
DI float sin_t(float turns) { return __builtin_amdgcn_sinf(__builtin_amdgcn_fractf(turns)); }
DI float cos_t(float turns) { return __builtin_amdgcn_cosf(__builtin_amdgcn_fractf(turns)); }
DI int otid() { int t = threadIdx.x; asm volatile("" : "+v"(t)); return t; }
DI float shx(float v, int o) { int lane = otid() & 63; return __builtin_bit_cast(float, __builtin_amdgcn_ds_bpermute((lane ^ o) << 2, __builtin_bit_cast(int, v))); }
DI float wave_sum(float v) { for (int o = 32; o >= 1; o >>= 1) v += shx(v, o); return v; }
DI float wave_max(float v) { for (int o = 32; o >= 1; o >>= 1) v = fmaxf(v, shx(v, o)); return v; }
DI float sigmoidf_(float x) { return 1.f / (1.f + __expf(-x)); }
DI size_t boff(int row, int k, int K) { return ((size_t)(row >> 8) * (K >> 6) + (k >> 6)) * 16384 + (row & 255) * 64 + (k & 63); }
DI size_t boff128(int row, int k, int K) { return ((size_t)(row >> 7) * (K >> 6) + (k >> 6)) * 8192 + (row & 127) * 64 + (k & 63); }
DI int crow(int i, int hh) { return (i & 3) + 8 * (i >> 2) + 4 * hh; }
DI float lam_init_of(int l) { return l == 0 ? 0.2f : 0.35550906f; }

DI float block_sum(float v, float* red) {
  v = wave_sum(v);
  __syncthreads();
  if ((otid() & 63) == 0) red[otid() >> 6] = v;
  __syncthreads();
  float s = 0.f;
  for (int i = 0; i < NT / 64; ++i) s += red[i];
  return s;
}

DI int phys(int p) { return p + (p >> 4); }
DI float2 cmul(float2 a, float2 b) { return make_float2(a.x * b.x - a.y * b.y, a.x * b.y + a.y * b.x); }

template <int N, bool INV>
DI void fft_lds(float2* s) {
  constexpr int LG = (N == 16384) ? 14 : (N == 8192) ? 13 : 9;
  const int tid = otid();
  if (!INV) {
    if (LG & 1) {
      __syncthreads();
      constexpr int h = N / 2;
#pragma unroll 4
      for (int j = tid; j < h; j += NT) {
        float f = (float)j * (1.0f / N);
        float2 w = make_float2(cos_t(f), -sin_t(f));
        float2 a = s[phys(j)], b = s[phys(j + h)];
        s[phys(j)] = make_float2(a.x + b.x, a.y + b.y);
        s[phys(j + h)] = cmul(make_float2(a.x - b.x, a.y - b.y), w);
      }
    }
    for (int lq = (LG & 1) ? LG - 3 : LG - 2; lq >= 0; lq -= 2) {
      const int q = 1 << lq;
      __syncthreads();
      const float inv4q = 1.0f / (float)(4 * q);
#pragma unroll 4
      for (int it = 0; it < N / 4 / NT; ++it) {
        int idx = tid + it * NT;
        int j = idx & (q - 1), blk = idx >> lq;
        int p0 = blk * 4 * q + j;
        float f = (float)j * inv4q;
        float2 t1 = make_float2(cos_t(f), -sin_t(f));
        float2 t2 = cmul(t1, t1);
        float2 x0 = s[phys(p0)], x1 = s[phys(p0 + q)], x2 = s[phys(p0 + 2 * q)], x3 = s[phys(p0 + 3 * q)];
        float2 a0 = make_float2(x0.x + x2.x, x0.y + x2.y);
        float2 a2 = cmul(make_float2(x0.x - x2.x, x0.y - x2.y), t1);
        float2 a1 = make_float2(x1.x + x3.x, x1.y + x3.y);
        float2 d3 = make_float2(x1.x - x3.x, x1.y - x3.y);
        float2 a3 = cmul(make_float2(d3.y, -d3.x), t1);
        s[phys(p0)] = make_float2(a0.x + a1.x, a0.y + a1.y);
        s[phys(p0 + q)] = cmul(make_float2(a0.x - a1.x, a0.y - a1.y), t2);
        s[phys(p0 + 2 * q)] = make_float2(a2.x + a3.x, a2.y + a3.y);
        s[phys(p0 + 3 * q)] = cmul(make_float2(a2.x - a3.x, a2.y - a3.y), t2);
      }
    }
  } else {
    constexpr int top = (LG & 1) ? N / 8 : N / 4;
    for (int lq = 0; (1 << lq) <= top; lq += 2) {
      const int q = 1 << lq;
      __syncthreads();
      const float inv4q = 1.0f / (float)(4 * q);
#pragma unroll 4
      for (int it = 0; it < N / 4 / NT; ++it) {
        int idx = tid + it * NT;
        int j = idx & (q - 1), blk = idx >> lq;
        int p0 = blk * 4 * q + j;
        float f = (float)j * inv4q;
        float2 t1 = make_float2(cos_t(f), sin_t(f));
        float2 t2 = cmul(t1, t1);
        float2 x0 = s[phys(p0)], x1 = s[phys(p0 + q)], x2 = s[phys(p0 + 2 * q)], x3 = s[phys(p0 + 3 * q)];
        float2 b = cmul(x1, t2);
        float2 a0 = make_float2(x0.x + b.x, x0.y + b.y), a1 = make_float2(x0.x - b.x, x0.y - b.y);
        b = cmul(x3, t2);
        float2 a2 = make_float2(x2.x + b.x, x2.y + b.y), a3 = make_float2(x2.x - b.x, x2.y - b.y);
        b = cmul(a2, t1);
        s[phys(p0)] = make_float2(a0.x + b.x, a0.y + b.y);
        s[phys(p0 + 2 * q)] = make_float2(a0.x - b.x, a0.y - b.y);
        float2 c3 = cmul(a3, t1);
        b = make_float2(-c3.y, c3.x);
        s[phys(p0 + q)] = make_float2(a1.x + b.x, a1.y + b.y);
        s[phys(p0 + 3 * q)] = make_float2(a1.x - b.x, a1.y - b.y);
      }
    }
    if (LG & 1) {
      __syncthreads();
      constexpr int h = N / 2;
#pragma unroll 4
      for (int j = tid; j < h; j += NT) {
        float f = (float)j * (1.0f / N);
        float2 w = make_float2(cos_t(f), sin_t(f));
        float2 a = s[phys(j)], b = cmul(s[phys(j + h)], w);
        s[phys(j)] = make_float2(a.x + b.x, a.y + b.y);
        s[phys(j + h)] = make_float2(a.x - b.x, a.y - b.y);
      }
    }
  }
  __syncthreads();
}

DI void convT(const float* __restrict__ src, int K, int N, u16* __restrict__ dst, int nbatch, bool perm, float* sm, int blockR = 0) {
  const int tk = K / 64, tn = N / 256, per = tk * tn, total = per * nbatch;
  const int tid = otid();
  for (int t = blockIdx.x; t < total; t += gridDim.x) {
    int bt = t / per, rr = t % per, kt = rr / tn, nt = rr % tn;
    const float* sp = src + (size_t)bt * K * N + (size_t)(kt * 64) * N + nt * 256;
    u16* dp = dst + (size_t)bt * K * N;
    int kr = tid >> 3, c8 = (tid & 7) * 8;
    float4 a[4], b[4];
#pragma unroll
    for (int q = 0; q < 4; ++q) {
      a[q] = *(const float4*)(sp + (size_t)kr * N + q * 64 + c8);
      b[q] = *(const float4*)(sp + (size_t)kr * N + q * 64 + c8 + 4);
    }
    __syncthreads();
#pragma unroll
    for (int q = 0; q < 4; ++q) {
      float* row = sm + kr * 257 + q * 64 + c8;
      row[0] = a[q].x; row[1] = a[q].y; row[2] = a[q].z; row[3] = a[q].w; row[4] = b[q].x; row[5] = b[q].y; row[6] = b[q].z; row[7] = b[q].w;
    }
    __syncthreads();
#pragma unroll
    for (int q = 0; q < 4; ++q) {
      int n = (tid >> 3) + 64 * q, k8 = (tid & 7) * 8;
      float v[8];
#pragma unroll
      for (int j = 0; j < 8; ++j) v[j] = sm[(k8 + j) * 257 + n];
      int ng = nt * 256 + n;
      if (perm) { int j2 = ng >> 1; ng = (j2 >> 5) * 64 + ((ng & 1) ? 32 : 0) + (j2 & 31); }
      uint4 o = make_uint4(pack2(v[0], v[1]), pack2(v[2], v[3]), pack2(v[4], v[5]), pack2(v[6], v[7]));
      size_t doff = blockR == 256 ? boff(ng, kt * 64 + k8, K) : blockR == 128 ? boff128(ng, kt * 64 + k8, K) : (size_t)ng * K + kt * 64 + k8;
      *(uint4*)(dp + doff) = o;
    }
  }
  __syncthreads();
}

DI void mod_phase(const P& p, float* sm) {
  const int tid = otid();
  float* sl = sm;
  float* red = sm + 5 * 1024;
  __syncthreads();
  for (int i = tid; i < 5 * 1024; i += NT) {
    int r = i >> 10, d = i & 1023;
    float c = (r < 4) ? p.in[I_C][r * 1024 + d] : p.in[I_CCTX][d];
    sl[i] = c / (1.f + __expf(-c));
  }
  __syncthreads();
  float* MOD = (float*)(p.ws + O_MOD);
  for (int it = blockIdx.x; it < 2 * 96; it += gridDim.x) {
    int l = it / 96, c0 = (it % 96) * 64;
    int col = tid & 63, ds = tid >> 6;
    const float* w = p.in[I_WMOD] + (size_t)l * 1024 * 6144 + c0 + col;
    float acc[5] = {0.f, 0.f, 0.f, 0.f, 0.f};
    for (int d = ds * 128; d < ds * 128 + 128; ++d) {
      float wv = w[(size_t)d * 6144];
#pragma unroll
      for (int r = 0; r < 5; ++r) acc[r] += sl[r * 1024 + d] * wv;
    }
    __syncthreads();
#pragma unroll
    for (int r = 0; r < 5; ++r) red[(ds * 5 + r) * 64 + col] = acc[r];
    __syncthreads();
    if (tid < 320) {
      int r = tid >> 6, cc = tid & 63;
      float s = 0.f;
      for (int k = 0; k < 8; ++k) s += red[(k * 5 + r) * 64 + cc];
      MOD[(l * 5 + r) * 6144 + c0 + cc] = s + p.in[I_BMOD][l * 6144 + c0 + cc];
    }
  }
  __syncthreads();
}

DI void z2_phase(const P& p, float* sm) {
  const int tid = otid();
  const int tt = tid >> 6, j = tid & 63;
  float* emb = sm;
  float* z1 = sm + 8 * 33;
  const int n_lat = L / 8, n_ctx = LC / 8;
  for (int it = blockIdx.x; it < 2 * n_lat + n_ctx; it += gridDim.x) {
    int l, Lf, t0; float* dst;
    if (it < 2 * n_lat) { l = it / n_lat; Lf = L; t0 = (it % n_lat) * 8; dst = (float*)(p.ws + O_Z2) + (size_t)l * L * 64; }
    else { l = 0; Lf = LC; t0 = (it - 2 * n_lat) * 8; dst = (float*)(p.ws + O_Z2C); }
    int t = t0 + tt;
    __syncthreads();
    if (j < 33) {
      float v;
      if (j == 0) v = (float)t / (float)(Lf - 1);
      else {
        int k = (j - 1) & 15;
        float band = 1e-4f + (float)k * ((15.f - 1e-4f) / 15.f);
        float turns = band * ((float)t / (float)Lf);
        v = (j <= 16) ? cos_t(turns) : -sin_t(turns);
      }
      emb[tt * 33 + j] = v;
    }
    __syncthreads();
    const float* w1 = p.in[I_HW1] + l * 33 * 64;
    float a = p.in[I_HB1][l * 64 + j];
    for (int i = 0; i < 33; ++i) a += emb[tt * 33 + i] * w1[i * 64 + j];
    z1[tt * 64 + j] = sin_t(p.in[I_HF1][l * 64 + j] * a * 0.15915494309189535f);
    __syncthreads();
    const float* w2 = p.in[I_HW2] + l * 64 * 64;
    float a2 = p.in[I_HB2][l * 64 + j];
    for (int i = 0; i < 64; ++i) a2 += z1[tt * 64 + i] * w2[i * 64 + j];
    dst[(size_t)t * 64 + j] = sin_t(p.in[I_HF2][l * 64 + j] * a2 * 0.15915494309189535f);
  }
  __syncthreads();
}

DI float hy_delta(int c) { return 4.605170185988091f * (1.f / 1.5f + (float)c * (1.f / 255.f) * (1.f / 0.3f - 1.f / 1.5f)); }

DI void filter_phase(const P& p, unsigned char* lds) {
  float2* s = (float2*)lds;
  float* w3s_ = (float*)(lds + 17408 * 8);
  float* red = w3s_ + 256;
  for (int it = blockIdx.x; it < 512 + 256; it += gridDim.x) {
    const int tid = otid();
    const bool lat = it < 512;
    const int l = lat ? (it >> 8) : 0, c = it & 255;
    const int Lf = lat ? L : LC;
    const float* z2 = lat ? (const float*)(p.ws + O_Z2) + (size_t)l * L * 64 : (const float*)(p.ws + O_Z2C);
    __syncthreads();
    if (tid < 256) {
      int od = tid >> 6, i = tid & 63;
      w3s_[tid] = p.in[I_HW3][(size_t)l * 64 * 1024 + i * 1024 + od * 256 + c];
    }
    __syncthreads();
    const float delta = hy_delta(c);
    float lsum0 = 0.f, lsum1 = 0.f;
    float2* park = (float2*)(p.ws + O_HYSCR) + (size_t)blockIdx.x * 4 * 8192;
#pragma unroll 1
    for (int k = 0; k < 16; ++k) {
      const int t = tid + k * NT;
      if (t < Lf) {
        const float4* zr = (const float4*)(z2 + (size_t)t * 64);
        const float* b3p = p.in[I_HB3] + l * 1024 + c;
        float a0 = b3p[0], a1 = b3p[256], a2 = b3p[512], a3 = b3p[768];
        const float* w3s = w3s_;
        asm volatile("" : "+v"(w3s));
#pragma unroll
        for (int i = 0; i < 16; ++i) {
          float4 z = zr[i];
          a0 += z.x * w3s[4 * i] + z.y * w3s[4 * i + 1] + z.z * w3s[4 * i + 2] + z.w * w3s[4 * i + 3];
          a1 += z.x * w3s[64 + 4 * i] + z.y * w3s[64 + 4 * i + 1] + z.z * w3s[64 + 4 * i + 2] + z.w * w3s[64 + 4 * i + 3];
          a2 += z.x * w3s[128 + 4 * i] + z.y * w3s[128 + 4 * i + 1] + z.z * w3s[128 + 4 * i + 2] + z.w * w3s[128 + 4 * i + 3];
          a3 += z.x * w3s[192 + 4 * i] + z.y * w3s[192 + 4 * i + 1] + z.z * w3s[192 + 4 * i + 2] + z.w * w3s[192 + 4 * i + 3];
        }
        float dec = __expf(-((float)t / (float)(Lf - 1)) * delta);
        a0 *= dec; a1 *= dec; a2 *= dec; a3 *= dec;
        s[phys(t)] = make_float2(a0, 0.f);
        lsum0 += fabsf(a0);
        lsum1 += fabsf(a2);
        if (t >= 1) { s[phys(2 * Lf - t)] = make_float2(a1, 0.f); lsum0 += fabsf(a1); lsum1 += fabsf(a3); }
        else s[phys(Lf)] = make_float2(0.f, 0.f);
        park[t] = make_float2(a2, a3);
      }
    }
#pragma unroll 1
    for (int o = 0; o < 2; ++o) {
      const int tid = otid();
      if (o == 1) {
        __syncthreads();
#pragma unroll 4
        for (int k = 0; k < 16; ++k) {
          const int t = tid + k * NT;
          if (t < Lf) {
            float2 pv = park[t];
            s[phys(t)] = make_float2(pv.x, 0.f);
            if (t >= 1) s[phys(2 * Lf - t)] = make_float2(pv.y, 0.f);
            else s[phys(Lf)] = make_float2(0.f, 0.f);
          }
        }
      }
      float tot = block_sum(o == 0 ? lsum0 : lsum1, red);
      float inv = 1.f / tot;
      if (lat) {
        fft_lds<16384, false>(s);
        float2* dst = (float2*)(p.ws + O_SPEC) + ((size_t)(l * 2 + o) * 256 + c) * 16384;
#pragma unroll 8
        for (int i = tid; i < 16384; i += NT) { float2 v = s[phys(i)]; dst[i] = make_float2(v.x * inv, v.y * inv); }
      } else {
        float* dst = (float*)(p.ws + O_FILTC) + (size_t)(o * 256 + c) * 512;
        dst[tid] = s[phys(tid)].x * inv;
      }
    }
  }
  __syncthreads();
}

DI void norm_mod_store(const float (&xv)[16], const float* g, const float* shift, const float* scale, u16* Hb, int row, int lane) {
  float ss = 0.f;
#pragma unroll
  for (int i = 0; i < 16; ++i) ss += xv[i] * xv[i];
  ss = wave_sum(ss);
  float rinv = rsqrtf(ss * (1.f / 1024.f) + 1e-6f);
#pragma unroll
  for (int i = 0; i < 4; ++i) {
    int c = (i * 64 + lane) * 4;
    float4 gv = *(const float4*)(g + c), sh = *(const float4*)(shift + c), sc = *(const float4*)(scale + c);
    float h0 = xv[4 * i] * rinv * gv.x * (1.f + sc.x) + sh.x;
    float h1 = xv[4 * i + 1] * rinv * gv.y * (1.f + sc.y) + sh.y;
    float h2 = xv[4 * i + 2] * rinv * gv.z * (1.f + sc.z) + sh.z;
    float h3 = xv[4 * i + 3] * rinv * gv.w * (1.f + sc.w) + sh.w;
    *(uint2*)(Hb + boff(row, c, 1024)) = make_uint2(pack2(h0, h1), pack2(h2, h3));
  }
}

DI void norm1_layer0(const P& p) {
  const int lane = otid() & 63, gw = blockIdx.x * (NT / 64) + (otid() >> 6), nw = gridDim.x * (NT / 64);
  const float* MOD = (const float*)(p.ws + O_MOD);
  u16* H = (u16*)(p.ws + O_H);
  for (int row = gw; row < TA; row += nw) {
    const float* xr = row < T ? p.in[I_X] + (size_t)row * D : p.in[I_CTX] + (size_t)(row - T) * D;
    int mr = row < T ? (row >> 13) : 4;
    float xv[16];
#pragma unroll
    for (int i = 0; i < 4; ++i) { float4 v = *(const float4*)(xr + (i * 64 + lane) * 4); xv[4 * i] = v.x; xv[4 * i + 1] = v.y; xv[4 * i + 2] = v.z; xv[4 * i + 3] = v.w; }
    norm_mod_store(xv, p.in[I_N1G], MOD + mr * 6144, MOD + mr * 6144 + 1024, H, row, lane);
  }
}

constexpr int G_AST = 144;
constexpr int G_ABYTES = 256 * G_AST, G_BBYTES = 128 * G_AST, G_STAGE = G_ABYTES + G_BBYTES;

#define G_LOADR(S, ko) do { S##0 = *(const uint4*)(a0p + (ko)); S##1 = *(const uint4*)(a1p + (ko)); S##2 = *(const uint4*)(a2p + (ko)); \
    S##3 = *(const uint4*)(a3p + (ko)); S##4 = *(const uint4*)(b0p + (ko)); S##5 = *(const uint4*)(b1p + (ko)); } while (0)
#define G_STORER(S, nb) do { *(uint4*)((nb) + wofs) = S##0; *(uint4*)((nb) + wofs + 64 * G_AST) = S##1; *(uint4*)((nb) + wofs + 128 * G_AST) = S##2; \
    *(uint4*)((nb) + wofs + 192 * G_AST) = S##3; *(uint4*)((nb) + G_ABYTES + wofs) = S##4; *(uint4*)((nb) + G_ABYTES + wofs + 64 * G_AST) = S##5; } while (0)

DI void gemm_compute(f32x16 (&acc)[2][2], const unsigned char* As, const unsigned char* Bs) {
  bf16x8 a0 = *(const bf16x8*)(As), a1 = *(const bf16x8*)(As + 32 * G_AST);
  bf16x8 b0 = *(const bf16x8*)(Bs), b1 = *(const bf16x8*)(Bs + 32 * G_AST);
#pragma unroll
  for (int ks = 0; ks < 4; ++ks) {
    bf16x8 na0 = a0, na1 = a1, nb0 = b0, nb1 = b1;
    if (ks < 3) {
      na0 = *(const bf16x8*)(As + (ks + 1) * 32); na1 = *(const bf16x8*)(As + 32 * G_AST + (ks + 1) * 32);
      nb0 = *(const bf16x8*)(Bs + (ks + 1) * 32); nb1 = *(const bf16x8*)(Bs + 32 * G_AST + (ks + 1) * 32);
    }
    acc[0][0] = MFMA16(a0, b0, acc[0][0]);
    acc[0][1] = MFMA16(a0, b1, acc[0][1]);
    acc[1][0] = MFMA16(a1, b0, acc[1][0]);
    acc[1][1] = MFMA16(a1, b1, acc[1][1]);
    a0 = na0; a1 = na1; b0 = nb0; b1 = nb1;
  }
}

DI void gemm_main(f32x16 (&acc)[2][2], const u16* const (&ap)[4], const u16* const (&bp)[2], int K, unsigned char* lds) {
  const int tid = otid(), lane = tid & 63, w = tid >> 6, r = lane & 31, hh = lane >> 5;
  const int wm = w >> 1, wn = w & 1;
  const int wofs = (tid >> 3) * G_AST + (tid & 7) * 16;
  const u16* a0p = ap[0]; const u16* a1p = ap[1]; const u16* a2p = ap[2]; const u16* a3p = ap[3];
  const u16* b0p = bp[0]; const u16* b1p = bp[1];
  uint4 P0, P1, P2, P3, P4, P5, Q0, Q1, Q2, Q3, Q4, Q5;
  G_LOADR(P, 0);
  G_LOADR(Q, 64);
  G_STORER(P, lds);
  __syncthreads();
  const unsigned char* As0 = lds + (wm * 64 + r) * G_AST + hh * 16;
  const unsigned char* Bs0 = lds + G_ABYTES + (wn * 64 + r) * G_AST + hh * 16;
  const int nk = K >> 6;
  for (int kt = 0; kt < nk; kt += 2) {
    if (kt + 2 < nk) G_LOADR(P, (kt + 2) * 64);
    __builtin_amdgcn_sched_barrier(0);
    gemm_compute(acc, As0, Bs0);
    __builtin_amdgcn_sched_barrier(0);
    G_STORER(Q, lds + G_STAGE);
    __syncthreads();
    if (kt + 3 < nk) G_LOADR(Q, (kt + 3) * 64);
    __builtin_amdgcn_sched_barrier(0);
    gemm_compute(acc, As0 + G_STAGE, Bs0 + G_STAGE);
    __builtin_amdgcn_sched_barrier(0);
    if (kt + 2 < nk) G_STORER(P, lds);
    __syncthreads();
  }
}

DI void acc_zero(f32x16 (&acc)[2][2]) {
#pragma unroll
  for (int a = 0; a < 2; ++a)
#pragma unroll
    for (int b = 0; b < 2; ++b)
#pragma unroll
      for (int i = 0; i < 16; ++i) acc[a][b][i] = 0.f;
}

constexpr int G2_ABYTES = 256 * G_AST, G2_STAGE = 2 * G2_ABYTES;
#define G2_LOADR(kt_) do { const size_t ko = (size_t)(kt_) * 16384; R0 = *(const uint4*)(a0p + ko); R1 = *(const uint4*)(a1p + ko); R2 = *(const uint4*)(a2p + ko); R3 = *(const uint4*)(a3p + ko); \
    R4 = *(const uint4*)(b0p + ko); R5 = *(const uint4*)(b0p + 4096 + ko); R6 = *(const uint4*)(b0p + 8192 + ko); R7 = *(const uint4*)(b0p + 12288 + ko); } while (0)
#define G2_STORER(nb) do { *(uint4*)((nb) + wofs) = R0; *(uint4*)((nb) + wofs + 64 * G_AST) = R1; *(uint4*)((nb) + wofs + 128 * G_AST) = R2; *(uint4*)((nb) + wofs + 192 * G_AST) = R3; \
    *(uint4*)((nb) + G2_ABYTES + wofs) = R4; *(uint4*)((nb) + G2_ABYTES + wofs + 64 * G_AST) = R5; *(uint4*)((nb) + G2_ABYTES + wofs + 128 * G_AST) = R6; \
    *(uint4*)((nb) + G2_ABYTES + wofs + 192 * G_AST) = R7; } while (0)

template <bool TR>
DI void gemm256_compute(f32x16 (&acc)[4][2], const unsigned char* As, const unsigned char* Bs) {
  __builtin_amdgcn_s_setprio(2);
  bf16x8 b0 = *(const bf16x8*)(Bs), b1 = *(const bf16x8*)(Bs + 32 * G_AST);
  bf16x8 a0 = *(const bf16x8*)(As), a1 = *(const bf16x8*)(As + 32 * G_AST), a2 = *(const bf16x8*)(As + 64 * G_AST), a3 = *(const bf16x8*)(As + 96 * G_AST);
#pragma unroll
  for (int ks = 0; ks < 4; ++ks) {
    bf16x8 nb0 = b0, nb1 = b1, na0 = a0, na1 = a1, na2 = a2, na3 = a3;
    if (ks < 3) {
      nb0 = *(const bf16x8*)(Bs + (ks + 1) * 32); nb1 = *(const bf16x8*)(Bs + 32 * G_AST + (ks + 1) * 32);
      na0 = *(const bf16x8*)(As + (ks + 1) * 32); na1 = *(const bf16x8*)(As + 32 * G_AST + (ks + 1) * 32);
      na2 = *(const bf16x8*)(As + 64 * G_AST + (ks + 1) * 32); na3 = *(const bf16x8*)(As + 96 * G_AST + (ks + 1) * 32);
    }
    if (TR) {
      acc[0][0] = MFMA16(b0, a0, acc[0][0]); acc[0][1] = MFMA16(b1, a0, acc[0][1]);
      acc[1][0] = MFMA16(b0, a1, acc[1][0]); acc[1][1] = MFMA16(b1, a1, acc[1][1]);
      acc[2][0] = MFMA16(b0, a2, acc[2][0]); acc[2][1] = MFMA16(b1, a2, acc[2][1]);
      acc[3][0] = MFMA16(b0, a3, acc[3][0]); acc[3][1] = MFMA16(b1, a3, acc[3][1]);
    } else {
      acc[0][0] = MFMA16(a0, b0, acc[0][0]); acc[0][1] = MFMA16(a0, b1, acc[0][1]);
      acc[1][0] = MFMA16(a1, b0, acc[1][0]); acc[1][1] = MFMA16(a1, b1, acc[1][1]);
      acc[2][0] = MFMA16(a2, b0, acc[2][0]); acc[2][1] = MFMA16(a2, b1, acc[2][1]);
      acc[3][0] = MFMA16(a3, b0, acc[3][0]); acc[3][1] = MFMA16(a3, b1, acc[3][1]);
    }
    if (ks < 3) {
      __builtin_amdgcn_sched_group_barrier(0x100, 6, 0);
      __builtin_amdgcn_sched_group_barrier(0x008, 8, 0);
    }
    b0 = nb0; b1 = nb1; a0 = na0; a1 = na1; a2 = na2; a3 = na3;
  }
  __builtin_amdgcn_s_setprio(0);
}

template <bool TR = false>
DI void gemm256(f32x16 (&acc)[4][2], const u16* const (&ap)[4], const u16* b0p, int K, unsigned char* lds) {
  const int tid = otid(), lane = tid & 63, w = tid >> 6, r = lane & 31, hh = lane >> 5;
  const int wm = w >> 2, wn = w & 3;
  const int wofs = (tid >> 3) * G_AST + (tid & 7) * 16;
  const u16* a0p = ap[0]; const u16* a1p = ap[1]; const u16* a2p = ap[2]; const u16* a3p = ap[3];
  uint4 R0, R1, R2, R3, R4, R5, R6, R7;
  const int nk = K >> 6;
  const bool late = w >= 4;
  G2_LOADR(0);
  G2_STORER(lds);
  if (late && nk > 1) G2_LOADR(1);
  __syncthreads();
  const unsigned char* As0 = lds + (wm * 128 + r) * G_AST + hh * 16;
  const unsigned char* Bs0 = lds + G2_ABYTES + (wn * 64 + r) * G_AST + hh * 16;
  if (!late) {
    for (int kt = 0; kt < nk; ++kt) {
      const bool more = kt + 1 < nk;
      if (more) G2_LOADR(kt + 1);
      __builtin_amdgcn_sched_barrier(0);
      gemm256_compute<TR>(acc, As0 + (kt & 1) * G2_STAGE, Bs0 + (kt & 1) * G2_STAGE);
      __builtin_amdgcn_sched_barrier(0);
      if (more) G2_STORER(lds + ((kt + 1) & 1) * G2_STAGE);
      __syncthreads();
    }
  } else {
    for (int kt = 0; kt < nk; ++kt) {
      if (kt + 1 < nk) G2_STORER(lds + ((kt + 1) & 1) * G2_STAGE);
      __builtin_amdgcn_sched_barrier(0);
      if (kt + 2 < nk) G2_LOADR(kt + 2);
      __builtin_amdgcn_sched_barrier(0);
      gemm256_compute<TR>(acc, As0 + (kt & 1) * G2_STAGE, Bs0 + (kt & 1) * G2_STAGE);
      __syncthreads();
    }
  }
}
DI void acc_zero4(f32x16 (&acc)[4][2]) {
#pragma unroll
  for (int a = 0; a < 4; ++a)
#pragma unroll
    for (int b = 0; b < 2; ++b)
#pragma unroll
      for (int i = 0; i < 16; ++i) acc[a][b][i] = 0.f;
}

DI void set_ap(const u16* (&ap)[4], const u16* A, int lda, int m0) {
  const int tid = otid();
#pragma unroll
  for (int i = 0; i < 4; ++i) ap[i] = A + (size_t)(m0 + (tid >> 3) + 64 * i) * lda + (tid & 7) * 8;
}
DI void set_bp(const u16* (&bp)[2], const u16* Bt, int ldb, int n0) {
  const int tid = otid();
#pragma unroll
  for (int i = 0; i < 2; ++i) bp[i] = Bt + (size_t)(n0 + (tid >> 3) + 64 * i) * ldb + (tid & 7) * 8;
}

template <class F>
DI void for_tiles(int ntm, int ntn, F f) {
  const int xcd = blockIdx.x & 7, lb = blockIdx.x >> 3, nlb = gridDim.x >> 3;
  const int total = ((ntm + 3) & ~3) * ntn;
  const int chunk = (total + 7) >> 3;
  for (int i = lb; i < chunk; i += nlb) {
    int idx = xcd * chunk + i;
    if (idx >= total) break;
    int panel = idx / (4 * ntn), within = idx - panel * 4 * ntn;
    int n = within >> 2, m = panel * 4 + (within & 3);
    if (m < ntm) f(m, n);
  }
}

DI void g1_phase(const P& p, int l, unsigned char* lds) {
  const u16* H = (const u16*)(p.ws + O_H);
  const u16* Wt = (const u16*)(p.ws + O_WT + l * WL_SIZE + WL_WIN);
  u16* PROJ = (u16*)(p.ws + O_PROJ);
  for_tiles(TA / 256, NC / 256, [&](int tm_, int tn_) {
    int m0 = tm_ * 256, n0 = tn_ * 256;
    const u16* ap[4];
    const int tid0 = otid();
#pragma unroll
    for (int i = 0; i < 4; ++i) ap[i] = H + (size_t)tm_ * 16 * 16384 + tid0 * 8 + i * 4096;
    const u16* b0p = Wt + (size_t)tn_ * 16 * 16384 + tid0 * 8;
    f32x16 acc[4][2]; acc_zero4(acc);
    if (tn_ >= 4 && tn_ < 8) {
      gemm256<true>(acc, ap, b0p, D, lds);
      const int tid = otid(), lane = tid & 63, w = tid >> 6, r = lane & 31, hh = lane >> 5, wm = w >> 2, wn = w & 3;
      const int grp = ((n0 - OFF_Q) >> 6) + wn, g8 = grp & 7;
      const bool isq = grp < 8, lat = tm_ < T / 256;
      const float* gg = p.in[isq ? I_QNG : I_KNG] + l * 64;
      const float post = isq ? (LOG2E * 0.125f) : 1.f;
      u16* dstb = (u16*)(p.ws + (isq ? O_QN : O_KN));
#pragma unroll 1
      for (int mt = 0; mt < 4; ++mt) {
        const int row = m0 + wm * 128 + mt * 32 + r;
        int bb, n, kpos;
        if (lat) { bb = row >> 13; n = row & (L - 1); kpos = n; } else { int rc = row - T; bb = rc >> 8; n = rc & 255; kpos = L + n; }
        f32x16 x0, x1;
        if (mt == 0) { x0 = acc[0][0]; x1 = acc[0][1]; } else if (mt == 1) { x0 = acc[1][0]; x1 = acc[1][1]; }
        else if (mt == 2) { x0 = acc[2][0]; x1 = acc[2][1]; } else { x0 = acc[3][0]; x1 = acc[3][1]; }
        float ss = 0.f;
#pragma unroll
        for (int i = 0; i < 16; ++i) ss += x0[i] * x0[i] + x1[i] * x1[i];
        ss += shx(ss, 32);
        const float rinv = rsqrtf(ss * (1.f / 64.f) + 1e-6f);
#pragma unroll
        for (int i = 0; i < 16; ++i) { x0[i] *= rinv * gg[crow(i, hh)]; x1[i] *= rinv * gg[32 + crow(i, hh)]; }
        if (lat) {
          const float prow = (float)(n >> 6), pcol = (float)(n & 63);
#pragma unroll
          for (int i = 0; i < 8; ++i) {
            const float invt = __builtin_amdgcn_exp2f(-(float)crow(i, hh) * (13.287712379549449f / 16.f)) * 0.15915494309189535f;
            float t0 = prow * invt, t1 = pcol * invt;
            float c0 = cos_t(t0), s0 = sin_t(t0), c1 = cos_t(t1), s1 = sin_t(t1);
            float a0 = x0[i], b0 = x0[i + 8], a1 = x1[i], b1 = x1[i + 8];
            x0[i] = a0 * c0 - b0 * s0; x0[i + 8] = b0 * c0 + a0 * s0;
            x1[i] = a1 * c1 - b1 * s1; x1[i + 8] = b1 * c1 + a1 * s1;
          }
        }
        u16* dst = dstb + ((size_t)(bb * 8 + g8) * LK + kpos) * 64 + 4 * hh;
#pragma unroll
        for (int g4 = 0; g4 < 4; ++g4) {
          *(uint2*)(dst + 8 * g4) = make_uint2(pack2(x0[4 * g4] * post, x0[4 * g4 + 1] * post), pack2(x0[4 * g4 + 2] * post, x0[4 * g4 + 3] * post));
          *(uint2*)(dst + 32 + 8 * g4) = make_uint2(pack2(x1[4 * g4] * post, x1[4 * g4 + 1] * post), pack2(x1[4 * g4 + 2] * post, x1[4 * g4 + 3] * post));
        }
      }
      return;
    }
    gemm256<false>(acc, ap, b0p, D, lds);
    const int tid = otid(), lane = tid & 63, w = tid >> 6, r = lane & 31, hh = lane >> 5, wm = w >> 2, wn = w & 3;
    if (tn_ >= 8 && tn_ < 10) {
      const bool lat = tm_ < T / 256;
      int bb, nbase;
      if (lat) { bb = m0 >> 13; nbase = (m0 & (L - 1)) + wm * 128; } else { int rc = m0 - T; bb = rc >> 8; nbase = L + (rc & 255) + wm * 128; }
      u16* vb = (u16*)(p.ws + O_VT) + ((size_t)bb * 512 + (n0 - OFF_V) + wn * 64 + r) * LK + nbase;
#pragma unroll
      for (int mt = 0; mt < 4; ++mt)
#pragma unroll
        for (int nt = 0; nt < 2; ++nt)
#pragma unroll
          for (int g4 = 0; g4 < 4; ++g4) {
            const int k16 = 8 * (g4 & 1) + 4 * hh;
            const int pk = (k16 == 4) ? 8 : (k16 == 8) ? 4 : k16;
            *(uint2*)(vb + (size_t)nt * 32 * LK + mt * 32 + 16 * (g4 >> 1) + pk) =
                make_uint2(pack2(acc[mt][nt][4 * g4], acc[mt][nt][4 * g4 + 1]), pack2(acc[mt][nt][4 * g4 + 2], acc[mt][nt][4 * g4 + 3]));
          }
      return;
    }
    if (tn_ >= 10) {
      const int br = (tn_ - 10) >> 2, tn2 = ((tn_ - 10) & 3) * 2 + (wn >> 1), wn2 = wn & 1;
      u16* gf = (u16*)(p.ws + O_GF) + (size_t)br * TA * 1024;
#pragma unroll
      for (int mt = 0; mt < 4; ++mt) {
        const int wave2 = (2 * wm + (mt >> 1)) * 2 + wn2, mt2 = mt & 1;
#pragma unroll
        for (int nt = 0; nt < 2; ++nt)
#pragma unroll
          for (int g4 = 0; g4 < 4; ++g4) {
            size_t idx = ((((((size_t)tm_ * 8 + tn2) * 8 + wave2) * 2 + mt2) * 2 + nt) * 4 + g4) * 64 + lane;
            *(uint2*)(gf + idx * 4) = make_uint2(pack2(sigmoidf_(acc[mt][nt][4 * g4]), sigmoidf_(acc[mt][nt][4 * g4 + 1])),
                                                 pack2(sigmoidf_(acc[mt][nt][4 * g4 + 2]), sigmoidf_(acc[mt][nt][4 * g4 + 3])));
          }
      }
    } else if (tn_ < 4 && tm_ < T / 256) {
      const int bb = m0 >> 13, nl = (m0 & (L - 1)) + wm * 128 + 4 * hh;
      u16* zb = (u16*)(p.ws + O_ZT) + ((size_t)bb * 1024 + n0 + wn * 64 + r) * L + nl;
#pragma unroll
      for (int mt = 0; mt < 4; ++mt)
#pragma unroll
        for (int nt = 0; nt < 2; ++nt)
#pragma unroll
          for (int g4 = 0; g4 < 4; ++g4)
            *(uint2*)(zb + (size_t)nt * 32 * L + mt * 32 + 8 * g4) =
                make_uint2(pack2(acc[mt][nt][4 * g4], acc[mt][nt][4 * g4 + 1]), pack2(acc[mt][nt][4 * g4 + 2], acc[mt][nt][4 * g4 + 3]));
    } else {
      u16* pbase = PROJ + (size_t)(m0 + wm * 128 + 4 * hh) * NC + n0 + wn * 64 + r;
#pragma unroll
      for (int mt = 0; mt < 4; ++mt)
#pragma unroll
        for (int nt = 0; nt < 2; ++nt)
#pragma unroll
          for (int i = 0; i < 16; ++i)
            pbase[(size_t)(mt * 32 + 8 * (i >> 2) + (i & 3)) * NC + nt * 32] = f2bf(acc[mt][nt][i]);
    }
  });
}

DI void prep_phase_tiles(const P& p, int l, unsigned char* lds, int job, int) {
  const int tid = otid();
  const u16* PROJ = (const u16*)(p.ws + O_PROJ);
  float2* rt = (float2*)lds;
  u16* vs = (u16*)(lds + 128 * 16 * 8);
  __syncthreads();
  for (int i = tid; i < 128 * 16; i += NT) {
    int pos = i >> 4, f = i & 15;
    float inv = exp2f(-(float)f * (13.287712379549449f / 16.f));
    float turns = (float)pos * inv * 0.15915494309189535f;
    rt[i] = make_float2(cos_t(turns), sin_t(turns));
  }
  const bool lat = job < 512;
  const int b = lat ? (job >> 7) : (job - 512) >> 2;
  const int n0 = lat ? (job & 127) * 64 : ((job - 512) & 3) * 64;
  const int row0 = lat ? b * L + n0 : T + b * LC + n0;
  const int kpos0 = lat ? n0 : L + n0;
#pragma unroll 8
  for (int i = tid; i < 64 * 64; i += NT) {
    int tk = i >> 6, ch = i & 63;
    uint4 v = *(const uint4*)(PROJ + (size_t)(row0 + tk) * NC + OFF_V + ch * 8);
    unsigned* d = (unsigned*)(vs + tk * 514 + ch * 8);
    d[0] = v.x; d[1] = v.y; d[2] = v.z; d[3] = v.w;
  }
  __syncthreads();
  const float* gq = p.in[I_QNG] + l * 64; const float* gk = p.in[I_KNG] + l * 64;
  for (int u = tid; u < 1024; u += NT) {
    int tk = u & 63, grp = u >> 6;
    const uint4* src = (const uint4*)(PROJ + (size_t)(row0 + tk) * NC + OFF_Q + grp * 64);
    float x[64];
#pragma unroll
    for (int i = 0; i < 8; ++i) {
      uint4 v = src[i];
      x[8 * i] = lo16(v.x); x[8 * i + 1] = hi16(v.x); x[8 * i + 2] = lo16(v.y); x[8 * i + 3] = hi16(v.y);
      x[8 * i + 4] = lo16(v.z); x[8 * i + 5] = hi16(v.z); x[8 * i + 6] = lo16(v.w); x[8 * i + 7] = hi16(v.w);
    }
    float ss = 0.f;
#pragma unroll
    for (int i = 0; i < 64; ++i) ss += x[i] * x[i];
    float rinv = rsqrtf(ss * (1.f / 64.f) + 1e-6f);
    const float* g = grp < 8 ? gq : gk;
    const float post = grp < 8 ? (LOG2E * 0.125f) : 1.f;
#pragma unroll
    for (int i = 0; i < 64; ++i) x[i] = x[i] * rinv * g[i];
    if (lat) {
      int n = n0 + tk;
      int prow = n >> 6, pcol = n & 63;
#pragma unroll
      for (int ax = 0; ax < 2; ++ax) {
        int pp = ax == 0 ? prow : pcol;
#pragma unroll
        for (int f = 0; f < 16; ++f) {
          float2 cs = rt[pp * 16 + f];
          float a = x[ax * 32 + f], bq = x[ax * 32 + 16 + f];
          x[ax * 32 + f] = a * cs.x - bq * cs.y;
          x[ax * 32 + 16 + f] = bq * cs.x + a * cs.y;
        }
      }
    }
    int g8 = grp & 7;
    u16* dst = (u16*)(p.ws + (grp < 8 ? O_QN : O_KN)) + ((size_t)(b * 8 + g8) * LK + kpos0 + tk) * 64;
#pragma unroll
    for (int i = 0; i < 8; ++i)
      ((uint4*)dst)[i] = make_uint4(pack2(x[8 * i] * post, x[8 * i + 1] * post), pack2(x[8 * i + 2] * post, x[8 * i + 3] * post),
                                    pack2(x[8 * i + 4] * post, x[8 * i + 5] * post), pack2(x[8 * i + 6] * post, x[8 * i + 7] * post));
  }
  u16* VT = (u16*)(p.ws + O_VT);
  for (int i = tid; i < 512 * 8; i += NT) {
    int he = i >> 3, tc = i & 7;
    u16 v[8];
#pragma unroll
    for (int j = 0; j < 8; ++j) v[j] = vs[(tc * 8 + j) * 514 + he];
    uint4 o = make_uint4(v[0] | ((unsigned)v[1] << 16), v[2] | ((unsigned)v[3] << 16), v[4] | ((unsigned)v[5] << 16), v[6] | ((unsigned)v[7] << 16));
    *(uint4*)(VT + ((size_t)(b * 512 + he)) * LK + kpos0 + tc * 8) = o;
  }
  __syncthreads();
}

DI float zval(const u16* PROJ, size_t rowbase, int n, int col) { return bf2f(PROJ[(rowbase + n) * NC + OFF_HY + col]); }
DI float ztval(const u16* ZT, int b, int n, int col) { return bf2f(ZT[((size_t)b * 1024 + OFF_HY + col) * L + n]); }

DI void hyena_lat_item(const P& p, int l, int c, int bp, unsigned char* lds) {
  const int tid = otid();
  const u16* PROJ = (const u16*)(p.ws + O_PROJ);
  float2* s = (float2*)lds;
  float2* scr = (float2*)(p.ws + O_HYSCR) + (size_t)blockIdx.x * 4 * 8192;
  const u16* ZT = (const u16*)(p.ws + O_ZT);
  const float* cw = p.in[I_HCW] + l * 3 * 768; const float* cb = p.in[I_HCB] + l * 768;
  float w[3][3], bs[3];
#pragma unroll
  for (int k = 0; k < 3; ++k) { bs[k] = cb[k * 256 + c];
#pragma unroll
    for (int j = 0; j < 3; ++j) w[k][j] = cw[j * 768 + k * 256 + c]; }
  const size_t rb0 = (size_t)(2 * bp) * L, rb1 = rb0 + L;
  __syncthreads();
#pragma unroll 1
  for (int ch = 0; ch < 2; ++ch) {
    const int n0 = ch * 4096 + tid * 8;
    float o[3][2][8];
#pragma unroll
    for (int k = 0; k < 3; ++k)
#pragma unroll
      for (int bq = 0; bq < 2; ++bq) {
        const u16* zr = ZT + ((size_t)(2 * bp + bq) * 1024 + OFF_HY + k * 256 + c) * L;
        uint4 v = *(const uint4*)(zr + n0);
        float x[10];
        x[0] = n0 > 0 ? bf2f(zr[n0 - 1]) : 0.f;
        x[9] = n0 + 8 < L ? bf2f(zr[n0 + 8]) : 0.f;
        x[1] = lo16(v.x); x[2] = hi16(v.x); x[3] = lo16(v.y); x[4] = hi16(v.y); x[5] = lo16(v.z); x[6] = hi16(v.z); x[7] = lo16(v.w); x[8] = hi16(v.w);
#pragma unroll
        for (int e = 0; e < 8; ++e) o[k][bq][e] = bs[k] + w[k][0] * x[e] + w[k][1] * x[e + 1] + w[k][2] * x[e + 2];
      }
#pragma unroll
    for (int e = 0; e < 8; ++e) {
      int n = n0 + e;
      s[phys(n)] = make_float2(o[0][0][e], o[0][1][e]);
      s[phys(n + L)] = make_float2(0.f, 0.f);
      scr[n] = make_float2(o[0][0][e], o[0][1][e]);
      scr[8192 + n] = make_float2(o[1][0][e], o[1][1][e]);
      scr[16384 + n] = make_float2(o[2][0][e], o[2][1][e]);
    }
  }
  const float invN = 1.f / 16384.f;
  for (int ord = 0; ord < 2; ++ord) {
    fft_lds<16384, false>(s);
    const float2* H = (const float2*)(p.ws + O_SPEC) + ((size_t)(l * 2 + ord) * 256 + c) * 16384;
#pragma unroll 8
    for (int i = tid; i < 16384; i += NT) { s[phys(i)] = cmul(s[phys(i)], H[i]); }
    fft_lds<16384, true>(s);
    const float bias = p.in[I_HBIAS][l * 512 + ord * 256 + c];
    if (ord == 0) {
      float2 y1v[16];
#pragma unroll
      for (int i = 0; i < 16; ++i) {
        int n = (i >> 3) * 4096 + tid * 8 + (i & 7);
        float2 cv = s[phys(n)], v = scr[n], x1 = scr[8192 + n];
        y1v[i] = make_float2(x1.x * (cv.x * invN + v.x * bias), x1.y * (cv.y * invN + v.y * bias));
        scr[24576 + n] = y1v[i];
      }
      __syncthreads();
#pragma unroll
      for (int i = 0; i < 16; ++i) { int n = (i >> 3) * 4096 + tid * 8 + (i & 7); s[phys(n)] = y1v[i]; s[phys(n + L)] = make_float2(0.f, 0.f); }
    } else {
      u16* HYT = (u16*)(p.ws + O_HYT);
#pragma unroll
      for (int ch = 0; ch < 2; ++ch) {
        float r0[8], r1[8];
#pragma unroll
        for (int e = 0; e < 8; ++e) {
          int n = ch * 4096 + tid * 8 + e;
          float2 cv = s[phys(n)], y1 = scr[24576 + n], x2 = scr[16384 + n];
          r0[e] = x2.x * (cv.x * invN + y1.x * bias);
          r1[e] = x2.y * (cv.y * invN + y1.y * bias);
        }
        *(uint4*)(HYT + ((size_t)(2 * bp) * 256 + c) * L + ch * 4096 + tid * 8) = make_uint4(pack2(r0[0], r0[1]), pack2(r0[2], r0[3]), pack2(r0[4], r0[5]), pack2(r0[6], r0[7]));
        *(uint4*)(HYT + ((size_t)(2 * bp + 1) * 256 + c) * L + ch * 4096 + tid * 8) = make_uint4(pack2(r1[0], r1[1]), pack2(r1[2], r1[3]), pack2(r1[4], r1[5]), pack2(r1[6], r1[7]));
      }
    }
  }
  __syncthreads();
}

DI void fourier_out(const float2* s, u16* FMT, int m, int tid) {
  const float sc = 0.0013810679320049757f;
  const int col2 = (m == 0) ? 32 : 64 - m;
#pragma unroll
  for (int ch = 0; ch < 2; ++ch) {
    const int k0 = ch * 4096 + tid * 8;
    float v[8], vm[8];
#pragma unroll
    for (int e = 0; e < 8; ++e) {
      int k = k0 + e;
      float2 zp = s[phys((int)(__brev((unsigned)k) >> 19))];
      float2 zn = s[phys((int)(__brev((unsigned)((L - k) & (L - 1))) >> 19))];
      if (m == 0) { v[e] = 0.5f * (zp.x + zn.x) * sc; vm[e] = 0.5f * (zp.y + zn.y) * sc; }
      else { v[e] = zp.x * sc; vm[e] = zn.x * sc; }
    }
    *(uint4*)(FMT + (size_t)m * L + k0) = make_uint4(pack2(v[0], v[1]), pack2(v[2], v[3]), pack2(v[4], v[5]), pack2(v[6], v[7]));
    *(uint4*)(FMT + (size_t)col2 * L + k0) = make_uint4(pack2(vm[0], vm[1]), pack2(vm[2], vm[3]), pack2(vm[4], vm[5]), pack2(vm[6], vm[7]));
  }
}

DI void fourier_lat_item(const P& p, int b, int g, int mp, unsigned char* lds) {
  const int tid = otid();
  const int m0 = 2 * mp, m1 = m0 + 1;
  float2* s0 = (float2*)lds;
  float2* s1 = s0 + 8704;
  float2* tw = (float2*)(lds + 2 * 8704 * 8);
  __syncthreads();
  if (tid < 64) { float f = (float)tid * (1.f / 64.f); tw[tid] = make_float2(cos_t(f), -sin_t(f)); }
  __syncthreads();
  {
    const u16* ZT = (const u16*)(p.ws + O_ZT) + ((size_t)b * 1024 + g * 64) * L + tid * 8;
    float re0[16], im0[16], re1[16], im1[16];
#pragma unroll
    for (int i = 0; i < 16; ++i) { re0[i] = 0.f; im0[i] = 0.f; re1[i] = 0.f; im1[i] = 0.f; }
#pragma unroll 4
    for (int j = 0; j < 64; ++j) {
      float2 t0 = tw[(m0 * j) & 63];
      if (m0 == 0) t0 = make_float2(1.f, (j & 1) ? -1.f : 1.f);
      const float2 t1 = tw[(m1 * j) & 63];
#pragma unroll
      for (int c = 0; c < 2; ++c) {
        uint4 v = *(const uint4*)(ZT + (size_t)j * L + c * 4096);
        float x[8] = {lo16(v.x), hi16(v.x), lo16(v.y), hi16(v.y), lo16(v.z), hi16(v.z), lo16(v.w), hi16(v.w)};
#pragma unroll
        for (int e = 0; e < 8; ++e) {
          re0[c * 8 + e] += x[e] * t0.x; im0[c * 8 + e] += x[e] * t0.y;
          re1[c * 8 + e] += x[e] * t1.x; im1[c * 8 + e] += x[e] * t1.y;
        }
      }
    }
#pragma unroll
    for (int i = 0; i < 16; ++i) {
      const int n = (i >> 3) * 4096 + tid * 8 + (i & 7);
      s0[phys(n)] = make_float2(re0[i], im0[i]);
      s1[phys(n)] = make_float2(re1[i], im1[i]);
    }
  }
  fft_lds<8192, false>(s0);
  fft_lds<8192, false>(s1);
  u16* FMT = (u16*)(p.ws + O_FMT) + ((size_t)b * 256 + g * 64) * L;
  fourier_out(s0, FMT, m0, tid);
  fourier_out(s1, FMT, m1, tid);
  __syncthreads();
}

DI void transpose_job(const P& p, int job, unsigned char* lds) {
  const int tid = otid();
  const int which = job >> 9, b = (job >> 7) & 3, nt = job & 127;
  const u16* src = (const u16*)(p.ws + (which ? O_HYT : O_FMT)) + (size_t)b * 256 * L + nt * 64;
  u16* dst = (u16*)(p.ws + (which ? O_HY : O_FM)) + ((size_t)b * L + nt * 64) * 256;
  u16* sm = (u16*)lds;
  __syncthreads();
  {
    const int c = tid >> 1, half = tid & 1;
    const uint4* sp = (const uint4*)(src + (size_t)c * L + half * 32);
#pragma unroll
    for (int q = 0; q < 4; ++q) {
      uint4 v = sp[q];
      unsigned wds[4] = {v.x, v.y, v.z, v.w};
#pragma unroll
      for (int e = 0; e < 4; ++e) {
        int n = half * 32 + q * 8 + 2 * e;
        sm[n * 264 + c] = (u16)(wds[e] & 0xffffu);
        sm[(n + 1) * 264 + c] = (u16)(wds[e] >> 16);
      }
    }
  }
  __syncthreads();
#pragma unroll
  for (int i = 0; i < 4; ++i) {
    int id = tid + NT * i, n = id >> 5, cc = id & 31;
    uint4 v = *(const uint4*)(sm + n * 264 + cc * 8);
    *(uint4*)(dst + (size_t)n * 256 + cc * 8) = v;
  }
}

DI void fourier_ctx_item(const P& p, int b, int g, int mc, unsigned char* lds) {
  const int tid = otid();
  const u16* PROJ = (const u16*)(p.ws + O_PROJ);
  float* u = (float*)lds;
  float2* ab = (float2*)(lds + 256 * 65 * 4);
  float2* tw64 = ab + 256 * 16;
  float2* tw256 = tw64 + 64;
  __syncthreads();
  if (tid < 64) { float f = (float)tid * (1.f / 64.f); tw64[tid] = make_float2(cos_t(f), -sin_t(f)); }
  if (tid < 256) { float f = (float)tid * (1.f / 256.f); tw256[tid] = make_float2(cos_t(f), -sin_t(f)); }
  for (int i = tid; i < 256 * 64; i += NT) { int n = i >> 6, j = i & 63; u[n * 65 + j] = bf2f(PROJ[(size_t)(T + b * LC + n) * NC + g * 64 + j]); }
  __syncthreads();
  for (int i = tid; i < 256 * 4; i += NT) {
    int n = i >> 2, mm = i & 3, m = mc * 4 + mm;
    float re = 0.f, im = 0.f;
    for (int j = 0; j < 64; ++j) { float2 t = tw64[(m * j) & 63]; float x = u[n * 65 + j]; re += x * t.x; im += x * t.y; }
    ab[n * 4 + mm] = make_float2(re, im);
  }
  __syncthreads();
  u16* FM = (u16*)(p.ws + O_FM);
  for (int i = tid; i < 256 * 4; i += NT) {
    int k = i >> 2, mm = i & 3;
    float y = 0.f;
    for (int n = 0; n < 256; ++n) { float2 t = tw256[(k * n) & 255]; float2 z = ab[n * 4 + mm]; y += z.x * t.x - z.y * t.y; }
    FM[(size_t)(T + b * LC + k) * 256 + g * 64 + mc * 4 + mm] = f2bf(y * (1.f / 128.f));
  }
  __syncthreads();
}

DI void hyena_ctx_item(const P& p, int l, int c, unsigned char* lds) {
  const int tid = otid();
  const u16* PROJ = (const u16*)(p.ws + O_PROJ);
  float* f0 = (float*)lds; float* f1 = f0 + 512; float* sv = f1 + 512;
  const float* FC = (const float*)(p.ws + O_FILTC);
  __syncthreads();
  f0[tid] = FC[(size_t)(0 * 256 + c) * 512 + tid];
  f1[tid] = FC[(size_t)(1 * 256 + c) * 512 + tid];
  const float* cw = p.in[I_HCW] + l * 3 * 768; const float* cb = p.in[I_HCB] + l * 768;
  const float bias0 = p.in[I_HBIAS][l * 512 + c], bias1 = p.in[I_HBIAS][l * 512 + 256 + c];
  const int bb = tid >> 8, t = tid & 255;
  u16* HY = (u16*)(p.ws + O_HY);
  for (int pass = 0; pass < 2; ++pass) {
    int b = pass * 2 + bb;
    size_t rb = (size_t)T + b * LC;
    float o[3];
#pragma unroll
    for (int k = 0; k < 3; ++k) {
      int col = k * 256 + c; float a = cb[col];
#pragma unroll
      for (int j = 0; j < 3; ++j) { int nn = t + j - 1; if (nn >= 0 && nn < LC) a += cw[j * 768 + col] * zval(PROJ, rb, nn, col); }
      o[k] = a;
    }
    __syncthreads();
    sv[bb * 256 + t] = o[0];
    __syncthreads();
    float a = 0.f;
    for (int s2 = 0; s2 < 256; ++s2) a += f0[(t - s2) & 511] * sv[bb * 256 + s2];
    float y1 = o[1] * (a + o[0] * bias0);
    __syncthreads();
    sv[bb * 256 + t] = y1;
    __syncthreads();
    float a2 = 0.f;
    for (int s2 = 0; s2 < 256; ++s2) a2 += f1[(t - s2) & 511] * sv[bb * 256 + s2];
    HY[(rb + t) * 256 + c] = f2bf(o[2] * (a2 + y1 * bias1));
  }
  __syncthreads();
}

#ifndef ATT_KT_PRAGMA
#define ATT_KT_PRAGMA _Pragma("unroll 1")
#endif
#ifndef ATT_SB
#define ATT_SB __builtin_amdgcn_sched_barrier(0)
#endif
constexpr int AT_KB = 64 * G_AST, AT_VB = 128 * G_AST, AT_STAGE = 2 * AT_KB + AT_VB;

DI void attn_item(const P& p, int l, int b, int h, int qpos0, int key0, int nkeys, int out_row0, unsigned char* lds,
                  float lam, float lam_init) {
  const int tid = otid(), lane = tid & 63, w = tid >> 6, r = lane & 31, hh = lane >> 5;
  const u16* QN = (const u16*)(p.ws + O_QN) + (size_t)(b * 8 + h * 2) * LK * 64;
  const u16* KN = (const u16*)(p.ws + O_KN) + (size_t)(b * 8 + h * 2) * LK * 64;
  const u16* VT = (const u16*)(p.ws + O_VT) + (size_t)(b * 512 + h * 128) * LK;
  unsigned char* qs = lds + 2 * AT_STAGE + w * (64 * G_AST);
  __syncthreads();
#pragma unroll
  for (int i = 0; i < 8; ++i) {
    int id = lane + 64 * i, m = id >> 8, row = (id >> 3) & 31, ch = id & 7;
    uint4 v = *(const uint4*)(QN + (size_t)m * LK * 64 + (size_t)(qpos0 + w * 32 + row) * 64 + ch * 8);
    *(uint4*)(qs + (m * 32 + row) * G_AST + ch * 16) = v;
  }
  const unsigned char* qrd = qs + r * G_AST + hh * 16;
  f32x16 O[2][4];
#pragma unroll
  for (int m = 0; m < 2; ++m)
#pragma unroll
    for (int vt = 0; vt < 4; ++vt)
#pragma unroll
      for (int i = 0; i < 16; ++i) O[m][vt][i] = 0.f;
  float lsum[2] = {0.f, 0.f};
  const int ntiles = nkeys >> 6;
  const u16* kbase0 = KN + (size_t)key0 * 64;
  const u16* vbase0 = VT + key0;
  {
    const unsigned koff = tid * 8;
    const unsigned voff = (tid >> 3) * LK + (tid & 7) * 8;
    const int kw = (tid >> 3) * G_AST + (tid & 7) * 16;
    uint4 rk0 = *(const uint4*)(kbase0 + koff), rk1 = *(const uint4*)(kbase0 + (size_t)LK * 64 + koff);
    uint4 rv0 = *(const uint4*)(vbase0 + voff), rv1 = *(const uint4*)(vbase0 + (size_t)64 * LK + voff);
    __syncthreads();
    *(uint4*)(lds + kw) = rk0; *(uint4*)(lds + AT_KB + kw) = rk1;
    *(uint4*)(lds + 2 * AT_KB + kw) = rv0; *(uint4*)(lds + 2 * AT_KB + 64 * G_AST + kw) = rv1;
  }
  __syncthreads();
  for (int t = 0; t < ntiles; ++t) {
    const bool more = t + 1 < ntiles;
    const unsigned char* st = lds + (t & 1) * AT_STAGE;
    uint4 rk0, rk1, rv0, rv1;
    if (more) {
      const int tid2 = otid();
      const unsigned koff = tid2 * 8, voff = (tid2 >> 3) * LK + (tid2 & 7) * 8;
      const u16* kb_ = kbase0 + (size_t)(t + 1) * 4096;
      const u16* vb_ = vbase0 + (t + 1) * 64;
      rk0 = *(const uint4*)(kb_ + koff); rk1 = *(const uint4*)(kb_ + (size_t)LK * 64 + koff);
      rv0 = *(const uint4*)(vb_ + voff); rv1 = *(const uint4*)(vb_ + (size_t)64 * LK + voff);
    }
    __builtin_amdgcn_sched_barrier(0);
ATT_KT_PRAGMA
    for (int kt = 0; kt < 2; ++kt) {
      {
        const unsigned char* kb = st + (kt * 32 + r) * G_AST + hh * 16;
        const unsigned char* vb = st + 2 * AT_KB + r * G_AST + (kt * 32 + 8 * hh) * 2;
        f32x16 S0, S1;
#pragma unroll
        for (int i = 0; i < 16; ++i) { S0[i] = 0.f; S1[i] = 0.f; }
        bf16x8 k0 = *(const bf16x8*)(kb), k1 = *(const bf16x8*)(kb + 32), k2 = *(const bf16x8*)(kb + 64), k3 = *(const bf16x8*)(kb + 96);
        bf16x8 q0 = *(const bf16x8*)(qrd), q1 = *(const bf16x8*)(qrd + 32), q2 = *(const bf16x8*)(qrd + 64), q3 = *(const bf16x8*)(qrd + 96);
        __builtin_amdgcn_sched_barrier(0);
        S0 = MFMA16(k0, q0, S0); S0 = MFMA16(k1, q1, S0); S0 = MFMA16(k2, q2, S0); S0 = MFMA16(k3, q3, S0);
        __builtin_amdgcn_sched_barrier(0);
        k0 = *(const bf16x8*)(kb + AT_KB); k1 = *(const bf16x8*)(kb + AT_KB + 32);
        q0 = *(const bf16x8*)(qrd + 32 * G_AST); q1 = *(const bf16x8*)(qrd + 32 * G_AST + 32);
        S1 = MFMA16(k0, q0, S1); S1 = MFMA16(k1, q1, S1);
        k0 = *(const bf16x8*)(kb + AT_KB + 64); k1 = *(const bf16x8*)(kb + AT_KB + 96);
        q0 = *(const bf16x8*)(qrd + 32 * G_AST + 64); q1 = *(const bf16x8*)(qrd + 32 * G_AST + 96);
        S1 = MFMA16(k0, q0, S1); S1 = MFMA16(k1, q1, S1);
        float ls0 = 0.f;
#pragma unroll
        for (int i = 0; i < 16; ++i) { S0[i] = __builtin_amdgcn_exp2f(S0[i]); ls0 += S0[i]; }
        lsum[0] += ls0;
        bf16x8 pa0 = __builtin_bit_cast(bf16x8, make_uint4(pack2(S0[0], S0[1]), pack2(S0[2], S0[3]), pack2(S0[4], S0[5]), pack2(S0[6], S0[7])));
        bf16x8 pb0 = __builtin_bit_cast(bf16x8, make_uint4(pack2(S0[8], S0[9]), pack2(S0[10], S0[11]), pack2(S0[12], S0[13]), pack2(S0[14], S0[15])));
        __builtin_amdgcn_sched_barrier(0);
        bf16x8 v0 = *(const bf16x8*)(vb), v1 = *(const bf16x8*)(vb + 32 * G_AST), v2 = *(const bf16x8*)(vb + 64 * G_AST), v3 = *(const bf16x8*)(vb + 96 * G_AST);
        O[0][0] = MFMA16(v0, pa0, O[0][0]); O[0][1] = MFMA16(v1, pa0, O[0][1]); O[0][2] = MFMA16(v2, pa0, O[0][2]); O[0][3] = MFMA16(v3, pa0, O[0][3]);
        float ls1 = 0.f;
#pragma unroll
        for (int i = 0; i < 16; ++i) { S1[i] = __builtin_amdgcn_exp2f(S1[i]); ls1 += S1[i]; }
        lsum[1] += ls1;
        bf16x8 pa1 = __builtin_bit_cast(bf16x8, make_uint4(pack2(S1[0], S1[1]), pack2(S1[2], S1[3]), pack2(S1[4], S1[5]), pack2(S1[6], S1[7])));
        bf16x8 pb1 = __builtin_bit_cast(bf16x8, make_uint4(pack2(S1[8], S1[9]), pack2(S1[10], S1[11]), pack2(S1[12], S1[13]), pack2(S1[14], S1[15])));
        __builtin_amdgcn_sched_barrier(0);
        bf16x8 w0 = *(const bf16x8*)(vb + 32), w1 = *(const bf16x8*)(vb + 32 * G_AST + 32), w2 = *(const bf16x8*)(vb + 64 * G_AST + 32), w3 = *(const bf16x8*)(vb + 96 * G_AST + 32);
        O[0][0] = MFMA16(w0, pb0, O[0][0]); O[0][1] = MFMA16(w1, pb0, O[0][1]); O[0][2] = MFMA16(w2, pb0, O[0][2]); O[0][3] = MFMA16(w3, pb0, O[0][3]);
        O[1][0] = MFMA16(v0, pa1, O[1][0]); O[1][1] = MFMA16(v1, pa1, O[1][1]); O[1][2] = MFMA16(v2, pa1, O[1][2]); O[1][3] = MFMA16(v3, pa1, O[1][3]);
        O[1][0] = MFMA16(w0, pb1, O[1][0]); O[1][1] = MFMA16(w1, pb1, O[1][1]); O[1][2] = MFMA16(w2, pb1, O[1][2]); O[1][3] = MFMA16(w3, pb1, O[1][3]);
        ATT_SB;
      }
    }
    if (more) {
      const int tid3 = otid();
      const int kw = (tid3 >> 3) * G_AST + (tid3 & 7) * 16;
      unsigned char* nb = lds + ((t + 1) & 1) * AT_STAGE;
      *(uint4*)(nb + kw) = rk0; *(uint4*)(nb + AT_KB + kw) = rk1;
      *(uint4*)(nb + 2 * AT_KB + kw) = rv0; *(uint4*)(nb + 2 * AT_KB + 64 * G_AST + kw) = rv1;
    }
    __syncthreads();
  }
  float l0 = lsum[0] + shx(lsum[0], 32), l1 = lsum[1] + shx(lsum[1], 32);
  float i0 = 1.f / l0, i1 = lam / l1;
  float ssq = 0.f;
#pragma unroll
  for (int vt = 0; vt < 4; ++vt)
#pragma unroll
    for (int i = 0; i < 16; ++i) { float o = O[0][vt][i] * i0 - O[1][vt][i] * i1; O[0][vt][i] = o; ssq += o * o; }
  ssq += shx(ssq, 32);
  float rn = rsqrtf(ssq * (1.f / 128.f) + 1e-5f) * (1.f - lam_init);
  const float* sg = p.in[I_SUBG] + l * 128;
  u16* OO = (u16*)(p.ws + O_O) + (size_t)(out_row0 + w * 32 + r) * 512 + h * 128;
#pragma unroll
  for (int vt = 0; vt < 4; ++vt)
#pragma unroll
    for (int g4 = 0; g4 < 4; ++g4) {
      int e0 = 32 * vt + 8 * g4 + 4 * hh;
      float4 gv = *(const float4*)(sg + e0);
      *(uint2*)(OO + e0) = make_uint2(pack2(O[0][vt][4 * g4] * rn * gv.x, O[0][vt][4 * g4 + 1] * rn * gv.y),
                                      pack2(O[0][vt][4 * g4 + 2] * rn * gv.z, O[0][vt][4 * g4 + 3] * rn * gv.w));
    }
}

DI void attn_phase(const P& p, int l, unsigned char* lds) {
  const int lane = otid() & 63;
  float s0 = p.in[I_LAMQ][l * 128 + lane] * p.in[I_LAMK][l * 128 + lane];
  float s1 = p.in[I_LAMQ][l * 128 + 64 + lane] * p.in[I_LAMK][l * 128 + 64 + lane];
  s0 = wave_sum(s0); s1 = wave_sum(s1);
  const float lam_init = lam_init_of(l);
  const float lam = __expf(s0) - __expf(s1) + lam_init;
  const int n_lat = NB * 4 * (L / 256), n_ctx = (l == 0) ? NB * 4 : 0, n_att = n_lat + n_ctx;
  const int n_hy = 512, n_fm = 16 * 16, n_fc = (l == 0) ? 256 : 0, n_hc = (l == 0) ? 256 : 0;
  const int total = n_att + n_hy + n_fm + n_fc + n_hc;
  for (int it = blockIdx.x; it < total; it += gridDim.x) {
    int k = it;
    if (k < n_att) {
      int b, h, qpos0, key0, nkeys, orow;
      if (k < n_lat) { int qb = k & 31, bh = k >> 5; b = bh >> 2; h = bh & 3; qpos0 = qb * 256; key0 = 0; nkeys = LK; orow = b * L + qb * 256; }
      else { int bh = k - n_lat; b = bh >> 2; h = bh & 3; qpos0 = L; key0 = L; nkeys = LC; orow = T + b * LC; }
      attn_item(p, l, b, h, qpos0, key0, nkeys, orow, lds, lam, lam_init);
      continue;
    }
    k -= n_att;
    if (k < n_hy) { hyena_lat_item(p, l, k >> 1, k & 1, lds); continue; }
    k -= n_hy;
    if (k < n_fm) { fourier_lat_item(p, k >> 6, (k >> 4) & 3, k & 15, lds); continue; }
    k -= n_fm;
    if (k < n_fc) { fourier_ctx_item(p, k >> 6, (k >> 4) & 3, k & 15, lds); continue; }
    k -= n_fc;
    hyena_ctx_item(p, l, k, lds);
  }
}

DI void transpose_phase(const P& p, unsigned char* lds) {
  for (int it = blockIdx.x; it < 1024; it += gridDim.x) transpose_job(p, it, lds);
}

DI void merge_phase(const P& p, int l, int rows, unsigned char* lds) {
  u16* MG = (u16*)(p.ws + O_MERGED);
  const unsigned char* WL = p.ws + O_WT + l * WL_SIZE;
  const int tid = otid(), lane = tid & 63, w = tid >> 6, r = lane & 31, hh = lane >> 5, wm = w >> 1, wn = w & 1;
  for_tiles(rows / 256, D / 128, [&](int tm_, int tn_) {
    int m0 = tm_ * 256, n0 = tn_ * 128;
    f32x16 tot[2][2]; acc_zero(tot);
#pragma unroll 1
    for (int br = 0; br < 3; ++br) {
      const u16* A = (const u16*)(p.ws + (br == 0 ? O_FM : br == 1 ? O_HY : O_O));
      const int K = br == 2 ? 512 : 256;
      const u16* Wt = (const u16*)(WL + (br == 0 ? WL_WF : br == 1 ? WL_WH : WL_WA));
      const u16* ap[4]; const u16* bp[2];
      set_ap(ap, A, K, m0); set_bp(bp, Wt, K, n0);
      f32x16 acc[2][2]; acc_zero(acc);
      gemm_main(acc, ap, bp, K, lds);
      size_t fb = ((((size_t)tm_ * 8 + tn_) * 8 + w) * 16) * 64 + lane;
      asm volatile("" : "+v"(fb));
      const u16* gf = (const u16*)(p.ws + O_GF) + (size_t)br * TA * 1024;
#pragma unroll
      for (int mt = 0; mt < 2; ++mt)
#pragma unroll
        for (int nt = 0; nt < 2; ++nt)
#pragma unroll
          for (int g4 = 0; g4 < 4; ++g4) {
            uint2 gv = *(const uint2*)(gf + (fb + (size_t)(((mt * 2 + nt) * 4 + g4) * 64)) * 4);
            tot[mt][nt][4 * g4] += lo16(gv.x) * acc[mt][nt][4 * g4];
            tot[mt][nt][4 * g4 + 1] += hi16(gv.x) * acc[mt][nt][4 * g4 + 1];
            tot[mt][nt][4 * g4 + 2] += lo16(gv.y) * acc[mt][nt][4 * g4 + 2];
            tot[mt][nt][4 * g4 + 3] += hi16(gv.y) * acc[mt][nt][4 * g4 + 3];
          }
    }
    u16* pm = MG + (size_t)(m0 + wm * 64 + 4 * hh) * D + n0 + wn * 64 + r;
#pragma unroll
    for (int mt = 0; mt < 2; ++mt)
#pragma unroll
      for (int nt = 0; nt < 2; ++nt)
#pragma unroll
        for (int i = 0; i < 16; ++i)
          pm[(size_t)(mt * 32 + 8 * (i >> 2) + (i & 3)) * D + nt * 32] = f2bf(tot[mt][nt][i]);
  });
}

DI void wo_phase(const P& p, int l, int rows, unsigned char* lds) {
  const u16* MG = (const u16*)(p.ws + O_MERGED);
  const u16* Wt = (const u16*)(p.ws + O_WT + l * WL_SIZE + WL_WO);
  float* XA = (float*)(p.ws + O_XA);
  const float* MOD = (const float*)(p.ws + O_MOD) + l * 5 * 6144;
  const int lane = otid() & 63, w = otid() >> 6, r = lane & 31, hh = lane >> 5, wm = w >> 1, wn = w & 1;
  for_tiles(rows / 256, D / 128, [&](int tm_, int tn_) {
    int m0 = tm_ * 256, n0 = tn_ * 128;
    const u16* ap[4]; const u16* bp[2];
    set_ap(ap, MG, D, m0); set_bp(bp, Wt, D, n0);
    f32x16 acc[2][2]; acc_zero(acc);
    gemm_main(acc, ap, bp, D, lds);
#pragma unroll
    for (int mt = 0; mt < 2; ++mt)
#pragma unroll
      for (int nt = 0; nt < 2; ++nt)
#pragma unroll
        for (int i = 0; i < 16; ++i) {
          int row = m0 + wm * 64 + mt * 32 + crow(i, hh), col = n0 + wn * 64 + nt * 32 + r;
          float xin;
          if (l == 0) xin = row < T ? p.in[I_X][(size_t)row * D + col] : p.in[I_CTX][(size_t)(row - T) * D + col];
          else xin = XA[(size_t)row * D + col];
          int mr = row < T ? (row >> 13) : 4;
          XA[(size_t)row * D + col] = xin + MOD[mr * 6144 + 2 * 1024 + col] * acc[mt][nt][i];
        }
  });
}

DI void router_phase(const P& p, int l, int ntok, unsigned char* lds) {
  const int tid = otid(), lane = tid & 63, w = tid >> 6, r = lane & 31, hh = lane >> 5;
  float* tile = (float*)lds;
  int* lcnt = (int*)(lds + 32 * 1025 * 4);
  const float* XA = (const float*)(p.ws + O_XA);
  const float* MOD = (const float*)(p.ws + O_MOD) + l * 5 * 6144;
  u16* H = (u16*)(p.ws + O_H);
  const float* wr = p.in[I_WR] + (size_t)l * 1024 * 32;
  const float* br = p.in[I_BR] + l * 32;
  int* TOKE = (int*)(p.ws + O_TOKE); float* TOKG = (float*)(p.ws + O_TOKG); int* TOKLP = (int*)(p.ws + O_TOKLP);
  const int per = ntok / gridDim.x;
  const int tbase = blockIdx.x * per;
  __syncthreads();
  if (tid < 32) lcnt[tid] = 0;
  __syncthreads();
  for (int c0 = 0; c0 < per; c0 += 32) {
#pragma unroll 2
    for (int q = 0; q < 4; ++q) {
      int tl = w * 4 + q;
      int tok = tbase + c0 + tl;
      bool valid = (c0 + tl) < per;
      if (!valid) tok = tbase;
      const float* xr = XA + (size_t)tok * D;
      int mr = tok < T ? (tok >> 13) : 4;
      float xv[16];
#pragma unroll
      for (int i = 0; i < 4; ++i) { float4 v = *(const float4*)(xr + (i * 64 + lane) * 4); xv[4 * i] = v.x; xv[4 * i + 1] = v.y; xv[4 * i + 2] = v.z; xv[4 * i + 3] = v.w; }
      float ss = 0.f;
#pragma unroll
      for (int i = 0; i < 16; ++i) ss += xv[i] * xv[i];
      ss = wave_sum(ss);
      float rinv = rsqrtf(ss * (1.f / 1024.f) + 1e-6f);
      const float* g = p.in[I_N2G] + l * 1024; const float* sh = MOD + mr * 6144 + 3 * 1024; const float* sc = MOD + mr * 6144 + 4 * 1024;
#pragma unroll
      for (int i = 0; i < 4; ++i) {
        int c = (i * 64 + lane) * 4;
        float4 gv = *(const float4*)(g + c), shv = *(const float4*)(sh + c), scv = *(const float4*)(sc + c);
        float h0 = xv[4 * i] * rinv * gv.x * (1.f + scv.x) + shv.x;
        float h1 = xv[4 * i + 1] * rinv * gv.y * (1.f + scv.y) + shv.y;
        float h2 = xv[4 * i + 2] * rinv * gv.z * (1.f + scv.z) + shv.z;
        float h3 = xv[4 * i + 3] * rinv * gv.w * (1.f + scv.w) + shv.w;
        float* tr = tile + tl * 1025 + c;
        tr[0] = h0; tr[1] = h1; tr[2] = h2; tr[3] = h3;
        if (valid) *(uint2*)(H + boff(tok, c, 1024)) = make_uint2(pack2(h0, h1), pack2(h2, h3));
      }
    }
    __syncthreads();
    f32x16 acc;
#pragma unroll
    for (int i = 0; i < 16; ++i) acc[i] = 0.f;
    {
      const float* ar = tile + r * 1025 + w * 128 + hh;
      const float* brp = wr + (size_t)(w * 128 + hh) * 32 + r;
#pragma unroll 8
      for (int s2 = 0; s2 < 64; ++s2) acc = __builtin_amdgcn_mfma_f32_32x32x2f32(ar[2 * s2], brp[(size_t)2 * s2 * 32], acc, 0, 0, 0);
    }
    __syncthreads();
    float* part = tile;
#pragma unroll
    for (int i = 0; i < 16; ++i) part[(w * 32 + crow(i, hh)) * 33 + r] = acc[i];
    __syncthreads();
#pragma unroll
    for (int q = 0; q < 4; ++q) {
      int tl = w * 4 + q;
      int tok = tbase + c0 + tl;
      bool valid = (c0 + tl) < per;
      float v = br[r];
#pragma unroll
      for (int k = 0; k < 8; ++k) v += part[(k * 32 + tl) * 33 + r];
      int se[4]; float sv[4];
#pragma unroll
      for (int k = 0; k < 4; ++k) {
        float m = wave_max(v);
        unsigned long long mask = __ballot(v == m);
        int idx = __ffsll((long long)mask) - 1;
        se[k] = idx & 31; sv[k] = m;
        if (r == (idx & 31)) v = -3.0e38f;
      }
      float e1 = __expf(sv[1] - sv[0]), e2 = __expf(sv[2] - sv[0]), e3 = __expf(sv[3] - sv[0]);
      float inv = 1.f / (1.f + e1 + e2 + e3);
      if (valid && lane < 4) {
        int e = lane == 0 ? se[0] : lane == 1 ? se[1] : lane == 2 ? se[2] : se[3];
        float gt = (lane == 0 ? 1.f : lane == 1 ? e1 : lane == 2 ? e2 : e3) * inv;
        int lp = atomicAdd(&lcnt[e], 1);
        TOKE[tok * 4 + lane] = e; TOKG[tok * 4 + lane] = gt; TOKLP[tok * 4 + lane] = lp;
      }
    }
    __syncthreads();
  }
  if (tid < 32) ((int*)(p.ws + O_CNT))[blockIdx.x * 32 + tid] = lcnt[tid];
  __syncthreads();
}

DI void slot_phase(const P& p, int ntok, unsigned char* lds) {
  const int tid = otid();
  int* cnt = (int*)lds;
  const int G = gridDim.x;
  int* total = cnt + G * 32; int* base = total + 32; int* pstart = base + 32; int* padded = pstart + 40;
  const int* CNT = (const int*)(p.ws + O_CNT);
  __syncthreads();
  for (int i = tid; i < G * 32; i += NT) cnt[i] = CNT[i];
  __syncthreads();
  if (tid < 32) {
    int s = 0, bsum = 0;
    for (int b = 0; b < G; ++b) { int v = cnt[b * 32 + tid]; if (b < (int)blockIdx.x) bsum += v; s += v; }
    total[tid] = s; base[tid] = bsum; padded[tid] = (s + 255) & ~255;
  }
  __syncthreads();
  if (tid == 0) { int a = 0; for (int e = 0; e < 32; ++e) { pstart[e] = a; a += padded[e]; } pstart[32] = a; }
  __syncthreads();
  int* TOKE = (int*)(p.ws + O_TOKE); int* TOKLP = (int*)(p.ws + O_TOKLP); int* TOKSLOT = (int*)(p.ws + O_TOKSLOT);
  int* ROWTOK = (int*)(p.ws + O_ROWTOK); int* TILEE = (int*)(p.ws + O_TILEE);
  const int per = ntok / G, tbase = blockIdx.x * per;
  for (int i = tid; i < per * 4; i += NT) {
    int idx = tbase * 4 + i;
    int e = TOKE[idx];
    int slot = pstart[e] + base[e] + TOKLP[idx];
    TOKSLOT[idx] = slot; ROWTOK[slot] = idx >> 2;
  }
  if (blockIdx.x < 32) {
    int e = blockIdx.x;
    for (int s2 = pstart[e] + total[e] + tid; s2 < pstart[e] + padded[e]; s2 += NT) ROWTOK[s2] = 0;
  }
  if (blockIdx.x == 0) {
    int nt = pstart[32] >> 8;
    if (tid == 0) TILEE[1023] = nt;
    for (int i = tid; i < nt; i += NT) {
      int row = i << 8, e = 0;
      for (int k = 1; k < 32; ++k) if (row >= pstart[k]) e = k;
      TILEE[i] = e;
    }
  }
  __syncthreads();
}

DI void moe1_phase(const P& p, int l, unsigned char* lds) {
  const u16* H = (const u16*)(p.ws + O_H);
  u16* ACT = (u16*)(p.ws + O_PROJ);
  const int* ROWTOK = (const int*)(p.ws + O_ROWTOK); const int* TILEE = (const int*)(p.ws + O_TILEE);
  const int ntm = TILEE[1023];
  const int tid = otid(), lane = tid & 63, w = tid >> 6, r = lane & 31, hh = lane >> 5, wm = w >> 2, wn = w & 3;
  for_tiles(ntm, 8, [&](int mt_, int tn_) {
    int n0 = tn_ * 256, m0 = mt_ * 256, e = TILEE[mt_];
    const u16* Wt = (const u16*)(p.ws + O_WT + l * WL_SIZE + WL_WE1) + (size_t)e * 2048 * 1024;
    const u16* ap[4];
#pragma unroll
    for (int i = 0; i < 4; ++i) ap[i] = H + boff(ROWTOK[m0 + (tid >> 3) + 64 * i], (tid & 7) * 8, 1024);
    const u16* b0p = Wt + (size_t)tn_ * 16 * 16384 + tid * 8;
    f32x16 acc[4][2]; acc_zero4(acc);
    gemm256(acc, ap, b0p, D, lds);
    const int j = (n0 >> 1) + wn * 32 + r;
    const float* b1 = p.in[I_BE1] + (size_t)(l * 32 + e) * 2048;
    const float bg = b1[2 * j], bl = b1[2 * j + 1];
    u16* abase = ACT + boff(m0 + wm * 128 + 4 * hh, j, 1024);
#pragma unroll
    for (int mt = 0; mt < 4; ++mt)
#pragma unroll
      for (int i = 0; i < 16; ++i) {
        float ug = fminf(acc[mt][0][i] + bg, 7.f);
        float ul = fminf(fmaxf(acc[mt][1][i] + bl, -7.f), 7.f);
        float a = ug * sigmoidf_(1.702f * ug) * (ul + 1.f);
        abase[(mt * 32 + 8 * (i >> 2) + (i & 3)) * 64] = f2bf(a);
      }
  });
}

DI void moe2_phase(const P& p, int l, unsigned char* lds) {
  const u16* ACT = (const u16*)(p.ws + O_PROJ);
  u16* Y = (u16*)(p.ws + O_Y);
  const int* TILEE = (const int*)(p.ws + O_TILEE);
  const int ntm = TILEE[1023];
  const int tid = otid(), lane = tid & 63, w = tid >> 6, r = lane & 31, hh = lane >> 5, wm = w >> 2, wn = w & 3;
  for_tiles(ntm, 4, [&](int mt_, int tn_) {
    int n0 = tn_ * 256, m0 = mt_ * 256, e = TILEE[mt_];
    const u16* Wt = (const u16*)(p.ws + O_WT + l * WL_SIZE + WL_WE2) + (size_t)e * 1024 * 1024;
    const u16* ap[4];
#pragma unroll
    for (int i = 0; i < 4; ++i) ap[i] = ACT + (size_t)mt_ * 16 * 16384 + tid * 8 + i * 4096;
    const u16* b0p = Wt + (size_t)tn_ * 16 * 16384 + tid * 8;
    f32x16 acc[4][2]; acc_zero4(acc);
    gemm256(acc, ap, b0p, 1024, lds);
    const float* b2 = p.in[I_BE2] + (size_t)(l * 32 + e) * 1024;
    u16* ybase = Y + (size_t)(m0 + wm * 128 + 4 * hh) * 1024 + n0 + wn * 64 + r;
#pragma unroll
    for (int nt = 0; nt < 2; ++nt) {
      float bv = b2[n0 + wn * 64 + nt * 32 + r];
#pragma unroll
      for (int mt = 0; mt < 4; ++mt)
#pragma unroll
        for (int i = 0; i < 16; ++i)
          ybase[(size_t)(mt * 32 + 8 * (i >> 2) + (i & 3)) * 1024 + nt * 32] = f2bf(acc[mt][nt][i] + bv);
    }
  });
}

DI void combine_phase(const P& p, int l, int ntok) {
  const int lane = otid() & 63, gw = blockIdx.x * (NT / 64) + (otid() >> 6), nw = gridDim.x * (NT / 64);
  float* XA = (float*)(p.ws + O_XA);
  const float* MOD = (const float*)(p.ws + O_MOD) + l * 5 * 6144;
  const float* MODN = (const float*)(p.ws + O_MOD) + (l + 1) * 5 * 6144;
  const u16* Y = (const u16*)(p.ws + O_Y);
  const int* TOKSLOT = (const int*)(p.ws + O_TOKSLOT); const float* TOKG = (const float*)(p.ws + O_TOKG);
  u16* H = (u16*)(p.ws + O_H);
  for (int row = gw; row < ntok; row += nw) {
    int mr = row < T ? (row >> 13) : 4;
    int4 sl = *(const int4*)(TOKSLOT + row * 4);
    float4 gt = *(const float4*)(TOKG + row * 4);
    float xv[16];
#pragma unroll
    for (int i = 0; i < 4; ++i) {
      int c = (i * 64 + lane) * 4;
      float4 x = *(const float4*)(XA + (size_t)row * D + c);
      float4 m5 = *(const float4*)(MOD + mr * 6144 + 5 * 1024 + c);
      uint2 y0 = *(const uint2*)(Y + (size_t)sl.x * 1024 + c), y1 = *(const uint2*)(Y + (size_t)sl.y * 1024 + c);
      uint2 y2 = *(const uint2*)(Y + (size_t)sl.z * 1024 + c), y3 = *(const uint2*)(Y + (size_t)sl.w * 1024 + c);
      float a0 = gt.x * lo16(y0.x) + gt.y * lo16(y1.x) + gt.z * lo16(y2.x) + gt.w * lo16(y3.x);
      float a1 = gt.x * hi16(y0.x) + gt.y * hi16(y1.x) + gt.z * hi16(y2.x) + gt.w * hi16(y3.x);
      float a2 = gt.x * lo16(y0.y) + gt.y * lo16(y1.y) + gt.z * lo16(y2.y) + gt.w * lo16(y3.y);
      float a3 = gt.x * hi16(y0.y) + gt.y * hi16(y1.y) + gt.z * hi16(y2.y) + gt.w * hi16(y3.y);
      xv[4 * i] = x.x + m5.x * a0; xv[4 * i + 1] = x.y + m5.y * a1; xv[4 * i + 2] = x.z + m5.z * a2; xv[4 * i + 3] = x.w + m5.w * a3;
      float4 o = make_float4(xv[4 * i], xv[4 * i + 1], xv[4 * i + 2], xv[4 * i + 3]);
      if (l == 1) *(float4*)(p.out + (size_t)row * D + c) = o;
      else *(float4*)(XA + (size_t)row * D + c) = o;
    }
    if (l == 0) norm_mod_store(xv, p.in[I_N1G] + 1024, MODN + mr * 6144, MODN + mr * 6144 + 1024, H, row, lane);
  }
}


#define XB_TMO      128
#define XB_XCNT(j)  (256  + 64 * (j))
#define XB_XSUB(j)  (1280 + 64 * (j))
#define XB_XGEN(j)  (2304 + 64 * (j))
#define XB_TOP      3328
#define XB_TOPGEN   3392
#define XCD_BAR_WORDS 3456
#define XB_SPIN_CAP (1u << 22)
#define LAS __attribute__((address_space(3)))
DI unsigned xb_ld(unsigned* p) { return __hip_atomic_load(p, __ATOMIC_RELAXED, __HIP_MEMORY_SCOPE_AGENT); }
DI unsigned xb_add(unsigned* p, unsigned v) { return __hip_atomic_fetch_add(p, v, __ATOMIC_RELAXED, __HIP_MEMORY_SCOPE_AGENT); }
DI unsigned xb_xcc_id() { return (unsigned)__builtin_amdgcn_s_getreg((3 << 11) | 20) & 0xFu; }
#define XB_SPIN(cond, bar) do { unsigned _sp = 0; while (cond) { __builtin_amdgcn_s_sleep(1); \
    if ((++_sp & 255u) == 0u) { if (xb_ld(&(bar)[XB_TMO])) break; if (_sp > XB_SPIN_CAP) { atomicAdd(&(bar)[XB_TMO], 1u); break; } } } } while (0)
struct XcdBarrier { unsigned* bar; unsigned x; volatile LAS unsigned* st; };
DI XcdBarrier xcd_barrier_post(unsigned* bar, volatile LAS unsigned* st) {
  XcdBarrier b; b.bar = bar; b.x = xb_xcc_id(); b.st = st;
  if (threadIdx.x == 0) (void)xb_add(&bar[XB_XCNT(b.x)], 1u);
  return b;
}
DI void xcd_barrier_complete(unsigned* bar, unsigned x, unsigned& nloc, unsigned& nx) {
  const unsigned G = gridDim.x * gridDim.y * gridDim.z;
  unsigned sum, cnt, mine, sp = 0u;
  for (;;) {
    sum = 0u; cnt = 0u; mine = 0u;
#pragma unroll
    for (unsigned j = 0; j < 16; ++j) { const unsigned c = xb_ld(&bar[XB_XCNT(j)]); sum += c; cnt += (c > 0u) ? 1u : 0u; mine = (j == x) ? c : mine; }
    if (sum == G) break;
    __builtin_amdgcn_s_sleep(1);
    if ((++sp & 255u) == 0u) { if (xb_ld(&bar[XB_TMO])) break; if (sp > XB_SPIN_CAP) { atomicAdd(&bar[XB_TMO], 1u); break; } }
  }
  nloc = mine > 0u ? mine : 1u; nx = cnt > 0u ? cnt : 1u;
}
DI void xcd_barrier(const XcdBarrier& b) {
  asm volatile("s_waitcnt vmcnt(0)" ::: "memory");
  __syncthreads();
  if (threadIdx.x == 0) {
    unsigned* bar = b.bar;
    __builtin_amdgcn_s_waitcnt(0);
    unsigned nloc = b.st[0], nx = b.st[1];
    if (nloc == 0u) { xcd_barrier_complete(bar, b.x, nloc, nx); b.st[0] = nloc; b.st[1] = nx; }
    const unsigned old = xb_add(&bar[XB_XSUB(b.x)], 1u);
    const unsigned gen = old / nloc;
    if (old + 1u == (gen + 1u) * nloc) {
      __builtin_amdgcn_fence(__ATOMIC_RELEASE, "agent");
      asm volatile("s_waitcnt vmcnt(0)" ::: "memory");
      const unsigned og = xb_add(&bar[XB_TOP], 1u);
      const unsigned tg = og / nx;
      if (og + 1u == (tg + 1u) * nx) xb_add(&bar[XB_TOPGEN], 1u);
      else XB_SPIN(xb_ld(&bar[XB_TOPGEN]) == tg, bar);
      __builtin_amdgcn_fence(__ATOMIC_ACQUIRE, "agent");
      xb_add(&bar[XB_XGEN(b.x)], 1u);
      asm volatile("s_waitcnt vmcnt(0)" ::: "memory");
    } else {
      XB_SPIN(xb_ld(&bar[XB_XGEN(b.x)]) == gen, bar);
      __builtin_amdgcn_fence(__ATOMIC_ACQUIRE, "agent");
      asm volatile("s_waitcnt vmcnt(0)" ::: "memory");
    }
  }
  __syncthreads();
}

#ifndef PM
#define PM 0xFFFF
#endif
#ifndef REP
#define REP 0
#endif
#define RUNP(bit, call) do { call; if (REP & (1 << (bit))) { GSYNC(); call; } } while (0)
__global__ void __launch_bounds__(NT) fwd_megakernel(P p) {
  cg::grid_group grid = cg::this_grid();
  extern __shared__ __attribute__((aligned(16))) unsigned char lds[];
  if (p.ws_size < WS_NEED) { if (blockIdx.x == 0 && otid() == 0) p.out[0] = 1e30f; return; }
  volatile LAS unsigned* xst = (volatile LAS unsigned*)(lds + LDS_BYTES - 16);
  if (threadIdx.x < 2) xst[threadIdx.x] = 0u;
  __syncthreads();
  (void)xcd_barrier_post((unsigned*)(p.ws + O_BAR), xst);
#define GSYNC() do { XcdBarrier xb_; unsigned* bp_ = (unsigned*)(p.ws + O_BAR); asm volatile("" : "+s"(bp_)); xb_.bar = bp_; xb_.x = xb_xcc_id(); \
    xb_.st = (volatile LAS unsigned*)(lds + LDS_BYTES - 16); xcd_barrier(xb_); } while (0)

  for (int rep = 0; rep < 1 + ((REP >> 0) & 1); ++rep) {
    if (rep) GSYNC();
    for (int l = 0; l < 2; ++l) {
      unsigned char* WL = p.ws + O_WT + l * WL_SIZE;
      convT(p.in[I_WE1] + (size_t)l * 32 * 1024 * 2048, 1024, 2048, (u16*)(WL + WL_WE1), 32, true, (float*)lds, 256);
      convT(p.in[I_WE2] + (size_t)l * 32 * 1024 * 1024, 1024, 1024, (u16*)(WL + WL_WE2), 32, false, (float*)lds, 256);
      convT(p.in[I_WIN] + (size_t)l * 1024 * NC, 1024, NC, (u16*)(WL + WL_WIN), 1, false, (float*)lds, 256);
      convT(p.in[I_WO] + (size_t)l * 1024 * 1024, 1024, 1024, (u16*)(WL + WL_WO), 1, false, (float*)lds);
      convT(p.in[I_WA] + (size_t)l * 512 * 1024, 512, 1024, (u16*)(WL + WL_WA), 1, false, (float*)lds);
      convT(p.in[I_WF] + (size_t)l * 256 * 1024, 256, 1024, (u16*)(WL + WL_WF), 1, false, (float*)lds);
      convT(p.in[I_WH] + (size_t)l * 256 * 1024, 256, 1024, (u16*)(WL + WL_WH), 1, false, (float*)lds);
    }
    mod_phase(p, (float*)lds);
    z2_phase(p, (float*)lds);
  }
  grid.sync();
  RUNP(1, filter_phase(p, lds));
  norm1_layer0(p);
  GSYNC();

  for (int l = 0; l < 2; ++l) {
    const int rows = (l == 0) ? TA : T;
    RUNP(2, g1_phase(p, l, lds));
    GSYNC();
    RUNP(4, attn_phase(p, l, lds));
    GSYNC();
    transpose_phase(p, lds);
    GSYNC();
    RUNP(5, merge_phase(p, l, rows, lds));
    GSYNC();
    if (PM & 256) wo_phase(p, l, rows, lds);
    GSYNC();
    RUNP(6, router_phase(p, l, rows, lds));
    GSYNC();
    RUNP(6, slot_phase(p, rows, lds));
    GSYNC();
    RUNP(7, moe1_phase(p, l, lds));
    GSYNC();
    RUNP(8, moe2_phase(p, l, lds));
    GSYNC();
    if (PM & 8192) combine_phase(p, l, rows);
    if (l == 0) GSYNC();
  }
}

extern "C" void kernel_launch(void* const* d_in, const int* in_sizes, int n_in, void* d_out, int out_size,
                              void* d_ws, size_t ws_size, hipStream_t stream) {
  static int grid_blocks = 0;
  if (!grid_blocks) {
    int dev = 0, cus = 0, per_cu = 0;
    (void)hipGetDevice(&dev);
    (void)hipDeviceGetAttribute(&cus, hipDeviceAttributeMultiprocessorCount, dev);
    if (hipFuncSetAttribute((const void*)fwd_megakernel, hipFuncAttributeMaxDynamicSharedMemorySize, LDS_BYTES) != hipSuccess)
      fprintf(stderr, "hipFuncSetAttribute failed\n");
    (void)hipOccupancyMaxActiveBlocksPerMultiprocessor(&per_cu, (const void*)fwd_megakernel, NT, LDS_BYTES);
    if (per_cu < 1) per_cu = 1;
    grid_blocks = cus * per_cu;
    if (grid_blocks > 256) grid_blocks = 256;
    if (grid_blocks != 256) fprintf(stderr, "unexpected grid %d\n", grid_blocks);
    fprintf(stderr, "grid %d (cus %d per_cu %d) ws %zu need %zu\n", grid_blocks, cus, per_cu, ws_size, (size_t)WS_NEED);
  }
  P p{};
  for (int i = 0; i < 35 && i < n_in; ++i) p.in[i] = (const float*)d_in[i];
  p.out = (float*)d_out;
  p.ws = (unsigned char*)d_ws;
  p.ws_size = (unsigned long long)ws_size;
  (void)hipMemsetAsync((unsigned char*)d_ws + O_BAR, 0, XCD_BAR_WORDS * 4, stream);
  void* args[] = {&p};
  hipError_t e = hipLaunchCooperativeKernel((void*)fwd_megakernel, dim3(grid_blocks), dim3(NT), args, LDS_BYTES, stream);
  if (e != hipSuccess) fprintf(stderr, "cooperative launch failed: %s (grid %d)\n", hipGetErrorString(e), grid_blocks);
}
```

```cpp
#include <hip/hip_runtime.h>
#include <hip/hip_cooperative_groups.h>
#include <cstdio>
namespace cg = cooperative_groups;

#define DI __device__ __forceinline__
typedef unsigned short u16;
typedef __attribute__((ext_vector_type(8))) short bf16x8;
typedef __attribute__((ext_vector_type(4))) short s16x4;
typedef __attribute__((ext_vector_type(16))) float f32x16;
typedef __bf16 bf2_t __attribute__((ext_vector_type(2)));
typedef float fl2_t __attribute__((ext_vector_type(2)));
#define MFMA16(a, b, c) __builtin_amdgcn_mfma_f32_32x32x16_bf16((a), (b), (c), 0, 0, 0)

constexpr int NT = 512;
constexpr int LDS_BYTES = 160 * 1024;
constexpr int NB = 4, L = 8192, D = 1024, T = NB * L, LC = 256, TC = NB * LC, TA = T + TC;
constexpr int NC = 5632, OFF_HY = 256, OFF_Q = 1024, OFF_V = 2048, OFF_G = 2560;
constexpr int LK = L + LC;
constexpr int NR = TA * 4 + 32 * 256;
constexpr float LOG2E = 1.4426950408889634f;

constexpr size_t WL_WIN = 0;
constexpr size_t WL_WF = WL_WIN + (size_t)NC * D * 2;
constexpr size_t WL_WH = WL_WF + (size_t)D * 256 * 2;
constexpr size_t WL_WA = WL_WH + (size_t)D * 256 * 2;
constexpr size_t WL_WO = WL_WA + (size_t)D * 512 * 2;
constexpr size_t WL_WE1 = WL_WO + (size_t)D * D * 2;
constexpr size_t WL_WE2 = WL_WE1 + (size_t)32 * 2048 * 1024 * 2;
constexpr size_t WL_SIZE = WL_WE2 + (size_t)32 * 1024 * 1024 * 2;
constexpr size_t O_WT = 0;
constexpr size_t O_MOD = O_WT + 2 * WL_SIZE;
constexpr size_t O_Z2 = O_MOD + 2 * 5 * 6144 * 4;
constexpr size_t O_Z2C = O_Z2 + (size_t)2 * L * 64 * 4;
constexpr size_t O_SPEC = O_Z2C + (size_t)LC * 64 * 4;
constexpr size_t O_FILTC = O_SPEC + (size_t)2 * 2 * 256 * 16384 * 8;
constexpr size_t O_XA = O_FILTC + (size_t)2 * 256 * 512 * 4;
constexpr size_t O_H = O_XA + (size_t)TA * D * 4;
constexpr size_t O_PROJ = O_H + (size_t)TA * D * 2;
constexpr size_t O_QN = O_PROJ + (size_t)TA * NC * 2;
constexpr size_t O_KN = O_QN + (size_t)NB * 4 * 2 * LK * 64 * 2;
constexpr size_t O_VT = O_KN + (size_t)NB * 4 * 2 * LK * 64 * 2;
constexpr size_t O_FM = O_VT + (size_t)NB * 4 * 128 * LK * 2;
constexpr size_t O_HY = O_FM + (size_t)TA * 256 * 2;
constexpr size_t O_O = O_HY + (size_t)TA * 256 * 2;
constexpr size_t O_MERGED = O_O + (size_t)TA * 512 * 2;
constexpr size_t O_HYSCR = O_MERGED + (size_t)TA * D * 2;
constexpr size_t O_YEND0 = O_HYSCR + (size_t)256 * 4 * 8192 * 8;
constexpr size_t O_Y = O_QN;
constexpr size_t Y_BYTES = (size_t)NR * D * 2;
constexpr size_t O_SMALL = (O_YEND0 > O_Y + Y_BYTES) ? O_YEND0 : (O_Y + Y_BYTES);
constexpr size_t O_TOKE = O_SMALL;
constexpr size_t O_TOKG = O_TOKE + (size_t)TA * 16;
constexpr size_t O_TOKLP = O_TOKG + (size_t)TA * 16;
constexpr size_t O_TOKSLOT = O_TOKLP + (size_t)TA * 16;
constexpr size_t O_CNT = O_TOKSLOT + (size_t)TA * 16;
constexpr size_t O_ROWTOK = O_CNT + 256 * 32 * 4;
constexpr size_t O_TILEE = O_ROWTOK + (size_t)NR * 4;
constexpr size_t O_ZT = O_TILEE + 4096;
constexpr size_t O_GF = O_ZT + (size_t)NB * 1024 * L * 2;
constexpr size_t O_FMT = O_GF + (size_t)3 * TA * 1024 * 2;
constexpr size_t O_HYT = O_FMT + (size_t)NB * 256 * L * 2;
constexpr size_t O_BAR = O_HYT + (size_t)NB * 256 * L * 2;
constexpr size_t WS_NEED = O_BAR + 16384;
static_assert((size_t)NR * D * 2 <= (size_t)TA * NC * 2, "ACT must fit in PROJ");

struct P {
  const float* in[35];
  float* out;
  unsigned char* ws;
  unsigned long long ws_size;
};
enum { I_X = 0, I_C, I_CTX, I_CCTX, I_WMOD, I_BMOD, I_N1G, I_N2G, I_WIN, I_HCW, I_HCB, I_HW1, I_HB1, I_HF1, I_HW2, I_HB2,
       I_HF2, I_HW3, I_HB3, I_HBIAS, I_QNG, I_KNG, I_LAMQ, I_LAMK, I_SUBG, I_WF, I_WH, I_WA, I_WO, I_WR, I_BR, I_WE1, I_BE1, I_WE2, I_BE2 };

DI float bf2f(u16 v) { return __uint_as_float(((unsigned)v) << 16); }
DI unsigned pack2(float a, float b) { fl2_t f = {a, b}; bf2_t r = __builtin_convertvector(f, bf2_t); return __builtin_bit_cast(unsigned, r); }
DI u16 f2bf(float a) { return (u16)(pack2(a, 0.f) & 0xffffu); }
DI float lo16(unsigned u) { return __uint_as_float(u << 16); }
DI float hi16(unsigned u) { return __uint_as_float(u & 0xffff0000u); }
DI float sin_t(float turns) { return __builtin_amdgcn_sinf(__builtin_amdgcn_fractf(turns)); }
DI float cos_t(float turns) { return __builtin_amdgcn_cosf(__builtin_amdgcn_fractf(turns)); }
DI int otid() { int t = threadIdx.x; asm volatile("" : "+v"(t)); return t; }
DI float shx(float v, int o) { int lane = otid() & 63; return __builtin_bit_cast(float, __builtin_amdgcn_ds_bpermute((lane ^ o) << 2, __builtin_bit_cast(int, v))); }
DI float wave_sum(float v) { for (int o = 32; o >= 1; o >>= 1) v += shx(v, o); return v; }
DI float wave_max(float v) { for (int o = 32; o >= 1; o >>= 1) v = fmaxf(v, shx(v, o)); return v; }
DI float sigmoidf_(float x) { return 1.f / (1.f + __expf(-x)); }
DI size_t boff(int row, int k, int K) { return ((size_t)(row >> 8) * (K >> 6) + (k >> 6)) * 16384 + (row & 255) * 64 + (k & 63); }
DI size_t boff128(int row, int k, int K) { return ((size_t)(row >> 7) * (K >> 6) + (k >> 6)) * 8192 + (row & 127) * 64 + (k & 63); }
DI int crow(int i, int hh) { return (i & 3) + 8 * (i >> 2) + 4 * hh; }
DI float lam_init_of(int l) { return l == 0 ? 0.2f : 0.35550906f; }

DI float block_sum(float v, float* red) {
  v = wave_sum(v);
  __syncthreads();
  if ((otid() & 63) == 0) red[otid() >> 6] = v;
  __syncthreads();
  float s = 0.f;
  for (int i = 0; i < NT / 64; ++i) s += red[i];
  return s;
}

DI int phys(int p) { return p + (p >> 4); }
DI float2 cmul(float2 a, float2 b) { return make_float2(a.x * b.x - a.y * b.y, a.x * b.y + a.y * b.x); }

template <int N, bool INV>
DI void fft_lds(float2* s) {
  constexpr int LG = (N == 16384) ? 14 : (N == 8192) ? 13 : 9;
  const int tid = otid();
  if (!INV) {
    if (LG & 1) {
      __syncthreads();
      constexpr int h = N / 2;
#pragma unroll 4
      for (int j = tid; j < h; j += NT) {
        float f = (float)j * (1.0f / N);
        float2 w = make_float2(cos_t(f), -sin_t(f));
        float2 a = s[phys(j)], b = s[phys(j + h)];
        s[phys(j)] = make_float2(a.x + b.x, a.y + b.y);
        s[phys(j + h)] = cmul(make_float2(a.x - b.x, a.y - b.y), w);
      }
    }
    for (int lq = (LG & 1) ? LG - 3 : LG - 2; lq >= 0; lq -= 2) {
      const int q = 1 << lq;
      __syncthreads();
      const float inv4q = 1.0f / (float)(4 * q);
#pragma unroll 4
      for (int it = 0; it < N / 4 / NT; ++it) {
        int idx = tid + it * NT;
        int j = idx & (q - 1), blk = idx >> lq;
        int p0 = blk * 4 * q + j;
        float f = (float)j * inv4q;
        float2 t1 = make_float2(cos_t(f), -sin_t(f));
        float2 t2 = cmul(t1, t1);
        float2 x0 = s[phys(p0)], x1 = s[phys(p0 + q)], x2 = s[phys(p0 + 2 * q)], x3 = s[phys(p0 + 3 * q)];
        float2 a0 = make_float2(x0.x + x2.x, x0.y + x2.y);
        float2 a2 = cmul(make_float2(x0.x - x2.x, x0.y - x2.y), t1);
        float2 a1 = make_float2(x1.x + x3.x, x1.y + x3.y);
        float2 d3 = make_float2(x1.x - x3.x, x1.y - x3.y);
        float2 a3 = cmul(make_float2(d3.y, -d3.x), t1);
        s[phys(p0)] = make_float2(a0.x + a1.x, a0.y + a1.y);
        s[phys(p0 + q)] = cmul(make_float2(a0.x - a1.x, a0.y - a1.y), t2);
        s[phys(p0 + 2 * q)] = make_float2(a2.x + a3.x, a2.y + a3.y);
        s[phys(p0 + 3 * q)] = cmul(make_float2(a2.x - a3.x, a2.y - a3.y), t2);
      }
    }
  } else {
    constexpr int top = (LG & 1) ? N / 8 : N / 4;
    for (int lq = 0; (1 << lq) <= top; lq += 2) {
      const int q = 1 << lq;
      __syncthreads();
      const float inv4q = 1.0f / (float)(4 * q);
#pragma unroll 4
      for (int it = 0; it < N / 4 / NT; ++it) {
        int idx = tid + it * NT;
        int j = idx & (q - 1), blk = idx >> lq;
        int p0 = blk * 4 * q + j;
        float f = (float)j * inv4q;
        float2 t1 = make_float2(cos_t(f), sin_t(f));
        float2 t2 = cmul(t1, t1);
        float2 x0 = s[phys(p0)], x1 = s[phys(p0 + q)], x2 = s[phys(p0 + 2 * q)], x3 = s[phys(p0 + 3 * q)];
        float2 b = cmul(x1, t2);
        float2 a0 = make_float2(x0.x + b.x, x0.y + b.y), a1 = make_float2(x0.x - b.x, x0.y - b.y);
        b = cmul(x3, t2);
        float2 a2 = make_float2(x2.x + b.x, x2.y + b.y), a3 = make_float2(x2.x - b.x, x2.y - b.y);
        b = cmul(a2, t1);
        s[phys(p0)] = make_float2(a0.x + b.x, a0.y + b.y);
        s[phys(p0 + 2 * q)] = make_float2(a0.x - b.x, a0.y - b.y);
        float2 c3 = cmul(a3, t1);
        b = make_float2(-c3.y, c3.x);
        s[phys(p0 + q)] = make_float2(a1.x + b.x, a1.y + b.y);
        s[phys(p0 + 3 * q)] = make_float2(a1.x - b.x, a1.y - b.y);
      }
    }
    if (LG & 1) {
      __syncthreads();
      constexpr int h = N / 2;
#pragma unroll 4
      for (int j = tid; j < h; j += NT) {
        float f = (float)j * (1.0f / N);
        float2 w = make_float2(cos_t(f), sin_t(f));
        float2 a = s[phys(j)], b = cmul(s[phys(j + h)], w);
        s[phys(j)] = make_float2(a.x + b.x, a.y + b.y);
        s[phys(j + h)] = make_float2(a.x - b.x, a.y - b.y);
      }
    }
  }
  __syncthreads();
}

DI void convT_tile(const float* __restrict__ src, int K, int N, u16* __restrict__ dst, bool perm, int blockR, int t, float* sm) {
  const int tk = K / 64, tn = N / 256, per = tk * tn;
  const int tid = otid();
  int bt = t / per, rr = t % per, kt = rr / tn, nt = rr % tn;
  const float* sp = src + (size_t)bt * K * N + (size_t)(kt * 64) * N + nt * 256;
  u16* dp = dst + (size_t)bt * K * N;
  int kr = tid >> 3, c8 = (tid & 7) * 8;
  float4 a[4], b[4];
#pragma unroll
  for (int q = 0; q < 4; ++q) {
    a[q] = *(const float4*)(sp + (size_t)kr * N + q * 64 + c8);
    b[q] = *(const float4*)(sp + (size_t)kr * N + q * 64 + c8 + 4);
  }
  __syncthreads();
#pragma unroll
  for (int q = 0; q < 4; ++q) {
    float* row = sm + kr * 257 + q * 64 + c8;
    row[0] = a[q].x; row[1] = a[q].y; row[2] = a[q].z; row[3] = a[q].w; row[4] = b[q].x; row[5] = b[q].y; row[6] = b[q].z; row[7] = b[q].w;
  }
  __syncthreads();
#pragma unroll
  for (int q = 0; q < 4; ++q) {
    int n = (tid >> 3) + 64 * q, k8 = (tid & 7) * 8;
    float v[8];
#pragma unroll
    for (int j = 0; j < 8; ++j) v[j] = sm[(k8 + j) * 257 + n];
    int ng = nt * 256 + n;
    if (perm) { int j2 = ng >> 1; ng = (j2 >> 5) * 64 + ((ng & 1) ? 32 : 0) + (j2 & 31); }
    uint4 o = make_uint4(pack2(v[0], v[1]), pack2(v[2], v[3]), pack2(v[4], v[5]), pack2(v[6], v[7]));
    size_t doff = blockR == 256 ? boff(ng, kt * 64 + k8, K) : blockR == 128 ? boff128(ng, kt * 64 + k8, K) : (size_t)ng * K + kt * 64 + k8;
    *(uint4*)(dp + doff) = o;
  }
}

DI void conv_all(const P& p, float* sm) {
  constexpr int C_E1 = 32 * 16 * 8, C_E2 = 32 * 16 * 4, C_IN = 16 * (NC / 256), C_O = 16 * 4, C_A = 8 * 4, C_F = 4 * 4, C_H = 4 * 4;
  constexpr int PER = C_E1 + C_E2 + C_IN + C_O + C_A + C_F + C_H;
  for (int t = blockIdx.x; t < 2 * PER; t += gridDim.x) {
    const int l = t / PER;
    int r = t - l * PER;
    unsigned char* WL = p.ws + O_WT + l * WL_SIZE;
    const float* src; u16* dst; int K, N, blockR = 0; bool perm = false;
    if (r < C_E1) { src = p.in[I_WE1] + (size_t)l * 32 * 1024 * 2048; dst = (u16*)(WL + WL_WE1); K = 1024; N = 2048; perm = true; blockR = 256; }
    else if ((r -= C_E1) < C_E2) { src = p.in[I_WE2] + (size_t)l * 32 * 1024 * 1024; dst = (u16*)(WL + WL_WE2); K = 1024; N = 1024; blockR = 256; }
    else if ((r -= C_E2) < C_IN) { src = p.in[I_WIN] + (size_t)l * 1024 * NC; dst = (u16*)(WL + WL_WIN); K = 1024; N = NC; blockR = 256; }
    else if ((r -= C_IN) < C_O) { src = p.in[I_WO] + (size_t)l * 1024 * 1024; dst = (u16*)(WL + WL_WO); K = 1024; N = 1024; }
    else if ((r -= C_O) < C_A) { src = p.in[I_WA] + (size_t)l * 512 * 1024; dst = (u16*)(WL + WL_WA); K = 512; N = 1024; }
    else if ((r -= C_A) < C_F) { src = p.in[I_WF] + (size_t)l * 256 * 1024; dst = (u16*)(WL + WL_WF); K = 256; N = 1024; }
    else { r -= C_F; src = p.in[I_WH] + (size_t)l * 256 * 1024; dst = (u16*)(WL + WL_WH); K = 256; N = 1024; }
    convT_tile(src, K, N, dst, perm, blockR, r, sm);
  }
  __syncthreads();
}

DI void mod_phase(const P& p, float* sm) {
  const int tid = otid();
  float* sl = sm;
  float* red = sm + 5 * 1024;
  __syncthreads();
  for (int i = tid; i < 5 * 1024; i += NT) {
    int r = i >> 10, d = i & 1023;
    float c = (r < 4) ? p.in[I_C][r * 1024 + d] : p.in[I_CCTX][d];
    sl[i] = c / (1.f + __expf(-c));
  }
  __syncthreads();
  float* MOD = (float*)(p.ws + O_MOD);
  for (int it = blockIdx.x; it < 2 * 96; it += gridDim.x) {
    int l = it / 96, c0 = (it % 96) * 64;
    int col = tid & 63, ds = tid >> 6;
    const float* w = p.in[I_WMOD] + (size_t)l * 1024 * 6144 + c0 + col;
    float acc[5] = {0.f, 0.f, 0.f, 0.f, 0.f};
    for (int d = ds * 128; d < ds * 128 + 128; ++d) {
      float wv = w[(size_t)d * 6144];
#pragma unroll
      for (int r = 0; r < 5; ++r) acc[r] += sl[r * 1024 + d] * wv;
    }
    __syncthreads();
#pragma unroll
    for (int r = 0; r < 5; ++r) red[(ds * 5 + r) * 64 + col] = acc[r];
    __syncthreads();
    if (tid < 320) {
      int r = tid >> 6, cc = tid & 63;
      float s = 0.f;
      for (int k = 0; k < 8; ++k) s += red[(k * 5 + r) * 64 + cc];
      MOD[(l * 5 + r) * 6144 + c0 + cc] = s + p.in[I_BMOD][l * 6144 + c0 + cc];
    }
  }
  __syncthreads();
}

DI void z2_phase(const P& p, float* sm) {
  const int tid = otid();
  const int tt = tid >> 6, j = tid & 63;
  float* emb = sm;
  float* z1 = sm + 8 * 33;
  const int n_lat = L / 8, n_ctx = LC / 8;
  for (int it = blockIdx.x; it < 2 * n_lat + n_ctx; it += gridDim.x) {
    int l, Lf, t0; float* dst;
    if (it < 2 * n_lat) { l = it / n_lat; Lf = L; t0 = (it % n_lat) * 8; dst = (float*)(p.ws + O_Z2) + (size_t)l * L * 64; }
    else { l = 0; Lf = LC; t0 = (it - 2 * n_lat) * 8; dst = (float*)(p.ws + O_Z2C); }
    int t = t0 + tt;
    __syncthreads();
    if (j < 33) {
      float v;
      if (j == 0) v = (float)t / (float)(Lf - 1);
      else {
        int k = (j - 1) & 15;
        float band = 1e-4f + (float)k * ((15.f - 1e-4f) / 15.f);
        float turns = band * ((float)t / (float)Lf);
        v = (j <= 16) ? cos_t(turns) : -sin_t(turns);
      }
      emb[tt * 33 + j] = v;
    }
    __syncthreads();
    const float* w1 = p.in[I_HW1] + l * 33 * 64;
    float a = p.in[I_HB1][l * 64 + j];
    for (int i = 0; i < 33; ++i) a += emb[tt * 33 + i] * w1[i * 64 + j];
    z1[tt * 64 + j] = sin_t(p.in[I_HF1][l * 64 + j] * a * 0.15915494309189535f);
    __syncthreads();
    const float* w2 = p.in[I_HW2] + l * 64 * 64;
    float a2 = p.in[I_HB2][l * 64 + j];
    for (int i = 0; i < 64; ++i) a2 += z1[tt * 64 + i] * w2[i * 64 + j];
    dst[(size_t)t * 64 + j] = sin_t(p.in[I_HF2][l * 64 + j] * a2 * 0.15915494309189535f);
  }
  __syncthreads();
}

DI float hy_delta(int c) { return 4.605170185988091f * (1.f / 1.5f + (float)c * (1.f / 255.f) * (1.f / 0.3f - 1.f / 1.5f)); }

DI void filter_phase(const P& p, unsigned char* lds) {
  float2* s = (float2*)lds;
  float* w3s_ = (float*)(lds + 17408 * 8);
  float* red = w3s_ + 256;
  for (int it = blockIdx.x; it < 512 + 256; it += gridDim.x) {
    const int tid = otid();
    const bool lat = it < 512;
    const int l = lat ? (it >> 8) : 0, c = it & 255;
    const int Lf = lat ? L : LC;
    const float* z2 = lat ? (const float*)(p.ws + O_Z2) + (size_t)l * L * 64 : (const float*)(p.ws + O_Z2C);
    __syncthreads();
    if (tid < 256) {
      int od = tid >> 6, i = tid & 63;
      w3s_[tid] = p.in[I_HW3][(size_t)l * 64 * 1024 + i * 1024 + od * 256 + c];
    }
    __syncthreads();
    const float delta = hy_delta(c);
    float lsum0 = 0.f, lsum1 = 0.f;
    float2* park = (float2*)(p.ws + O_HYSCR) + (size_t)blockIdx.x * 4 * 8192;
#pragma unroll 1
    for (int k = 0; k < 16; ++k) {
      const int t = tid + k * NT;
      if (t < Lf) {
        const float4* zr = (const float4*)(z2 + (size_t)t * 64);
        const float* b3p = p.in[I_HB3] + l * 1024 + c;
        float a0 = b3p[0], a1 = b3p[256], a2 = b3p[512], a3 = b3p[768];
        const float* w3s = w3s_;
        asm volatile("" : "+v"(w3s));
#pragma unroll
        for (int i = 0; i < 16; ++i) {
          float4 z = zr[i];
          a0 += z.x * w3s[4 * i] + z.y * w3s[4 * i + 1] + z.z * w3s[4 * i + 2] + z.w * w3s[4 * i + 3];
          a1 += z.x * w3s[64 + 4 * i] + z.y * w3s[64 + 4 * i + 1] + z.z * w3s[64 + 4 * i + 2] + z.w * w3s[64 + 4 * i + 3];
          a2 += z.x * w3s[128 + 4 * i] + z.y * w3s[128 + 4 * i + 1] + z.z * w3s[128 + 4 * i + 2] + z.w * w3s[128 + 4 * i + 3];
          a3 += z.x * w3s[192 + 4 * i] + z.y * w3s[192 + 4 * i + 1] + z.z * w3s[192 + 4 * i + 2] + z.w * w3s[192 + 4 * i + 3];
        }
        float dec = __expf(-((float)t / (float)(Lf - 1)) * delta);
        a0 *= dec; a1 *= dec; a2 *= dec; a3 *= dec;
        s[phys(t)] = make_float2(a0, 0.f);
        lsum0 += fabsf(a0);
        lsum1 += fabsf(a2);
        if (t >= 1) { s[phys(2 * Lf - t)] = make_float2(a1, 0.f); lsum0 += fabsf(a1); lsum1 += fabsf(a3); }
        else s[phys(Lf)] = make_float2(0.f, 0.f);
        park[t] = make_float2(a2, a3);
      }
    }
#pragma unroll 1
    for (int o = 0; o < 2; ++o) {
      const int tid = otid();
      if (o == 1) {
        __syncthreads();
#pragma unroll 4
        for (int k = 0; k < 16; ++k) {
          const int t = tid + k * NT;
          if (t < Lf) {
            float2 pv = park[t];
            s[phys(t)] = make_float2(pv.x, 0.f);
            if (t >= 1) s[phys(2 * Lf - t)] = make_float2(pv.y, 0.f);
            else s[phys(Lf)] = make_float2(0.f, 0.f);
          }
        }
      }
      float tot = block_sum(o == 0 ? lsum0 : lsum1, red);
      float inv = 1.f / tot;
      if (lat) {
        fft_lds<16384, false>(s);
        float2* dst = (float2*)(p.ws + O_SPEC) + ((size_t)(l * 2 + o) * 256 + c) * 16384;
#pragma unroll 8
        for (int i = tid; i < 16384; i += NT) { float2 v = s[phys(i)]; dst[i] = make_float2(v.x * inv, v.y * inv); }
      } else {
        float* dst = (float*)(p.ws + O_FILTC) + (size_t)(o * 256 + c) * 512;
        dst[tid] = s[phys(tid)].x * inv;
      }
    }
  }
  __syncthreads();
}

DI void norm_mod_store(const float (&xv)[16], const float* g, const float* shift, const float* scale, u16* Hb, int row, int lane) {
  float ss = 0.f;
#pragma unroll
  for (int i = 0; i < 16; ++i) ss += xv[i] * xv[i];
  ss = wave_sum(ss);
  float rinv = rsqrtf(ss * (1.f / 1024.f) + 1e-6f);
#pragma unroll
  for (int i = 0; i < 4; ++i) {
    int c = (i * 64 + lane) * 4;
    float4 gv = *(const float4*)(g + c), sh = *(const float4*)(shift + c), sc = *(const float4*)(scale + c);
    float h0 = xv[4 * i] * rinv * gv.x * (1.f + sc.x) + sh.x;
    float h1 = xv[4 * i + 1] * rinv * gv.y * (1.f + sc.y) + sh.y;
    float h2 = xv[4 * i + 2] * rinv * gv.z * (1.f + sc.z) + sh.z;
    float h3 = xv[4 * i + 3] * rinv * gv.w * (1.f + sc.w) + sh.w;
    *(uint2*)(Hb + boff(row, c, 1024)) = make_uint2(pack2(h0, h1), pack2(h2, h3));
  }
}

DI void norm1_layer0(const P& p) {
  const int lane = otid() & 63, gw = blockIdx.x * (NT / 64) + (otid() >> 6), nw = gridDim.x * (NT / 64);
  const float* MOD = (const float*)(p.ws + O_MOD);
  u16* H = (u16*)(p.ws + O_H);
  for (int row = gw; row < TA; row += nw) {
    const float* xr = row < T ? p.in[I_X] + (size_t)row * D : p.in[I_CTX] + (size_t)(row - T) * D;
    int mr = row < T ? (row >> 13) : 4;
    float xv[16];
#pragma unroll
    for (int i = 0; i < 4; ++i) { float4 v = *(const float4*)(xr + (i * 64 + lane) * 4); xv[4 * i] = v.x; xv[4 * i + 1] = v.y; xv[4 * i + 2] = v.z; xv[4 * i + 3] = v.w; }
    norm_mod_store(xv, p.in[I_N1G], MOD + mr * 6144, MOD + mr * 6144 + 1024, H, row, lane);
  }
}

constexpr int G_AST = 144;
constexpr int G_ABYTES = 256 * G_AST, G_BBYTES = 128 * G_AST, G_STAGE = G_ABYTES + G_BBYTES;

#define G_LOADR(S, ko) do { S##0 = *(const uint4*)(a0p + (ko)); S##1 = *(const uint4*)(a1p + (ko)); S##2 = *(const uint4*)(a2p + (ko)); \
    S##3 = *(const uint4*)(a3p + (ko)); S##4 = *(const uint4*)(b0p + (ko)); S##5 = *(const uint4*)(b1p + (ko)); } while (0)
#define G_STORER(S, nb) do { *(uint4*)((nb) + wofs) = S##0; *(uint4*)((nb) + wofs + 64 * G_AST) = S##1; *(uint4*)((nb) + wofs + 128 * G_AST) = S##2; \
    *(uint4*)((nb) + wofs + 192 * G_AST) = S##3; *(uint4*)((nb) + G_ABYTES + wofs) = S##4; *(uint4*)((nb) + G_ABYTES + wofs + 64 * G_AST) = S##5; } while (0)

DI void gemm_compute(f32x16 (&acc)[2][2], const unsigned char* As, const unsigned char* Bs) {
  bf16x8 a0 = *(const bf16x8*)(As), a1 = *(const bf16x8*)(As + 32 * G_AST);
  bf16x8 b0 = *(const bf16x8*)(Bs), b1 = *(const bf16x8*)(Bs + 32 * G_AST);
#pragma unroll
  for (int ks = 0; ks < 4; ++ks) {
    bf16x8 na0 = a0, na1 = a1, nb0 = b0, nb1 = b1;
    if (ks < 3) {
      na0 = *(const bf16x8*)(As + (ks + 1) * 32); na1 = *(const bf16x8*)(As + 32 * G_AST + (ks + 1) * 32);
      nb0 = *(const bf16x8*)(Bs + (ks + 1) * 32); nb1 = *(const bf16x8*)(Bs + 32 * G_AST + (ks + 1) * 32);
    }
    acc[0][0] = MFMA16(a0, b0, acc[0][0]);
    acc[0][1] = MFMA16(a0, b1, acc[0][1]);
    acc[1][0] = MFMA16(a1, b0, acc[1][0]);
    acc[1][1] = MFMA16(a1, b1, acc[1][1]);
    a0 = na0; a1 = na1; b0 = nb0; b1 = nb1;
  }
}

DI void gemm_main(f32x16 (&acc)[2][2], const u16* const (&ap)[4], const u16* const (&bp)[2], int K, unsigned char* lds) {
  const int tid = otid(), lane = tid & 63, w = tid >> 6, r = lane & 31, hh = lane >> 5;
  const int wm = w >> 1, wn = w & 1;
  const int wofs = (tid >> 3) * G_AST + (tid & 7) * 16;
  const u16* a0p = ap[0]; const u16* a1p = ap[1]; const u16* a2p = ap[2]; const u16* a3p = ap[3];
  const u16* b0p = bp[0]; const u16* b1p = bp[1];
  uint4 P0, P1, P2, P3, P4, P5, Q0, Q1, Q2, Q3, Q4, Q5;
  G_LOADR(P, 0);
  G_LOADR(Q, 64);
  G_STORER(P, lds);
  __syncthreads();
  const unsigned char* As0 = lds + (wm * 64 + r) * G_AST + hh * 16;
  const unsigned char* Bs0 = lds + G_ABYTES + (wn * 64 + r) * G_AST + hh * 16;
  const int nk = K >> 6;
  for (int kt = 0; kt < nk; kt += 2) {
    if (kt + 2 < nk) G_LOADR(P, (kt + 2) * 64);
    __builtin_amdgcn_sched_barrier(0);
    gemm_compute(acc, As0, Bs0);
    __builtin_amdgcn_sched_barrier(0);
    G_STORER(Q, lds + G_STAGE);
    __syncthreads();
    if (kt + 3 < nk) G_LOADR(Q, (kt + 3) * 64);
    __builtin_amdgcn_sched_barrier(0);
    gemm_compute(acc, As0 + G_STAGE, Bs0 + G_STAGE);
    __builtin_amdgcn_sched_barrier(0);
    if (kt + 2 < nk) G_STORER(P, lds);
    __syncthreads();
  }
}

DI void acc_zero(f32x16 (&acc)[2][2]) {
#pragma unroll
  for (int a = 0; a < 2; ++a)
#pragma unroll
    for (int b = 0; b < 2; ++b)
#pragma unroll
      for (int i = 0; i < 16; ++i) acc[a][b][i] = 0.f;
}

constexpr int G2_ABYTES = 256 * G_AST, G2_STAGE = 2 * G2_ABYTES;
#define G2_LOADR(kt_) do { const size_t ko = (size_t)(kt_) * 16384; R0 = *(const uint4*)(a0p + ko); R1 = *(const uint4*)(a1p + ko); R2 = *(const uint4*)(a2p + ko); R3 = *(const uint4*)(a3p + ko); \
    R4 = *(const uint4*)(b0p + ko); R5 = *(const uint4*)(b0p + 4096 + ko); R6 = *(const uint4*)(b0p + 8192 + ko); R7 = *(const uint4*)(b0p + 12288 + ko); } while (0)
#define G2_STORER(nb) do { *(uint4*)((nb) + wofs) = R0; *(uint4*)((nb) + wofs + 64 * G_AST) = R1; *(uint4*)((nb) + wofs + 128 * G_AST) = R2; *(uint4*)((nb) + wofs + 192 * G_AST) = R3; \
    *(uint4*)((nb) + G2_ABYTES + wofs) = R4; *(uint4*)((nb) + G2_ABYTES + wofs + 64 * G_AST) = R5; *(uint4*)((nb) + G2_ABYTES + wofs + 128 * G_AST) = R6; \
    *(uint4*)((nb) + G2_ABYTES + wofs + 192 * G_AST) = R7; } while (0)

template <bool TR>
DI void gemm256_compute(f32x16 (&acc)[4][2], const unsigned char* As, const unsigned char* Bs) {
  __builtin_amdgcn_s_setprio(2);
  bf16x8 b0 = *(const bf16x8*)(Bs), b1 = *(const bf16x8*)(Bs + 32 * G_AST);
  bf16x8 a0 = *(const bf16x8*)(As), a1 = *(const bf16x8*)(As + 32 * G_AST), a2 = *(const bf16x8*)(As + 64 * G_AST), a3 = *(const bf16x8*)(As + 96 * G_AST);
#pragma unroll
  for (int ks = 0; ks < 4; ++ks) {
    bf16x8 nb0 = b0, nb1 = b1, na0 = a0, na1 = a1, na2 = a2, na3 = a3;
    if (ks < 3) {
      nb0 = *(const bf16x8*)(Bs + (ks + 1) * 32); nb1 = *(const bf16x8*)(Bs + 32 * G_AST + (ks + 1) * 32);
      na0 = *(const bf16x8*)(As + (ks + 1) * 32); na1 = *(const bf16x8*)(As + 32 * G_AST + (ks + 1) * 32);
      na2 = *(const bf16x8*)(As + 64 * G_AST + (ks + 1) * 32); na3 = *(const bf16x8*)(As + 96 * G_AST + (ks + 1) * 32);
    }
    if (TR) {
      acc[0][0] = MFMA16(b0, a0, acc[0][0]); acc[0][1] = MFMA16(b1, a0, acc[0][1]);
      acc[1][0] = MFMA16(b0, a1, acc[1][0]); acc[1][1] = MFMA16(b1, a1, acc[1][1]);
      acc[2][0] = MFMA16(b0, a2, acc[2][0]); acc[2][1] = MFMA16(b1, a2, acc[2][1]);
      acc[3][0] = MFMA16(b0, a3, acc[3][0]); acc[3][1] = MFMA16(b1, a3, acc[3][1]);
    } else {
      acc[0][0] = MFMA16(a0, b0, acc[0][0]); acc[0][1] = MFMA16(a0, b1, acc[0][1]);
      acc[1][0] = MFMA16(a1, b0, acc[1][0]); acc[1][1] = MFMA16(a1, b1, acc[1][1]);
      acc[2][0] = MFMA16(a2, b0, acc[2][0]); acc[2][1] = MFMA16(a2, b1, acc[2][1]);
      acc[3][0] = MFMA16(a3, b0, acc[3][0]); acc[3][1] = MFMA16(a3, b1, acc[3][1]);
    }
    if (ks < 3) {
      __builtin_amdgcn_sched_group_barrier(0x100, 6, 0);
      __builtin_amdgcn_sched_group_barrier(0x008, 8, 0);
    }
    b0 = nb0; b1 = nb1; a0 = na0; a1 = na1; a2 = na2; a3 = na3;
  }
  __builtin_amdgcn_s_setprio(0);
}

template <bool TR = false>
DI void gemm256(f32x16 (&acc)[4][2], const u16* const (&ap)[4], const u16* b0p, int K, unsigned char* lds) {
  const int tid = otid(), lane = tid & 63, w = tid >> 6, r = lane & 31, hh = lane >> 5;
  const int wm = w >> 2, wn = w & 3;
  const int wofs = (tid >> 3) * G_AST + (tid & 7) * 16;
  const u16* a0p = ap[0]; const u16* a1p = ap[1]; const u16* a2p = ap[2]; const u16* a3p = ap[3];
  uint4 R0, R1, R2, R3, R4, R5, R6, R7;
  const int nk = K >> 6;
  const bool late = w >= 4;
  G2_LOADR(0);
  G2_STORER(lds);
  if (late && nk > 1) G2_LOADR(1);
  __syncthreads();
  const unsigned char* As0 = lds + (wm * 128 + r) * G_AST + hh * 16;
  const unsigned char* Bs0 = lds + G2_ABYTES + (wn * 64 + r) * G_AST + hh * 16;
  if (!late) {
    for (int kt = 0; kt < nk; ++kt) {
      const bool more = kt + 1 < nk;
      if (more) G2_LOADR(kt + 1);
      __builtin_amdgcn_sched_barrier(0);
      gemm256_compute<TR>(acc, As0 + (kt & 1) * G2_STAGE, Bs0 + (kt & 1) * G2_STAGE);
      __builtin_amdgcn_sched_barrier(0);
      if (more) G2_STORER(lds + ((kt + 1) & 1) * G2_STAGE);
      __syncthreads();
    }
  } else {
    for (int kt = 0; kt < nk; ++kt) {
      if (kt + 1 < nk) G2_STORER(lds + ((kt + 1) & 1) * G2_STAGE);
      __builtin_amdgcn_sched_barrier(0);
      if (kt + 2 < nk) G2_LOADR(kt + 2);
      __builtin_amdgcn_sched_barrier(0);
      gemm256_compute<TR>(acc, As0 + (kt & 1) * G2_STAGE, Bs0 + (kt & 1) * G2_STAGE);
      __syncthreads();
    }
  }
}
DI void acc_zero4(f32x16 (&acc)[4][2]) {
#pragma unroll
  for (int a = 0; a < 4; ++a)
#pragma unroll
    for (int b = 0; b < 2; ++b)
#pragma unroll
      for (int i = 0; i < 16; ++i) acc[a][b][i] = 0.f;
}

DI void set_ap(const u16* (&ap)[4], const u16* A, int lda, int m0) {
  const int tid = otid();
#pragma unroll
  for (int i = 0; i < 4; ++i) ap[i] = A + (size_t)(m0 + (tid >> 3) + 64 * i) * lda + (tid & 7) * 8;
}
DI void set_bp(const u16* (&bp)[2], const u16* Bt, int ldb, int n0) {
  const int tid = otid();
#pragma unroll
  for (int i = 0; i < 2; ++i) bp[i] = Bt + (size_t)(n0 + (tid >> 3) + 64 * i) * ldb + (tid & 7) * 8;
}

template <class F>
DI void for_tiles(int ntm, int ntn, F f) {
  const int xcd = blockIdx.x & 7, lb = blockIdx.x >> 3, nlb = gridDim.x >> 3;
  const int total = ((ntm + 3) & ~3) * ntn;
  const int chunk = (total + 7) >> 3;
  for (int i = lb; i < chunk; i += nlb) {
    int idx = xcd * chunk + i;
    if (idx >= total) break;
    int panel = idx / (4 * ntn), within = idx - panel * 4 * ntn;
    int n = within >> 2, m = panel * 4 + (within & 3);
    if (m < ntm) f(m, n);
  }
}

DI void g1_phase(const P& p, int l, unsigned char* lds) {
  const u16* H = (const u16*)(p.ws + O_H);
  const u16* Wt = (const u16*)(p.ws + O_WT + l * WL_SIZE + WL_WIN);
  u16* PROJ = (u16*)(p.ws + O_PROJ);
  for_tiles(TA / 256, NC / 256, [&](int tm_, int tn_) {
    int m0 = tm_ * 256, n0 = tn_ * 256;
    const u16* ap[4];
    const int tid0 = otid();
#pragma unroll
    for (int i = 0; i < 4; ++i) ap[i] = H + (size_t)tm_ * 16 * 16384 + tid0 * 8 + i * 4096;
    const u16* b0p = Wt + (size_t)tn_ * 16 * 16384 + tid0 * 8;
    f32x16 acc[4][2]; acc_zero4(acc);
    if (tn_ >= 4 && tn_ < 8) {
      gemm256<true>(acc, ap, b0p, D, lds);
      const int tid = otid(), lane = tid & 63, w = tid >> 6, r = lane & 31, hh = lane >> 5, wm = w >> 2, wn = w & 3;
      const int grp = ((n0 - OFF_Q) >> 6) + wn, g8 = grp & 7;
      const bool isq = grp < 8, lat = tm_ < T / 256;
      const float* gg = p.in[isq ? I_QNG : I_KNG] + l * 64;
      const float post = isq ? (LOG2E * 0.125f) : 1.f;
      u16* dstb = (u16*)(p.ws + (isq ? O_QN : O_KN));
#pragma unroll 1
      for (int mt = 0; mt < 4; ++mt) {
        const int row = m0 + wm * 128 + mt * 32 + r;
        int bb, n, kpos;
        if (lat) { bb = row >> 13; n = row & (L - 1); kpos = n; } else { int rc = row - T; bb = rc >> 8; n = rc & 255; kpos = L + n; }
        f32x16 x0, x1;
        if (mt == 0) { x0 = acc[0][0]; x1 = acc[0][1]; } else if (mt == 1) { x0 = acc[1][0]; x1 = acc[1][1]; }
        else if (mt == 2) { x0 = acc[2][0]; x1 = acc[2][1]; } else { x0 = acc[3][0]; x1 = acc[3][1]; }
        float ss = 0.f;
#pragma unroll
        for (int i = 0; i < 16; ++i) ss += x0[i] * x0[i] + x1[i] * x1[i];
        ss += shx(ss, 32);
        const float rinv = rsqrtf(ss * (1.f / 64.f) + 1e-6f);
#pragma unroll
        for (int i = 0; i < 16; ++i) { x0[i] *= rinv * gg[crow(i, hh)]; x1[i] *= rinv * gg[32 + crow(i, hh)]; }
        if (lat) {
          const float prow = (float)(n >> 6), pcol = (float)(n & 63);
#pragma unroll
          for (int i = 0; i < 8; ++i) {
            const float invt = __builtin_amdgcn_exp2f(-(float)crow(i, hh) * (13.287712379549449f / 16.f)) * 0.15915494309189535f;
            float t0 = prow * invt, t1 = pcol * invt;
            float c0 = cos_t(t0), s0 = sin_t(t0), c1 = cos_t(t1), s1 = sin_t(t1);
            float a0 = x0[i], b0 = x0[i + 8], a1 = x1[i], b1 = x1[i + 8];
            x0[i] = a0 * c0 - b0 * s0; x0[i + 8] = b0 * c0 + a0 * s0;
            x1[i] = a1 * c1 - b1 * s1; x1[i + 8] = b1 * c1 + a1 * s1;
          }
        }
        u16* dst = dstb + ((size_t)(bb * 8 + g8) * LK + kpos) * 64 + 4 * hh;
#pragma unroll
        for (int g4 = 0; g4 < 4; ++g4) {
          *(uint2*)(dst + 8 * g4) = make_uint2(pack2(x0[4 * g4] * post, x0[4 * g4 + 1] * post), pack2(x0[4 * g4 + 2] * post, x0[4 * g4 + 3] * post));
          *(uint2*)(dst + 32 + 8 * g4) = make_uint2(pack2(x1[4 * g4] * post, x1[4 * g4 + 1] * post), pack2(x1[4 * g4 + 2] * post, x1[4 * g4 + 3] * post));
        }
      }
      return;
    }
    gemm256<false>(acc, ap, b0p, D, lds);
    const int tid = otid(), lane = tid & 63, w = tid >> 6, r = lane & 31, hh = lane >> 5, wm = w >> 2, wn = w & 3;
    if (tn_ >= 8 && tn_ < 10) {
      const bool lat = tm_ < T / 256;
      int bb, nbase;
      if (lat) { bb = m0 >> 13; nbase = (m0 & (L - 1)) + wm * 128; } else { int rc = m0 - T; bb = rc >> 8; nbase = L + (rc & 255) + wm * 128; }
      u16* vb = (u16*)(p.ws + O_VT) + ((size_t)bb * 512 + (n0 - OFF_V) + wn * 64 + r) * LK + nbase;
#pragma unroll
      for (int mt = 0; mt < 4; ++mt)
#pragma unroll
        for (int nt = 0; nt < 2; ++nt)
#pragma unroll
          for (int g4 = 0; g4 < 4; ++g4) {
            const int k16 = 8 * (g4 & 1) + 4 * hh;
            const int pk = (k16 == 4) ? 8 : (k16 == 8) ? 4 : k16;
            *(uint2*)(vb + (size_t)nt * 32 * LK + mt * 32 + 16 * (g4 >> 1) + pk) =
                make_uint2(pack2(acc[mt][nt][4 * g4], acc[mt][nt][4 * g4 + 1]), pack2(acc[mt][nt][4 * g4 + 2], acc[mt][nt][4 * g4 + 3]));
          }
      return;
    }
    if (tn_ >= 10) {
      const int br = (tn_ - 10) >> 2, tn2 = ((tn_ - 10) & 3) * 2 + (wn >> 1), wn2 = wn & 1;
      u16* gf = (u16*)(p.ws + O_GF) + (size_t)br * TA * 1024;
#pragma unroll
      for (int mt = 0; mt < 4; ++mt) {
        const int wave2 = (2 * wm + (mt >> 1)) * 2 + wn2, mt2 = mt & 1;
#pragma unroll
        for (int nt = 0; nt < 2; ++nt)
#pragma unroll
          for (int g4 = 0; g4 < 4; ++g4) {
            size_t idx = ((((((size_t)tm_ * 8 + tn2) * 8 + wave2) * 2 + mt2) * 2 + nt) * 4 + g4) * 64 + lane;
            *(uint2*)(gf + idx * 4) = make_uint2(pack2(sigmoidf_(acc[mt][nt][4 * g4]), sigmoidf_(acc[mt][nt][4 * g4 + 1])),
                                                 pack2(sigmoidf_(acc[mt][nt][4 * g4 + 2]), sigmoidf_(acc[mt][nt][4 * g4 + 3])));
          }
      }
    } else if (tn_ < 4 && tm_ < T / 256) {
      const int bb = m0 >> 13, nl = (m0 & (L - 1)) + wm * 128 + 4 * hh;
      u16* zb = (u16*)(p.ws + O_ZT) + ((size_t)bb * 1024 + n0 + wn * 64 + r) * L + nl;
#pragma unroll
      for (int mt = 0; mt < 4; ++mt)
#pragma unroll
        for (int nt = 0; nt < 2; ++nt)
#pragma unroll
          for (int g4 = 0; g4 < 4; ++g4)
            *(uint2*)(zb + (size_t)nt * 32 * L + mt * 32 + 8 * g4) =
                make_uint2(pack2(acc[mt][nt][4 * g4], acc[mt][nt][4 * g4 + 1]), pack2(acc[mt][nt][4 * g4 + 2], acc[mt][nt][4 * g4 + 3]));
    } else {
      u16* pbase = PROJ + (size_t)(m0 + wm * 128 + 4 * hh) * NC + n0 + wn * 64 + r;
#pragma unroll
      for (int mt = 0; mt < 4; ++mt)
#pragma unroll
        for (int nt = 0; nt < 2; ++nt)
#pragma unroll
          for (int i = 0; i < 16; ++i)
            pbase[(size_t)(mt * 32 + 8 * (i >> 2) + (i & 3)) * NC + nt * 32] = f2bf(acc[mt][nt][i]);
    }
  });
}

DI void prep_phase_tiles(const P& p, int l, unsigned char* lds, int job, int) {
  const int tid = otid();
  const u16* PROJ = (const u16*)(p.ws + O_PROJ);
  float2* rt = (float2*)lds;
  u16* vs = (u16*)(lds + 128 * 16 * 8);
  __syncthreads();
  for (int i = tid; i < 128 * 16; i += NT) {
    int pos = i >> 4, f = i & 15;
    float inv = exp2f(-(float)f * (13.287712379549449f / 16.f));
    float turns = (float)pos * inv * 0.15915494309189535f;
    rt[i] = make_float2(cos_t(turns), sin_t(turns));
  }
  const bool lat = job < 512;
  const int b = lat ? (job >> 7) : (job - 512) >> 2;
  const int n0 = lat ? (job & 127) * 64 : ((job - 512) & 3) * 64;
  const int row0 = lat ? b * L + n0 : T + b * LC + n0;
  const int kpos0 = lat ? n0 : L + n0;
#pragma unroll 8
  for (int i = tid; i < 64 * 64; i += NT) {
    int tk = i >> 6, ch = i & 63;
    uint4 v = *(const uint4*)(PROJ + (size_t)(row0 + tk) * NC + OFF_V + ch * 8);
    unsigned* d = (unsigned*)(vs + tk * 514 + ch * 8);
    d[0] = v.x; d[1] = v.y; d[2] = v.z; d[3] = v.w;
  }
  __syncthreads();
  const float* gq = p.in[I_QNG] + l * 64; const float* gk = p.in[I_KNG] + l * 64;
  for (int u = tid; u < 1024; u += NT) {
    int tk = u & 63, grp = u >> 6;
    const uint4* src = (const uint4*)(PROJ + (size_t)(row0 + tk) * NC + OFF_Q + grp * 64);
    float x[64];
#pragma unroll
    for (int i = 0; i < 8; ++i) {
      uint4 v = src[i];
      x[8 * i] = lo16(v.x); x[8 * i + 1] = hi16(v.x); x[8 * i + 2] = lo16(v.y); x[8 * i + 3] = hi16(v.y);
      x[8 * i + 4] = lo16(v.z); x[8 * i + 5] = hi16(v.z); x[8 * i + 6] = lo16(v.w); x[8 * i + 7] = hi16(v.w);
    }
    float ss = 0.f;
#pragma unroll
    for (int i = 0; i < 64; ++i) ss += x[i] * x[i];
    float rinv = rsqrtf(ss * (1.f / 64.f) + 1e-6f);
    const float* g = grp < 8 ? gq : gk;
    const float post = grp < 8 ? (LOG2E * 0.125f) : 1.f;
#pragma unroll
    for (int i = 0; i < 64; ++i) x[i] = x[i] * rinv * g[i];
    if (lat) {
      int n = n0 + tk;
      int prow = n >> 6, pcol = n & 63;
#pragma unroll
      for (int ax = 0; ax < 2; ++ax) {
        int pp = ax == 0 ? prow : pcol;
#pragma unroll
        for (int f = 0; f < 16; ++f) {
          float2 cs = rt[pp * 16 + f];
          float a = x[ax * 32 + f], bq = x[ax * 32 + 16 + f];
          x[ax * 32 + f] = a * cs.x - bq * cs.y;
          x[ax * 32 + 16 + f] = bq * cs.x + a * cs.y;
        }
      }
    }
    int g8 = grp & 7;
    u16* dst = (u16*)(p.ws + (grp < 8 ? O_QN : O_KN)) + ((size_t)(b * 8 + g8) * LK + kpos0 + tk) * 64;
#pragma unroll
    for (int i = 0; i < 8; ++i)
      ((uint4*)dst)[i] = make_uint4(pack2(x[8 * i] * post, x[8 * i + 1] * post), pack2(x[8 * i + 2] * post, x[8 * i + 3] * post),
                                    pack2(x[8 * i + 4] * post, x[8 * i + 5] * post), pack2(x[8 * i + 6] * post, x[8 * i + 7] * post));
  }
  u16* VT = (u16*)(p.ws + O_VT);
  for (int i = tid; i < 512 * 8; i += NT) {
    int he = i >> 3, tc = i & 7;
    u16 v[8];
#pragma unroll
    for (int j = 0; j < 8; ++j) v[j] = vs[(tc * 8 + j) * 514 + he];
    uint4 o = make_uint4(v[0] | ((unsigned)v[1] << 16), v[2] | ((unsigned)v[3] << 16), v[4] | ((unsigned)v[5] << 16), v[6] | ((unsigned)v[7] << 16));
    *(uint4*)(VT + ((size_t)(b * 512 + he)) * LK + kpos0 + tc * 8) = o;
  }
  __syncthreads();
}

DI float zval(const u16* PROJ, size_t rowbase, int n, int col) { return bf2f(PROJ[(rowbase + n) * NC + OFF_HY + col]); }
DI float ztval(const u16* ZT, int b, int n, int col) { return bf2f(ZT[((size_t)b * 1024 + OFF_HY + col) * L + n]); }

DI void hyena_lat_item(const P& p, int l, int c, int bp, unsigned char* lds) {
  const int tid = otid();
  const u16* PROJ = (const u16*)(p.ws + O_PROJ);
  float2* s = (float2*)lds;
  float2* scr = (float2*)(p.ws + O_HYSCR) + (size_t)blockIdx.x * 4 * 8192;
  const u16* ZT = (const u16*)(p.ws + O_ZT);
  const float* cw = p.in[I_HCW] + l * 3 * 768; const float* cb = p.in[I_HCB] + l * 768;
  float w[3][3], bs[3];
#pragma unroll
  for (int k = 0; k < 3; ++k) { bs[k] = cb[k * 256 + c];
#pragma unroll
    for (int j = 0; j < 3; ++j) w[k][j] = cw[j * 768 + k * 256 + c]; }
  const size_t rb0 = (size_t)(2 * bp) * L, rb1 = rb0 + L;
  __syncthreads();
#pragma unroll 1
  for (int ch = 0; ch < 2; ++ch) {
    const int n0 = ch * 4096 + tid * 8;
    float o[3][2][8];
#pragma unroll
    for (int k = 0; k < 3; ++k)
#pragma unroll
      for (int bq = 0; bq < 2; ++bq) {
        const u16* zr = ZT + ((size_t)(2 * bp + bq) * 1024 + OFF_HY + k * 256 + c) * L;
        uint4 v = *(const uint4*)(zr + n0);
        float x[10];
        x[0] = n0 > 0 ? bf2f(zr[n0 - 1]) : 0.f;
        x[9] = n0 + 8 < L ? bf2f(zr[n0 + 8]) : 0.f;
        x[1] = lo16(v.x); x[2] = hi16(v.x); x[3] = lo16(v.y); x[4] = hi16(v.y); x[5] = lo16(v.z); x[6] = hi16(v.z); x[7] = lo16(v.w); x[8] = hi16(v.w);
#pragma unroll
        for (int e = 0; e < 8; ++e) o[k][bq][e] = bs[k] + w[k][0] * x[e] + w[k][1] * x[e + 1] + w[k][2] * x[e + 2];
      }
#pragma unroll
    for (int e = 0; e < 8; ++e) {
      int n = n0 + e;
      s[phys(n)] = make_float2(o[0][0][e], o[0][1][e]);
      s[phys(n + L)] = make_float2(0.f, 0.f);
      scr[n] = make_float2(o[0][0][e], o[0][1][e]);
      scr[8192 + n] = make_float2(o[1][0][e], o[1][1][e]);
      scr[16384 + n] = make_float2(o[2][0][e], o[2][1][e]);
    }
  }
  const float invN = 1.f / 16384.f;
  for (int ord = 0; ord < 2; ++ord) {
    fft_lds<16384, false>(s);
    const float2* H = (const float2*)(p.ws + O_SPEC) + ((size_t)(l * 2 + ord) * 256 + c) * 16384;
#pragma unroll 8
    for (int i = tid; i < 16384; i += NT) { s[phys(i)] = cmul(s[phys(i)], H[i]); }
    fft_lds<16384, true>(s);
    const float bias = p.in[I_HBIAS][l * 512 + ord * 256 + c];
    if (ord == 0) {
      float2 y1v[16];
#pragma unroll
      for (int i = 0; i < 16; ++i) {
        int n = (i >> 3) * 4096 + tid * 8 + (i & 7);
        float2 cv = s[phys(n)], v = scr[n], x1 = scr[8192 + n];
        y1v[i] = make_float2(x1.x * (cv.x * invN + v.x * bias), x1.y * (cv.y * invN + v.y * bias));
        scr[24576 + n] = y1v[i];
      }
      __syncthreads();
#pragma unroll
      for (int i = 0; i < 16; ++i) { int n = (i >> 3) * 4096 + tid * 8 + (i & 7); s[phys(n)] = y1v[i]; s[phys(n + L)] = make_float2(0.f, 0.f); }
    } else {
      u16* HYT = (u16*)(p.ws + O_HYT);
#pragma unroll
      for (int ch = 0; ch < 2; ++ch) {
        float r0[8], r1[8];
#pragma unroll
        for (int e = 0; e < 8; ++e) {
          int n = ch * 4096 + tid * 8 + e;
          float2 cv = s[phys(n)], y1 = scr[24576 + n], x2 = scr[16384 + n];
          r0[e] = x2.x * (cv.x * invN + y1.x * bias);
          r1[e] = x2.y * (cv.y * invN + y1.y * bias);
        }
        *(uint4*)(HYT + ((size_t)(2 * bp) * 256 + c) * L + ch * 4096 + tid * 8) = make_uint4(pack2(r0[0], r0[1]), pack2(r0[2], r0[3]), pack2(r0[4], r0[5]), pack2(r0[6], r0[7]));
        *(uint4*)(HYT + ((size_t)(2 * bp + 1) * 256 + c) * L + ch * 4096 + tid * 8) = make_uint4(pack2(r1[0], r1[1]), pack2(r1[2], r1[3]), pack2(r1[4], r1[5]), pack2(r1[6], r1[7]));
      }
    }
  }
  __syncthreads();
}

DI void fourier_out(const float2* s, u16* FMT, int m, int tid) {
  const float sc = 0.0013810679320049757f;
  const int col2 = (m == 0) ? 32 : 64 - m;
#pragma unroll
  for (int ch = 0; ch < 2; ++ch) {
    const int k0 = ch * 4096 + tid * 8;
    float v[8], vm[8];
#pragma unroll
    for (int e = 0; e < 8; ++e) {
      int k = k0 + e;
      float2 zp = s[phys((int)(__brev((unsigned)k) >> 19))];
      float2 zn = s[phys((int)(__brev((unsigned)((L - k) & (L - 1))) >> 19))];
      if (m == 0) { v[e] = 0.5f * (zp.x + zn.x) * sc; vm[e] = 0.5f * (zp.y + zn.y) * sc; }
      else { v[e] = zp.x * sc; vm[e] = zn.x * sc; }
    }
    *(uint4*)(FMT + (size_t)m * L + k0) = make_uint4(pack2(v[0], v[1]), pack2(v[2], v[3]), pack2(v[4], v[5]), pack2(v[6], v[7]));
    *(uint4*)(FMT + (size_t)col2 * L + k0) = make_uint4(pack2(vm[0], vm[1]), pack2(vm[2], vm[3]), pack2(vm[4], vm[5]), pack2(vm[6], vm[7]));
  }
}

DI void fourier_lat_item(const P& p, int b, int g, int mp, unsigned char* lds) {
  const int tid = otid();
  const int m0 = 2 * mp, m1 = m0 + 1;
  float2* s0 = (float2*)lds;
  float2* s1 = s0 + 8704;
  float2* tw = (float2*)(lds + 2 * 8704 * 8);
  __syncthreads();
  if (tid < 64) { float f = (float)tid * (1.f / 64.f); tw[tid] = make_float2(cos_t(f), -sin_t(f)); }
  __syncthreads();
  {
    const u16* ZT = (const u16*)(p.ws + O_ZT) + ((size_t)b * 1024 + g * 64) * L + tid * 8;
    float re0[16], im0[16], re1[16], im1[16];
#pragma unroll
    for (int i = 0; i < 16; ++i) { re0[i] = 0.f; im0[i] = 0.f; re1[i] = 0.f; im1[i] = 0.f; }
#pragma unroll 4
    for (int j = 0; j < 64; ++j) {
      float2 t0 = tw[(m0 * j) & 63];
      if (m0 == 0) t0 = make_float2(1.f, (j & 1) ? -1.f : 1.f);
      const float2 t1 = tw[(m1 * j) & 63];
#pragma unroll
      for (int c = 0; c < 2; ++c) {
        uint4 v = *(const uint4*)(ZT + (size_t)j * L + c * 4096);
        float x[8] = {lo16(v.x), hi16(v.x), lo16(v.y), hi16(v.y), lo16(v.z), hi16(v.z), lo16(v.w), hi16(v.w)};
#pragma unroll
        for (int e = 0; e < 8; ++e) {
          re0[c * 8 + e] += x[e] * t0.x; im0[c * 8 + e] += x[e] * t0.y;
          re1[c * 8 + e] += x[e] * t1.x; im1[c * 8 + e] += x[e] * t1.y;
        }
      }
    }
#pragma unroll
    for (int i = 0; i < 16; ++i) {
      const int n = (i >> 3) * 4096 + tid * 8 + (i & 7);
      s0[phys(n)] = make_float2(re0[i], im0[i]);
      s1[phys(n)] = make_float2(re1[i], im1[i]);
    }
  }
  fft_lds<8192, false>(s0);
  fft_lds<8192, false>(s1);
  u16* FMT = (u16*)(p.ws + O_FMT) + ((size_t)b * 256 + g * 64) * L;
  fourier_out(s0, FMT, m0, tid);
  fourier_out(s1, FMT, m1, tid);
  __syncthreads();
}

DI void transpose_job(const P& p, int job, unsigned char* lds) {
  const int tid = otid();
  const int which = job >> 9, b = (job >> 7) & 3, nt = job & 127;
  const u16* src = (const u16*)(p.ws + (which ? O_HYT : O_FMT)) + (size_t)b * 256 * L + nt * 64;
  u16* dst = (u16*)(p.ws + (which ? O_HY : O_FM)) + ((size_t)b * L + nt * 64) * 256;
  u16* sm = (u16*)lds;
  __syncthreads();
  {
    const int c = tid >> 1, half = tid & 1;
    const uint4* sp = (const uint4*)(src + (size_t)c * L + half * 32);
#pragma unroll
    for (int q = 0; q < 4; ++q) {
      uint4 v = sp[q];
      unsigned wds[4] = {v.x, v.y, v.z, v.w};
#pragma unroll
      for (int e = 0; e < 4; ++e) {
        int n = half * 32 + q * 8 + 2 * e;
        sm[n * 264 + c] = (u16)(wds[e] & 0xffffu);
        sm[(n + 1) * 264 + c] = (u16)(wds[e] >> 16);
      }
    }
  }
  __syncthreads();
#pragma unroll
  for (int i = 0; i < 4; ++i) {
    int id = tid + NT * i, n = id >> 5, cc = id & 31;
    uint4 v = *(const uint4*)(sm + n * 264 + cc * 8);
    *(uint4*)(dst + (size_t)n * 256 + cc * 8) = v;
  }
}

DI void fourier_ctx_item(const P& p, int b, int g, int mc, unsigned char* lds) {
  const int tid = otid();
  const u16* PROJ = (const u16*)(p.ws + O_PROJ);
  float* u = (float*)lds;
  float2* ab = (float2*)(lds + 256 * 65 * 4);
  float2* tw64 = ab + 256 * 16;
  float2* tw256 = tw64 + 64;
  __syncthreads();
  if (tid < 64) { float f = (float)tid * (1.f / 64.f); tw64[tid] = make_float2(cos_t(f), -sin_t(f)); }
  if (tid < 256) { float f = (float)tid * (1.f / 256.f); tw256[tid] = make_float2(cos_t(f), -sin_t(f)); }
  for (int i = tid; i < 256 * 64; i += NT) { int n = i >> 6, j = i & 63; u[n * 65 + j] = bf2f(PROJ[(size_t)(T + b * LC + n) * NC + g * 64 + j]); }
  __syncthreads();
  for (int i = tid; i < 256 * 4; i += NT) {
    int n = i >> 2, mm = i & 3, m = mc * 4 + mm;
    float re = 0.f, im = 0.f;
    for (int j = 0; j < 64; ++j) { float2 t = tw64[(m * j) & 63]; float x = u[n * 65 + j]; re += x * t.x; im += x * t.y; }
    ab[n * 4 + mm] = make_float2(re, im);
  }
  __syncthreads();
  u16* FM = (u16*)(p.ws + O_FM);
  for (int i = tid; i < 256 * 4; i += NT) {
    int k = i >> 2, mm = i & 3;
    float y = 0.f;
    for (int n = 0; n < 256; ++n) { float2 t = tw256[(k * n) & 255]; float2 z = ab[n * 4 + mm]; y += z.x * t.x - z.y * t.y; }
    FM[(size_t)(T + b * LC + k) * 256 + g * 64 + mc * 4 + mm] = f2bf(y * (1.f / 128.f));
  }
  __syncthreads();
}

DI void hyena_ctx_item(const P& p, int l, int c, unsigned char* lds) {
  const int tid = otid();
  const u16* PROJ = (const u16*)(p.ws + O_PROJ);
  float* f0 = (float*)lds; float* f1 = f0 + 512; float* sv = f1 + 512;
  const float* FC = (const float*)(p.ws + O_FILTC);
  __syncthreads();
  f0[tid] = FC[(size_t)(0 * 256 + c) * 512 + tid];
  f1[tid] = FC[(size_t)(1 * 256 + c) * 512 + tid];
  const float* cw = p.in[I_HCW] + l * 3 * 768; const float* cb = p.in[I_HCB] + l * 768;
  const float bias0 = p.in[I_HBIAS][l * 512 + c], bias1 = p.in[I_HBIAS][l * 512 + 256 + c];
  const int bb = tid >> 8, t = tid & 255;
  u16* HY = (u16*)(p.ws + O_HY);
  for (int pass = 0; pass < 2; ++pass) {
    int b = pass * 2 + bb;
    size_t rb = (size_t)T + b * LC;
    float o[3];
#pragma unroll
    for (int k = 0; k < 3; ++k) {
      int col = k * 256 + c; float a = cb[col];
#pragma unroll
      for (int j = 0; j < 3; ++j) { int nn = t + j - 1; if (nn >= 0 && nn < LC) a += cw[j * 768 + col] * zval(PROJ, rb, nn, col); }
      o[k] = a;
    }
    __syncthreads();
    sv[bb * 256 + t] = o[0];
    __syncthreads();
    float a = 0.f;
    for (int s2 = 0; s2 < 256; ++s2) a += f0[(t - s2) & 511] * sv[bb * 256 + s2];
    float y1 = o[1] * (a + o[0] * bias0);
    __syncthreads();
    sv[bb * 256 + t] = y1;
    __syncthreads();
    float a2 = 0.f;
    for (int s2 = 0; s2 < 256; ++s2) a2 += f1[(t - s2) & 511] * sv[bb * 256 + s2];
    HY[(rb + t) * 256 + c] = f2bf(o[2] * (a2 + y1 * bias1));
  }
  __syncthreads();
}

#ifndef ATT_KT_PRAGMA
#define ATT_KT_PRAGMA _Pragma("unroll 1")
#endif
#ifndef ATT_SB
#define ATT_SB __builtin_amdgcn_sched_barrier(0)
#endif
constexpr int AT_KB = 64 * G_AST, AT_VB = 128 * G_AST, AT_STAGE = 2 * AT_KB + AT_VB;

DI void attn_item(const P& p, int l, int b, int h, int qpos0, int key0, int nkeys, int out_row0, unsigned char* lds,
                  float lam, float lam_init) {
  const int tid = otid(), lane = tid & 63, w = tid >> 6, r = lane & 31, hh = lane >> 5;
  const u16* QN = (const u16*)(p.ws + O_QN) + (size_t)(b * 8 + h * 2) * LK * 64;
  const u16* KN = (const u16*)(p.ws + O_KN) + (size_t)(b * 8 + h * 2) * LK * 64;
  const u16* VT = (const u16*)(p.ws + O_VT) + (size_t)(b * 512 + h * 128) * LK;
  unsigned char* qs = lds + 2 * AT_STAGE + w * (64 * G_AST);
  __syncthreads();
#pragma unroll
  for (int i = 0; i < 8; ++i) {
    int id = lane + 64 * i, m = id >> 8, row = (id >> 3) & 31, ch = id & 7;
    uint4 v = *(const uint4*)(QN + (size_t)m * LK * 64 + (size_t)(qpos0 + w * 32 + row) * 64 + ch * 8);
    *(uint4*)(qs + (m * 32 + row) * G_AST + ch * 16) = v;
  }
  const unsigned char* qrd = qs + r * G_AST + hh * 16;
  f32x16 O[2][4];
#pragma unroll
  for (int m = 0; m < 2; ++m)
#pragma unroll
    for (int vt = 0; vt < 4; ++vt)
#pragma unroll
      for (int i = 0; i < 16; ++i) O[m][vt][i] = 0.f;
  float lsum[2] = {0.f, 0.f};
  const int ntiles = nkeys >> 6;
  const u16* kbase0 = KN + (size_t)key0 * 64;
  const u16* vbase0 = VT + key0;
  {
    const unsigned koff = tid * 8;
    const unsigned voff = (tid >> 3) * LK + (tid & 7) * 8;
    const int kw = (tid >> 3) * G_AST + (tid & 7) * 16;
    uint4 rk0 = *(const uint4*)(kbase0 + koff), rk1 = *(const uint4*)(kbase0 + (size_t)LK * 64 + koff);
    uint4 rv0 = *(const uint4*)(vbase0 + voff), rv1 = *(const uint4*)(vbase0 + (size_t)64 * LK + voff);
    __syncthreads();
    *(uint4*)(lds + kw) = rk0; *(uint4*)(lds + AT_KB + kw) = rk1;
    *(uint4*)(lds + 2 * AT_KB + kw) = rv0; *(uint4*)(lds + 2 * AT_KB + 64 * G_AST + kw) = rv1;
  }
  __syncthreads();
  for (int t = 0; t < ntiles; ++t) {
    const bool more = t + 1 < ntiles;
    const unsigned char* st = lds + (t & 1) * AT_STAGE;
    uint4 rk0, rk1, rv0, rv1;
    if (more) {
      const int tid2 = otid();
      const unsigned koff = tid2 * 8, voff = (tid2 >> 3) * LK + (tid2 & 7) * 8;
      const u16* kb_ = kbase0 + (size_t)(t + 1) * 4096;
      const u16* vb_ = vbase0 + (t + 1) * 64;
      rk0 = *(const uint4*)(kb_ + koff); rk1 = *(const uint4*)(kb_ + (size_t)LK * 64 + koff);
      rv0 = *(const uint4*)(vb_ + voff); rv1 = *(const uint4*)(vb_ + (size_t)64 * LK + voff);
    }
    __builtin_amdgcn_sched_barrier(0);
ATT_KT_PRAGMA
    for (int kt = 0; kt < 2; ++kt) {
      {
        const unsigned char* kb = st + (kt * 32 + r) * G_AST + hh * 16;
        const unsigned char* vb = st + 2 * AT_KB + r * G_AST + (kt * 32 + 8 * hh) * 2;
        f32x16 S0, S1;
#pragma unroll
        for (int i = 0; i < 16; ++i) { S0[i] = 0.f; S1[i] = 0.f; }
        bf16x8 k0 = *(const bf16x8*)(kb), k1 = *(const bf16x8*)(kb + 32), k2 = *(const bf16x8*)(kb + 64), k3 = *(const bf16x8*)(kb + 96);
        bf16x8 q0 = *(const bf16x8*)(qrd), q1 = *(const bf16x8*)(qrd + 32), q2 = *(const bf16x8*)(qrd + 64), q3 = *(const bf16x8*)(qrd + 96);
        __builtin_amdgcn_sched_barrier(0);
        S0 = MFMA16(k0, q0, S0); S0 = MFMA16(k1, q1, S0); S0 = MFMA16(k2, q2, S0); S0 = MFMA16(k3, q3, S0);
        __builtin_amdgcn_sched_barrier(0);
        k0 = *(const bf16x8*)(kb + AT_KB); k1 = *(const bf16x8*)(kb + AT_KB + 32);
        q0 = *(const bf16x8*)(qrd + 32 * G_AST); q1 = *(const bf16x8*)(qrd + 32 * G_AST + 32);
        S1 = MFMA16(k0, q0, S1); S1 = MFMA16(k1, q1, S1);
        k0 = *(const bf16x8*)(kb + AT_KB + 64); k1 = *(const bf16x8*)(kb + AT_KB + 96);
        q0 = *(const bf16x8*)(qrd + 32 * G_AST + 64); q1 = *(const bf16x8*)(qrd + 32 * G_AST + 96);
        S1 = MFMA16(k0, q0, S1); S1 = MFMA16(k1, q1, S1);
        float ls0 = 0.f;
#pragma unroll
        for (int i = 0; i < 16; ++i) { S0[i] = __builtin_amdgcn_exp2f(S0[i]); ls0 += S0[i]; }
        lsum[0] += ls0;
        bf16x8 pa0 = __builtin_bit_cast(bf16x8, make_uint4(pack2(S0[0], S0[1]), pack2(S0[2], S0[3]), pack2(S0[4], S0[5]), pack2(S0[6], S0[7])));
        bf16x8 pb0 = __builtin_bit_cast(bf16x8, make_uint4(pack2(S0[8], S0[9]), pack2(S0[10], S0[11]), pack2(S0[12], S0[13]), pack2(S0[14], S0[15])));
        __builtin_amdgcn_sched_barrier(0);
        bf16x8 v0 = *(const bf16x8*)(vb), v1 = *(const bf16x8*)(vb + 32 * G_AST), v2 = *(const bf16x8*)(vb + 64 * G_AST), v3 = *(const bf16x8*)(vb + 96 * G_AST);
        O[0][0] = MFMA16(v0, pa0, O[0][0]); O[0][1] = MFMA16(v1, pa0, O[0][1]); O[0][2] = MFMA16(v2, pa0, O[0][2]); O[0][3] = MFMA16(v3, pa0, O[0][3]);
        float ls1 = 0.f;
#pragma unroll
        for (int i = 0; i < 16; ++i) { S1[i] = __builtin_amdgcn_exp2f(S1[i]); ls1 += S1[i]; }
        lsum[1] += ls1;
        bf16x8 pa1 = __builtin_bit_cast(bf16x8, make_uint4(pack2(S1[0], S1[1]), pack2(S1[2], S1[3]), pack2(S1[4], S1[5]), pack2(S1[6], S1[7])));
        bf16x8 pb1 = __builtin_bit_cast(bf16x8, make_uint4(pack2(S1[8], S1[9]), pack2(S1[10], S1[11]), pack2(S1[12], S1[13]), pack2(S1[14], S1[15])));
        __builtin_amdgcn_sched_barrier(0);
        bf16x8 w0 = *(const bf16x8*)(vb + 32), w1 = *(const bf16x8*)(vb + 32 * G_AST + 32), w2 = *(const bf16x8*)(vb + 64 * G_AST + 32), w3 = *(const bf16x8*)(vb + 96 * G_AST + 32);
        O[0][0] = MFMA16(w0, pb0, O[0][0]); O[0][1] = MFMA16(w1, pb0, O[0][1]); O[0][2] = MFMA16(w2, pb0, O[0][2]); O[0][3] = MFMA16(w3, pb0, O[0][3]);
        O[1][0] = MFMA16(v0, pa1, O[1][0]); O[1][1] = MFMA16(v1, pa1, O[1][1]); O[1][2] = MFMA16(v2, pa1, O[1][2]); O[1][3] = MFMA16(v3, pa1, O[1][3]);
        O[1][0] = MFMA16(w0, pb1, O[1][0]); O[1][1] = MFMA16(w1, pb1, O[1][1]); O[1][2] = MFMA16(w2, pb1, O[1][2]); O[1][3] = MFMA16(w3, pb1, O[1][3]);
        ATT_SB;
      }
    }
    if (more) {
      const int tid3 = otid();
      const int kw = (tid3 >> 3) * G_AST + (tid3 & 7) * 16;
      unsigned char* nb = lds + ((t + 1) & 1) * AT_STAGE;
      *(uint4*)(nb + kw) = rk0; *(uint4*)(nb + AT_KB + kw) = rk1;
      *(uint4*)(nb + 2 * AT_KB + kw) = rv0; *(uint4*)(nb + 2 * AT_KB + 64 * G_AST + kw) = rv1;
    }
    __syncthreads();
  }
  float l0 = lsum[0] + shx(lsum[0], 32), l1 = lsum[1] + shx(lsum[1], 32);
  float i0 = 1.f / l0, i1 = lam / l1;
  float ssq = 0.f;
#pragma unroll
  for (int vt = 0; vt < 4; ++vt)
#pragma unroll
    for (int i = 0; i < 16; ++i) { float o = O[0][vt][i] * i0 - O[1][vt][i] * i1; O[0][vt][i] = o; ssq += o * o; }
  ssq += shx(ssq, 32);
  float rn = rsqrtf(ssq * (1.f / 128.f) + 1e-5f) * (1.f - lam_init);
  const float* sg = p.in[I_SUBG] + l * 128;
  u16* OO = (u16*)(p.ws + O_O) + (size_t)(out_row0 + w * 32 + r) * 512 + h * 128;
#pragma unroll
  for (int vt = 0; vt < 4; ++vt)
#pragma unroll
    for (int g4 = 0; g4 < 4; ++g4) {
      int e0 = 32 * vt + 8 * g4 + 4 * hh;
      float4 gv = *(const float4*)(sg + e0);
      *(uint2*)(OO + e0) = make_uint2(pack2(O[0][vt][4 * g4] * rn * gv.x, O[0][vt][4 * g4 + 1] * rn * gv.y),
                                      pack2(O[0][vt][4 * g4 + 2] * rn * gv.z, O[0][vt][4 * g4 + 3] * rn * gv.w));
    }
}

DI void attn_phase(const P& p, int l, unsigned char* lds) {
  const int lane = otid() & 63;
  float s0 = p.in[I_LAMQ][l * 128 + lane] * p.in[I_LAMK][l * 128 + lane];
  float s1 = p.in[I_LAMQ][l * 128 + 64 + lane] * p.in[I_LAMK][l * 128 + 64 + lane];
  s0 = wave_sum(s0); s1 = wave_sum(s1);
  const float lam_init = lam_init_of(l);
  const float lam = __expf(s0) - __expf(s1) + lam_init;
  const int n_lat = NB * 4 * (L / 256), n_ctx = (l == 0) ? NB * 4 : 0, n_att = n_lat + n_ctx;
  const int n_hy = 512, n_fm = 16 * 16, n_fc = (l == 0) ? 256 : 0, n_hc = (l == 0) ? 256 : 0;
  const int total = n_att + n_hy + n_fm + n_fc + n_hc;
  for (int it = blockIdx.x; it < total; it += gridDim.x) {
    int k = it;
    if (k < n_att) {
      int b, h, qpos0, key0, nkeys, orow;
      if (k < n_lat) { int qb = k & 31, bh = k >> 5; b = bh >> 2; h = bh & 3; qpos0 = qb * 256; key0 = 0; nkeys = LK; orow = b * L + qb * 256; }
      else { int bh = k - n_lat; b = bh >> 2; h = bh & 3; qpos0 = L; key0 = L; nkeys = LC; orow = T + b * LC; }
      attn_item(p, l, b, h, qpos0, key0, nkeys, orow, lds, lam, lam_init);
      continue;
    }
    k -= n_att;
    if (k < n_hy) { hyena_lat_item(p, l, k >> 1, k & 1, lds); continue; }
    k -= n_hy;
    if (k < n_fm) { fourier_lat_item(p, k >> 6, (k >> 4) & 3, k & 15, lds); continue; }
    k -= n_fm;
    if (k < n_fc) { fourier_ctx_item(p, k >> 6, (k >> 4) & 3, k & 15, lds); continue; }
    k -= n_fc;
    hyena_ctx_item(p, l, k, lds);
  }
}

DI void transpose_phase(const P& p, unsigned char* lds) {
  for (int it = blockIdx.x; it < 1024; it += gridDim.x) transpose_job(p, it, lds);
}

DI void merge_phase(const P& p, int l, int rows, unsigned char* lds) {
  u16* MG = (u16*)(p.ws + O_MERGED);
  const unsigned char* WL = p.ws + O_WT + l * WL_SIZE;
  const int tid = otid(), lane = tid & 63, w = tid >> 6, r = lane & 31, hh = lane >> 5, wm = w >> 1, wn = w & 1;
  for_tiles(rows / 256, D / 128, [&](int tm_, int tn_) {
    int m0 = tm_ * 256, n0 = tn_ * 128;
    f32x16 tot[2][2]; acc_zero(tot);
#pragma unroll 1
    for (int br = 0; br < 3; ++br) {
      const u16* A = (const u16*)(p.ws + (br == 0 ? O_FM : br == 1 ? O_HY : O_O));
      const int K = br == 2 ? 512 : 256;
      const u16* Wt = (const u16*)(WL + (br == 0 ? WL_WF : br == 1 ? WL_WH : WL_WA));
      const u16* ap[4]; const u16* bp[2];
      set_ap(ap, A, K, m0); set_bp(bp, Wt, K, n0);
      f32x16 acc[2][2]; acc_zero(acc);
      gemm_main(acc, ap, bp, K, lds);
      size_t fb = ((((size_t)tm_ * 8 + tn_) * 8 + w) * 16) * 64 + lane;
      asm volatile("" : "+v"(fb));
      const u16* gf = (const u16*)(p.ws + O_GF) + (size_t)br * TA * 1024;
#pragma unroll
      for (int mt = 0; mt < 2; ++mt)
#pragma unroll
        for (int nt = 0; nt < 2; ++nt)
#pragma unroll
          for (int g4 = 0; g4 < 4; ++g4) {
            uint2 gv = *(const uint2*)(gf + (fb + (size_t)(((mt * 2 + nt) * 4 + g4) * 64)) * 4);
            tot[mt][nt][4 * g4] += lo16(gv.x) * acc[mt][nt][4 * g4];
            tot[mt][nt][4 * g4 + 1] += hi16(gv.x) * acc[mt][nt][4 * g4 + 1];
            tot[mt][nt][4 * g4 + 2] += lo16(gv.y) * acc[mt][nt][4 * g4 + 2];
            tot[mt][nt][4 * g4 + 3] += hi16(gv.y) * acc[mt][nt][4 * g4 + 3];
          }
    }
    u16* pm = MG + (size_t)(m0 + wm * 64 + 4 * hh) * D + n0 + wn * 64 + r;
#pragma unroll
    for (int mt = 0; mt < 2; ++mt)
#pragma unroll
      for (int nt = 0; nt < 2; ++nt)
#pragma unroll
        for (int i = 0; i < 16; ++i)
          pm[(size_t)(mt * 32 + 8 * (i >> 2) + (i & 3)) * D + nt * 32] = f2bf(tot[mt][nt][i]);
  });
}

DI void wo_phase(const P& p, int l, int rows, unsigned char* lds) {
  const u16* MG = (const u16*)(p.ws + O_MERGED);
  const u16* Wt = (const u16*)(p.ws + O_WT + l * WL_SIZE + WL_WO);
  float* XA = (float*)(p.ws + O_XA);
  const float* MOD = (const float*)(p.ws + O_MOD) + l * 5 * 6144;
  const int lane = otid() & 63, w = otid() >> 6, r = lane & 31, hh = lane >> 5, wm = w >> 1, wn = w & 1;
  for_tiles(rows / 256, D / 128, [&](int tm_, int tn_) {
    int m0 = tm_ * 256, n0 = tn_ * 128;
    const u16* ap[4]; const u16* bp[2];
    set_ap(ap, MG, D, m0); set_bp(bp, Wt, D, n0);
    f32x16 acc[2][2]; acc_zero(acc);
    gemm_main(acc, ap, bp, D, lds);
#pragma unroll
    for (int mt = 0; mt < 2; ++mt)
#pragma unroll
      for (int nt = 0; nt < 2; ++nt)
#pragma unroll
        for (int i = 0; i < 16; ++i) {
          int row = m0 + wm * 64 + mt * 32 + crow(i, hh), col = n0 + wn * 64 + nt * 32 + r;
          float xin;
          if (l == 0) xin = row < T ? p.in[I_X][(size_t)row * D + col] : p.in[I_CTX][(size_t)(row - T) * D + col];
          else xin = XA[(size_t)row * D + col];
          int mr = row < T ? (row >> 13) : 4;
          XA[(size_t)row * D + col] = xin + MOD[mr * 6144 + 2 * 1024 + col] * acc[mt][nt][i];
        }
  });
}

DI void router_phase(const P& p, int l, int ntok, unsigned char* lds) {
  const int tid = otid(), lane = tid & 63, w = tid >> 6, r = lane & 31, hh = lane >> 5;
  float* tile = (float*)lds;
  int* lcnt = (int*)(lds + 32 * 1025 * 4);
  const float* XA = (const float*)(p.ws + O_XA);
  const float* MOD = (const float*)(p.ws + O_MOD) + l * 5 * 6144;
  u16* H = (u16*)(p.ws + O_H);
  const float* wr = p.in[I_WR] + (size_t)l * 1024 * 32;
  const float* br = p.in[I_BR] + l * 32;
  int* TOKE = (int*)(p.ws + O_TOKE); float* TOKG = (float*)(p.ws + O_TOKG); int* TOKLP = (int*)(p.ws + O_TOKLP);
  const int per = ntok / gridDim.x;
  const int tbase = blockIdx.x * per;
  __syncthreads();
  if (tid < 32) lcnt[tid] = 0;
  __syncthreads();
  for (int c0 = 0; c0 < per; c0 += 32) {
#pragma unroll 2
    for (int q = 0; q < 4; ++q) {
      int tl = w * 4 + q;
      int tok = tbase + c0 + tl;
      bool valid = (c0 + tl) < per;
      if (!valid) tok = tbase;
      const float* xr = XA + (size_t)tok * D;
      int mr = tok < T ? (tok >> 13) : 4;
      float xv[16];
#pragma unroll
      for (int i = 0; i < 4; ++i) { float4 v = *(const float4*)(xr + (i * 64 + lane) * 4); xv[4 * i] = v.x; xv[4 * i + 1] = v.y; xv[4 * i + 2] = v.z; xv[4 * i + 3] = v.w; }
      float ss = 0.f;
#pragma unroll
      for (int i = 0; i < 16; ++i) ss += xv[i] * xv[i];
      ss = wave_sum(ss);
      float rinv = rsqrtf(ss * (1.f / 1024.f) + 1e-6f);
      const float* g = p.in[I_N2G] + l * 1024; const float* sh = MOD + mr * 6144 + 3 * 1024; const float* sc = MOD + mr * 6144 + 4 * 1024;
#pragma unroll
      for (int i = 0; i < 4; ++i) {
        int c = (i * 64 + lane) * 4;
        float4 gv = *(const float4*)(g + c), shv = *(const float4*)(sh + c), scv = *(const float4*)(sc + c);
        float h0 = xv[4 * i] * rinv * gv.x * (1.f + scv.x) + shv.x;
        float h1 = xv[4 * i + 1] * rinv * gv.y * (1.f + scv.y) + shv.y;
        float h2 = xv[4 * i + 2] * rinv * gv.z * (1.f + scv.z) + shv.z;
        float h3 = xv[4 * i + 3] * rinv * gv.w * (1.f + scv.w) + shv.w;
        float* tr = tile + tl * 1025 + c;
        tr[0] = h0; tr[1] = h1; tr[2] = h2; tr[3] = h3;
        if (valid) *(uint2*)(H + boff(tok, c, 1024)) = make_uint2(pack2(h0, h1), pack2(h2, h3));
      }
    }
    __syncthreads();
    f32x16 acc;
#pragma unroll
    for (int i = 0; i < 16; ++i) acc[i] = 0.f;
    {
      const float* ar = tile + r * 1025 + w * 128 + hh;
      const float* brp = wr + (size_t)(w * 128 + hh) * 32 + r;
#pragma unroll 8
      for (int s2 = 0; s2 < 64; ++s2) acc = __builtin_amdgcn_mfma_f32_32x32x2f32(ar[2 * s2], brp[(size_t)2 * s2 * 32], acc, 0, 0, 0);
    }
    __syncthreads();
    float* part = tile;
#pragma unroll
    for (int i = 0; i < 16; ++i) part[(w * 32 + crow(i, hh)) * 33 + r] = acc[i];
    __syncthreads();
#pragma unroll
    for (int q = 0; q < 4; ++q) {
      int tl = w * 4 + q;
      int tok = tbase + c0 + tl;
      bool valid = (c0 + tl) < per;
      float v = br[r];
#pragma unroll
      for (int k = 0; k < 8; ++k) v += part[(k * 32 + tl) * 33 + r];
      int se[4]; float sv[4];
#pragma unroll
      for (int k = 0; k < 4; ++k) {
        float m = wave_max(v);
        unsigned long long mask = __ballot(v == m);
        int idx = __ffsll((long long)mask) - 1;
        se[k] = idx & 31; sv[k] = m;
        if (r == (idx & 31)) v = -3.0e38f;
      }
      float e1 = __expf(sv[1] - sv[0]), e2 = __expf(sv[2] - sv[0]), e3 = __expf(sv[3] - sv[0]);
      float inv = 1.f / (1.f + e1 + e2 + e3);
      if (valid && lane < 4) {
        int e = lane == 0 ? se[0] : lane == 1 ? se[1] : lane == 2 ? se[2] : se[3];
        float gt = (lane == 0 ? 1.f : lane == 1 ? e1 : lane == 2 ? e2 : e3) * inv;
        int lp = atomicAdd(&lcnt[e], 1);
        TOKE[tok * 4 + lane] = e; TOKG[tok * 4 + lane] = gt; TOKLP[tok * 4 + lane] = lp;
      }
    }
    __syncthreads();
  }
  if (tid < 32) ((int*)(p.ws + O_CNT))[blockIdx.x * 32 + tid] = lcnt[tid];
  __syncthreads();
}

DI void slot_phase(const P& p, int ntok, unsigned char* lds) {
  const int tid = otid();
  int* cnt = (int*)lds;
  const int G = gridDim.x;
  int* total = cnt + G * 32; int* base = total + 32; int* pstart = base + 32; int* padded = pstart + 40;
  const int* CNT = (const int*)(p.ws + O_CNT);
  __syncthreads();
  for (int i = tid; i < G * 32; i += NT) cnt[i] = CNT[i];
  __syncthreads();
  if (tid < 32) {
    int s = 0, bsum = 0;
    for (int b = 0; b < G; ++b) { int v = cnt[b * 32 + tid]; if (b < (int)blockIdx.x) bsum += v; s += v; }
    total[tid] = s; base[tid] = bsum; padded[tid] = (s + 255) & ~255;
  }
  __syncthreads();
  if (tid == 0) { int a = 0; for (int e = 0; e < 32; ++e) { pstart[e] = a; a += padded[e]; } pstart[32] = a; }
  __syncthreads();
  int* TOKE = (int*)(p.ws + O_TOKE); int* TOKLP = (int*)(p.ws + O_TOKLP); int* TOKSLOT = (int*)(p.ws + O_TOKSLOT);
  int* ROWTOK = (int*)(p.ws + O_ROWTOK); int* TILEE = (int*)(p.ws + O_TILEE);
  const int per = ntok / G, tbase = blockIdx.x * per;
  for (int i = tid; i < per * 4; i += NT) {
    int idx = tbase * 4 + i;
    int e = TOKE[idx];
    int slot = pstart[e] + base[e] + TOKLP[idx];
    TOKSLOT[idx] = slot; ROWTOK[slot] = idx >> 2;
  }
  if (blockIdx.x < 32) {
    int e = blockIdx.x;
    for (int s2 = pstart[e] + total[e] + tid; s2 < pstart[e] + padded[e]; s2 += NT) ROWTOK[s2] = 0;
  }
  if (blockIdx.x == 0) {
    int nt = pstart[32] >> 8;
    if (tid == 0) TILEE[1023] = nt;
    for (int i = tid; i < nt; i += NT) {
      int row = i << 8, e = 0;
      for (int k = 1; k < 32; ++k) if (row >= pstart[k]) e = k;
      TILEE[i] = e;
    }
  }
  __syncthreads();
}

DI void moe1_phase(const P& p, int l, unsigned char* lds) {
  const u16* H = (const u16*)(p.ws + O_H);
  u16* ACT = (u16*)(p.ws + O_PROJ);
  const int* ROWTOK = (const int*)(p.ws + O_ROWTOK); const int* TILEE = (const int*)(p.ws + O_TILEE);
  const int ntm = TILEE[1023];
  const int tid = otid(), lane = tid & 63, w = tid >> 6, r = lane & 31, hh = lane >> 5, wm = w >> 2, wn = w & 3;
  for_tiles(ntm, 8, [&](int mt_, int tn_) {
    int n0 = tn_ * 256, m0 = mt_ * 256, e = TILEE[mt_];
    const u16* Wt = (const u16*)(p.ws + O_WT + l * WL_SIZE + WL_WE1) + (size_t)e * 2048 * 1024;
    const u16* ap[4];
#pragma unroll
    for (int i = 0; i < 4; ++i) ap[i] = H + boff(ROWTOK[m0 + (tid >> 3) + 64 * i], (tid & 7) * 8, 1024);
    const u16* b0p = Wt + (size_t)tn_ * 16 * 16384 + tid * 8;
    f32x16 acc[4][2]; acc_zero4(acc);
    gemm256(acc, ap, b0p, D, lds);
    const int j = (n0 >> 1) + wn * 32 + r;
    const float* b1 = p.in[I_BE1] + (size_t)(l * 32 + e) * 2048;
    const float bg = b1[2 * j], bl = b1[2 * j + 1];
    u16* abase = ACT + boff(m0 + wm * 128 + 4 * hh, j, 1024);
#pragma unroll
    for (int mt = 0; mt < 4; ++mt)
#pragma unroll
      for (int i = 0; i < 16; ++i) {
        float ug = fminf(acc[mt][0][i] + bg, 7.f);
        float ul = fminf(fmaxf(acc[mt][1][i] + bl, -7.f), 7.f);
        float a = ug * sigmoidf_(1.702f * ug) * (ul + 1.f);
        abase[(mt * 32 + 8 * (i >> 2) + (i & 3)) * 64] = f2bf(a);
      }
  });
}

DI void moe2_phase(const P& p, int l, unsigned char* lds) {
  const u16* ACT = (const u16*)(p.ws + O_PROJ);
  u16* Y = (u16*)(p.ws + O_Y);
  const int* TILEE = (const int*)(p.ws + O_TILEE);
  const int ntm = TILEE[1023];
  const int tid = otid(), lane = tid & 63, w = tid >> 6, r = lane & 31, hh = lane >> 5, wm = w >> 2, wn = w & 3;
  for_tiles(ntm, 4, [&](int mt_, int tn_) {
    int n0 = tn_ * 256, m0 = mt_ * 256, e = TILEE[mt_];
    const u16* Wt = (const u16*)(p.ws + O_WT + l * WL_SIZE + WL_WE2) + (size_t)e * 1024 * 1024;
    const u16* ap[4];
#pragma unroll
    for (int i = 0; i < 4; ++i) ap[i] = ACT + (size_t)mt_ * 16 * 16384 + tid * 8 + i * 4096;
    const u16* b0p = Wt + (size_t)tn_ * 16 * 16384 + tid * 8;
    f32x16 acc[4][2]; acc_zero4(acc);
    gemm256(acc, ap, b0p, 1024, lds);
    const float* b2 = p.in[I_BE2] + (size_t)(l * 32 + e) * 1024;
    u16* ybase = Y + (size_t)(m0 + wm * 128 + 4 * hh) * 1024 + n0 + wn * 64 + r;
#pragma unroll
    for (int nt = 0; nt < 2; ++nt) {
      float bv = b2[n0 + wn * 64 + nt * 32 + r];
#pragma unroll
      for (int mt = 0; mt < 4; ++mt)
#pragma unroll
        for (int i = 0; i < 16; ++i)
          ybase[(size_t)(mt * 32 + 8 * (i >> 2) + (i & 3)) * 1024 + nt * 32] = f2bf(acc[mt][nt][i] + bv);
    }
  });
}

DI void combine_phase(const P& p, int l, int ntok) {
  const int lane = otid() & 63, gw = blockIdx.x * (NT / 64) + (otid() >> 6), nw = gridDim.x * (NT / 64);
  float* XA = (float*)(p.ws + O_XA);
  const float* MOD = (const float*)(p.ws + O_MOD) + l * 5 * 6144;
  const float* MODN = (const float*)(p.ws + O_MOD) + (l + 1) * 5 * 6144;
  const u16* Y = (const u16*)(p.ws + O_Y);
  const int* TOKSLOT = (const int*)(p.ws + O_TOKSLOT); const float* TOKG = (const float*)(p.ws + O_TOKG);
  u16* H = (u16*)(p.ws + O_H);
  for (int row = gw; row < ntok; row += nw) {
    int mr = row < T ? (row >> 13) : 4;
    int4 sl = *(const int4*)(TOKSLOT + row * 4);
    float4 gt = *(const float4*)(TOKG + row * 4);
    float xv[16];
#pragma unroll
    for (int i = 0; i < 4; ++i) {
      int c = (i * 64 + lane) * 4;
      float4 x = *(const float4*)(XA + (size_t)row * D + c);
      float4 m5 = *(const float4*)(MOD + mr * 6144 + 5 * 1024 + c);
      uint2 y0 = *(const uint2*)(Y + (size_t)sl.x * 1024 + c), y1 = *(const uint2*)(Y + (size_t)sl.y * 1024 + c);
      uint2 y2 = *(const uint2*)(Y + (size_t)sl.z * 1024 + c), y3 = *(const uint2*)(Y + (size_t)sl.w * 1024 + c);
      float a0 = gt.x * lo16(y0.x) + gt.y * lo16(y1.x) + gt.z * lo16(y2.x) + gt.w * lo16(y3.x);
      float a1 = gt.x * hi16(y0.x) + gt.y * hi16(y1.x) + gt.z * hi16(y2.x) + gt.w * hi16(y3.x);
      float a2 = gt.x * lo16(y0.y) + gt.y * lo16(y1.y) + gt.z * lo16(y2.y) + gt.w * lo16(y3.y);
      float a3 = gt.x * hi16(y0.y) + gt.y * hi16(y1.y) + gt.z * hi16(y2.y) + gt.w * hi16(y3.y);
      xv[4 * i] = x.x + m5.x * a0; xv[4 * i + 1] = x.y + m5.y * a1; xv[4 * i + 2] = x.z + m5.z * a2; xv[4 * i + 3] = x.w + m5.w * a3;
      float4 o = make_float4(xv[4 * i], xv[4 * i + 1], xv[4 * i + 2], xv[4 * i + 3]);
      if (l == 1) *(float4*)(p.out + (size_t)row * D + c) = o;
      else *(float4*)(XA + (size_t)row * D + c) = o;
    }
    if (l == 0) norm_mod_store(xv, p.in[I_N1G] + 1024, MODN + mr * 6144, MODN + mr * 6144 + 1024, H, row, lane);
  }
}


#define XB_TMO      128
#define XB_XCNT(j)  (256  + 64 * (j))
#define XB_XSUB(j)  (1280 + 64 * (j))
#define XB_XGEN(j)  (2304 + 64 * (j))
#define XB_TOP      3328
#define XB_TOPGEN   3392
#define XCD_BAR_WORDS 3456
#define XB_SPIN_CAP (1u << 22)
#define LAS __attribute__((address_space(3)))
DI unsigned xb_ld(unsigned* p) { return __hip_atomic_load(p, __ATOMIC_RELAXED, __HIP_MEMORY_SCOPE_AGENT); }
DI unsigned xb_add(unsigned* p, unsigned v) { return __hip_atomic_fetch_add(p, v, __ATOMIC_RELAXED, __HIP_MEMORY_SCOPE_AGENT); }
DI unsigned xb_xcc_id() { return (unsigned)__builtin_amdgcn_s_getreg((3 << 11) | 20) & 0xFu; }
#define XB_SPIN(cond, bar) do { unsigned _sp = 0; while (cond) { __builtin_amdgcn_s_sleep(1); \
    if ((++_sp & 255u) == 0u) { if (xb_ld(&(bar)[XB_TMO])) break; if (_sp > XB_SPIN_CAP) { atomicAdd(&(bar)[XB_TMO], 1u); break; } } } } while (0)
struct XcdBarrier { unsigned* bar; unsigned x; volatile LAS unsigned* st; };
DI XcdBarrier xcd_barrier_post(unsigned* bar, volatile LAS unsigned* st) {
  XcdBarrier b; b.bar = bar; b.x = xb_xcc_id(); b.st = st;
  if (threadIdx.x == 0) (void)xb_add(&bar[XB_XCNT(b.x)], 1u);
  return b;
}
DI void xcd_barrier_complete(unsigned* bar, unsigned x, unsigned& nloc, unsigned& nx) {
  const unsigned G = gridDim.x * gridDim.y * gridDim.z;
  unsigned sum, cnt, mine, sp = 0u;
  for (;;) {
    sum = 0u; cnt = 0u; mine = 0u;
#pragma unroll
    for (unsigned j = 0; j < 16; ++j) { const unsigned c = xb_ld(&bar[XB_XCNT(j)]); sum += c; cnt += (c > 0u) ? 1u : 0u; mine = (j == x) ? c : mine; }
    if (sum == G) break;
    __builtin_amdgcn_s_sleep(1);
    if ((++sp & 255u) == 0u) { if (xb_ld(&bar[XB_TMO])) break; if (sp > XB_SPIN_CAP) { atomicAdd(&bar[XB_TMO], 1u); break; } }
  }
  nloc = mine > 0u ? mine : 1u; nx = cnt > 0u ? cnt : 1u;
}
DI void xcd_barrier(const XcdBarrier& b) {
  asm volatile("s_waitcnt vmcnt(0)" ::: "memory");
  __syncthreads();
  if (threadIdx.x == 0) {
    unsigned* bar = b.bar;
    __builtin_amdgcn_s_waitcnt(0);
    unsigned nloc = b.st[0], nx = b.st[1];
    if (nloc == 0u) { xcd_barrier_complete(bar, b.x, nloc, nx); b.st[0] = nloc; b.st[1] = nx; }
    const unsigned old = xb_add(&bar[XB_XSUB(b.x)], 1u);
    const unsigned gen = old / nloc;
    if (old + 1u == (gen + 1u) * nloc) {
      __builtin_amdgcn_fence(__ATOMIC_RELEASE, "agent");
      asm volatile("s_waitcnt vmcnt(0)" ::: "memory");
      const unsigned og = xb_add(&bar[XB_TOP], 1u);
      const unsigned tg = og / nx;
      if (og + 1u == (tg + 1u) * nx) xb_add(&bar[XB_TOPGEN], 1u);
      else XB_SPIN(xb_ld(&bar[XB_TOPGEN]) == tg, bar);
      __builtin_amdgcn_fence(__ATOMIC_ACQUIRE, "agent");
      xb_add(&bar[XB_XGEN(b.x)], 1u);
      asm volatile("s_waitcnt vmcnt(0)" ::: "memory");
    } else {
      XB_SPIN(xb_ld(&bar[XB_XGEN(b.x)]) == gen, bar);
      __builtin_amdgcn_fence(__ATOMIC_ACQUIRE, "agent");
      asm volatile("s_waitcnt vmcnt(0)" ::: "memory");
    }
  }
  __syncthreads();
}

#ifndef PM
#define PM 0xFFFF
#endif
#ifndef REP
#define REP 0
#endif
#define RUNP(bit, call) do { call; if (REP & (1 << (bit))) { GSYNC(); call; } } while (0)
__global__ void __launch_bounds__(NT) fwd_megakernel(P p) {
  cg::grid_group grid = cg::this_grid();
  extern __shared__ __attribute__((aligned(16))) unsigned char lds[];
  if (p.ws_size < WS_NEED) { if (blockIdx.x == 0 && otid() == 0) p.out[0] = 1e30f; return; }
  volatile LAS unsigned* xst = (volatile LAS unsigned*)(lds + LDS_BYTES - 16);
  if (threadIdx.x < 2) xst[threadIdx.x] = 0u;
  __syncthreads();
  (void)xcd_barrier_post((unsigned*)(p.ws + O_BAR), xst);
#define GSYNC() do { XcdBarrier xb_; unsigned* bp_ = (unsigned*)(p.ws + O_BAR); asm volatile("" : "+s"(bp_)); xb_.bar = bp_; xb_.x = xb_xcc_id(); \
    xb_.st = (volatile LAS unsigned*)(lds + LDS_BYTES - 16); xcd_barrier(xb_); } while (0)

  for (int rep = 0; rep < 1 + ((REP >> 0) & 1); ++rep) {
    if (rep) GSYNC();
    conv_all(p, (float*)lds);
    mod_phase(p, (float*)lds);
    z2_phase(p, (float*)lds);
  }
  grid.sync();
  RUNP(1, filter_phase(p, lds));
  norm1_layer0(p);
  GSYNC();

  for (int l = 0; l < 2; ++l) {
    const int rows = (l == 0) ? TA : T;
    RUNP(2, g1_phase(p, l, lds));
    GSYNC();
    RUNP(4, attn_phase(p, l, lds));
    GSYNC();
    transpose_phase(p, lds);
    GSYNC();
    RUNP(5, merge_phase(p, l, rows, lds));
    GSYNC();
    if (PM & 256) wo_phase(p, l, rows, lds);
    GSYNC();
    RUNP(6, router_phase(p, l, rows, lds));
    GSYNC();
    RUNP(6, slot_phase(p, rows, lds));
    GSYNC();
    RUNP(7, moe1_phase(p, l, lds));
    GSYNC();
    RUNP(8, moe2_phase(p, l, lds));
    GSYNC();
    if (PM & 8192) combine_phase(p, l, rows);
    if (l == 0) GSYNC();
  }
}

extern "C" void kernel_launch(void* const* d_in, const int* in_sizes, int n_in, void* d_out, int out_size,
                              void* d_ws, size_t ws_size, hipStream_t stream) {
  static int grid_blocks = 0;
  if (!grid_blocks) {
    int dev = 0, cus = 0, per_cu = 0;
    (void)hipGetDevice(&dev);
    (void)hipDeviceGetAttribute(&cus, hipDeviceAttributeMultiprocessorCount, dev);
    if (hipFuncSetAttribute((const void*)fwd_megakernel, hipFuncAttributeMaxDynamicSharedMemorySize, LDS_BYTES) != hipSuccess)
      fprintf(stderr, "hipFuncSetAttribute failed\n");
    (void)hipOccupancyMaxActiveBlocksPerMultiprocessor(&per_cu, (const void*)fwd_megakernel, NT, LDS_BYTES);
    if (per_cu < 1) per_cu = 1;
    grid_blocks = cus * per_cu;
    if (grid_blocks > 256) grid_blocks = 256;
    if (grid_blocks != 256) fprintf(stderr, "unexpected grid %d\n", grid_blocks);
    fprintf(stderr, "grid %d (cus %d per_cu %d) ws %zu need %zu\n", grid_blocks, cus, per_cu, ws_size, (size_t)WS_NEED);
  }
  P p{};
  for (int i = 0; i < 35 && i < n_in; ++i) p.in[i] = (const float*)d_in[i];
  p.out = (float*)d_out;
  p.ws = (unsigned char*)d_ws;
  p.ws_size = (unsigned long long)ws_size;
  (void)hipMemsetAsync((unsigned char*)d_ws + O_BAR, 0, XCD_BAR_WORDS * 4, stream);
  void* args[] = {&p};
  hipError_t e = hipLaunchCooperativeKernel((void*)fwd_megakernel, dim3(grid_blocks), dim3(NT), args, LDS_BYTES, stream);
  if (e != hipSuccess) fprintf(stderr, "cooperative launch failed: %s (grid %d)\n", hipGetErrorString(e), grid_blocks);
}
```
